# Optimizing an MI355X kernel written in HIP

```python
import jax, jax.numpy as jnp
from jax import lax
import numpy as np

D_MODEL = 2048
BATCH = 4
SEQ = 4096
DEPTH = 4

N_A_LAYERS = DEPTH // 2
N_B_LAYERS = DEPTH - N_A_LAYERS
A_HEADS = 16
A_DK = D_MODEL // A_HEADS
A_DV = D_MODEL // A_HEADS
A_CHUNK = 64
B_HEADS = 16
B_HD = D_MODEL // B_HEADS
B_CONFIGS = ((128, 1), (512, 4), (2048, 16))
N_GROUPS = len(B_CONFIGS)
B_QBLOCK = 128
ROPE_THETA = 500000.0
ROPE_DIM = B_HD // 4
FFN_HIDDEN = ((8 * D_MODEL // 3 + 255) // 256) * 256
EPS = 1e-6
F32 = jnp.float32

kernel_name = 'yoco_hgrn2_dilated_swa'


def rms_norm(x, g):
    xf = x.astype(F32)
    y = xf * lax.rsqrt(jnp.mean(xf * xf, axis=-1, keepdims=True) + EPS)
    return (y * g.astype(F32)).astype(x.dtype)


def swiglu(h, w_in, w_out):
    gate, up = jnp.split(h @ w_in, 2, axis=-1)
    return (jax.nn.silu(gate) * up) @ w_out


def apply_partial_rope(x, positions):
    half = ROPE_DIM // 2
    inv_freq = ROPE_THETA ** (-jnp.arange(half, dtype=F32) * 2.0 / ROPE_DIM)
    ang = positions.astype(F32)[:, None] * inv_freq[None, :]
    shape = (ang.shape[0],) + (1,) * (x.ndim - 3) + (half,)
    cos, sin = jnp.cos(ang).reshape(shape), jnp.sin(ang).reshape(shape)
    xf = x.astype(F32)
    x1, x2, rest = xf[..., :half], xf[..., half:ROPE_DIM], xf[..., ROPE_DIM:]
    out = jnp.concatenate([x1 * cos - x2 * sin, x2 * cos + x1 * sin, rest], axis=-1)
    return out.astype(x.dtype)


def hgrn2_mixer(h, w_in, o_gain, w_out, lb):
    Bn, S, _ = h.shape
    q, fz, i, g = jnp.split(h @ w_in, 4, axis=-1)
    fz = fz.astype(F32)
    lbf = jnp.clip(lb.astype(F32), 0.0, 1.0 - 1e-6)
    log_f = jnp.logaddexp(jnp.log(lbf), jnp.log1p(-lbf) + jax.nn.log_sigmoid(fz))
    k = (1.0 - lbf) * jax.nn.sigmoid(-fz)
    n_chunks = S // A_CHUNK

    def heads(t, d):
        return t.reshape(Bn, n_chunks, A_CHUNK, A_HEADS, d).transpose(1, 0, 3, 2, 4).astype(F32)

    qc, kc, vc, lc = heads(q, A_DK), heads(k, A_DK), heads(i, A_DV), heads(log_f, A_DK)
    causal = jnp.tril(jnp.ones((A_CHUNK, A_CHUNK), dtype=bool))

    def step(state, inp):
        qb, kb, vb, lfb = inp
        b = jnp.cumsum(lfb, axis=-2)
        o_inter = jnp.einsum('bhtk,bhkv->bhtv', qb * jnp.exp(b), state)
        diff = b[:, :, :, None, :] - b[:, :, None, :, :]
        decay = jnp.exp(jnp.where(causal[:, :, None], diff, -jnp.inf))
        scores = jnp.einsum('bhtk,bhtsk,bhsk->bhts', qb, decay, kb)
        o = o_inter + jnp.einsum('bhts,bhsv->bhtv', scores, vb)
        b_last = b[:, :, -1:, :]
        state = (jnp.exp(b_last[:, :, 0, :])[..., None] * state
                 + jnp.einsum('bhsk,bhsv->bhkv', kb * jnp.exp(b_last - b), vb))
        return state, o

    s0 = jnp.zeros((Bn, A_HEADS, A_DK, A_DV), F32)
    _, o = lax.scan(step, s0, (qc, kc, vc, lc))
    o = o.transpose(1, 0, 3, 2, 4).reshape(Bn, S, A_HEADS, A_DV)
    o = rms_norm(o, o_gain).reshape(Bn, S, A_HEADS * A_DV) * jax.nn.silu(g.astype(F32))
    return o.astype(h.dtype) @ w_out


def dilated_window_attention(q, k, v, window, dilation):
    Bn, S, H, hd = q.shape
    L = S // dilation
    w_sub = window // dilation
    n_blk = -(-L // B_QBLOCK)
    Lp = n_blk * B_QBLOCK

    def strided(t):
        t = t.reshape(Bn, L, dilation, H, hd).transpose(0, 2, 3, 1, 4)
        t = jnp.pad(t, ((0, 0), (0, 0), (0, 0), (0, Lp - L), (0, 0)))
        return t.reshape(Bn, dilation, H, n_blk, B_QBLOCK, hd)

    def band(t):
        prev = jnp.pad(t, ((0, 0), (0, 0), (0, 0), (1, 0), (0, 0), (0, 0)))[:, :, :, :-1]
        return jnp.concatenate([prev, t], axis=4)

    qb = strided(q)
    kk, vv = band(strided(k)), band(strided(v))
    scores = jnp.einsum('bdhnqe,bdhnke->bdhnqk', qb, kk).astype(F32) * (hd ** -0.5)
    qi = jnp.arange(B_QBLOCK)[:, None]
    kj = jnp.arange(2 * B_QBLOCK)[None, :]
    dist = B_QBLOCK + qi - kj
    key_pos = jnp.arange(n_blk)[:, None, None] * B_QBLOCK + kj[None] - B_QBLOCK
    valid = (dist >= 0) & (dist <= w_sub) & (key_pos >= 0)
    scores = jnp.where(valid, scores, -jnp.inf)
    m = jnp.max(scores, axis=-1, keepdims=True)
    p = jnp.exp(scores - m)
    l = jnp.sum(p, axis=-1, keepdims=True)
    o = jnp.einsum('bdhnqk,bdhnke->bdhnqe', p, vv.astype(F32)) / l
    lse = (m + jnp.log(l))[..., 0]
    o = o.reshape(Bn, dilation, H, Lp, hd)[:, :, :, :L].transpose(0, 3, 1, 2, 4).reshape(Bn, S, H, hd)
    lse = lse.reshape(Bn, dilation, H, Lp)[..., :L].transpose(0, 3, 1, 2).reshape(Bn, S, H)
    return o, lse


def shared_kv(x, kv_norm, w_kv, k_gain, positions):
    Bn, S, _ = x.shape
    kv = (rms_norm(x, kv_norm) @ w_kv).reshape(Bn, S, 2, N_GROUPS, B_HEADS, B_HD)
    k = apply_partial_rope(rms_norm(kv[:, :, 0], k_gain[:, None, :]), positions)
    return k, kv[:, :, 1]


def dilated_mixer(h, w_q, q_gain, w_out, k_sh, v_sh, positions):
    Bn, S, _ = h.shape
    q = (h @ w_q).reshape(Bn, S, N_GROUPS, B_HEADS, B_HD)
    q = apply_partial_rope(rms_norm(q, q_gain[:, None, :]), positions)
    outs, lses = [], []
    for gi, (window, dilation) in enumerate(B_CONFIGS):
        o_g, lse_g = dilated_window_attention(q[:, :, gi], k_sh[:, :, gi], v_sh[:, :, gi], window, dilation)
        outs.append(o_g)
        lses.append(lse_g)
    wts = jax.nn.softmax(jnp.stack(lses, axis=0), axis=0)
    o = jnp.sum(wts[..., None] * jnp.stack(outs, axis=0), axis=0)
    return o.reshape(Bn, S, B_HEADS * B_HD).astype(h.dtype) @ w_out


def setup_inputs(seed: int = 0) -> dict:
    key = jax.random.key(seed)
    ks = jax.random.split(key, 16)
    D = D_MODEL

    def w(k, shape, fan_in):
        return jax.random.normal(k, shape, F32) * (fan_in ** -0.5)

    def gain(k, shape):
        return 1.0 + 0.02 * jax.random.normal(k, shape, F32)

    return {
        'x': jax.random.normal(ks[0], (BATCH, SEQ, D), F32),
        'a_norm': gain(ks[1], (N_A_LAYERS, D)),
        'a_w_in': w(ks[2], (N_A_LAYERS, D, 4 * D), D),
        'a_o_gain': gain(ks[3], (N_A_LAYERS, A_DV)),
        'a_w_out': w(ks[4], (N_A_LAYERS, A_HEADS * A_DV, D), A_HEADS * A_DV),
        'a_lower_bounds': 0.1 * jax.random.normal(ks[5], (N_A_LAYERS, A_HEADS * A_DK), F32),
        'kv_norm': gain(ks[6], (D,)),
        'w_kv': w(ks[7], (D, 2 * N_GROUPS * B_HEADS * B_HD), D),
        'k_gain': gain(ks[8], (N_GROUPS, B_HD)),
        'b_norm': gain(ks[9], (N_B_LAYERS, D)),
        'b_w_q': w(ks[10], (N_B_LAYERS, D, N_GROUPS * B_HEADS * B_HD), D),
        'b_q_gain': gain(ks[11], (N_B_LAYERS, N_GROUPS, B_HD)),
        'b_w_out': w(ks[12], (N_B_LAYERS, B_HEADS * B_HD, D), B_HEADS * B_HD),
        'ffn_norm': gain(ks[13], (DEPTH, D)),
        'ffn_w_in': w(ks[14], (DEPTH, D, 2 * FFN_HIDDEN), D),
        'ffn_w_out': w(ks[15], (DEPTH, FFN_HIDDEN, D), FFN_HIDDEN),
    }


def reference(x, a_norm, a_w_in, a_o_gain, a_w_out, a_lower_bounds, kv_norm, w_kv, k_gain,
              b_norm, b_w_q, b_q_gain, b_w_out, ffn_norm, ffn_w_in, ffn_w_out):
    S = x.shape[1]
    positions = jnp.arange(S)
    lbs = jax.nn.softmax(a_lower_bounds.astype(F32), axis=0)
    lbs = jnp.cumsum(lbs, axis=0) - lbs[0]
    k_sh, v_sh = None, None
    for layer in range(DEPTH):
        if layer < N_A_LAYERS:
            x = x + hgrn2_mixer(rms_norm(x, a_norm[layer]), a_w_in[layer], a_o_gain[layer],
                                a_w_out[layer], lbs[layer])
        else:
            if layer == N_A_LAYERS:
                k_sh, v_sh = shared_kv(x, kv_norm, w_kv, k_gain, positions)
            j = layer - N_A_LAYERS
            x = x + dilated_mixer(rms_norm(x, b_norm[j]), b_w_q[j], b_q_gain[j], b_w_out[j],
                                  k_sh, v_sh, positions)
        x = x + swiglu(rms_norm(x, ffn_norm[layer]), ffn_w_in[layer], ffn_w_out[layer])
    return x
```

```cpp
#include <hip/hip_runtime.h>
#include <cstdio>
#include <cstdint>
namespace pg8 {
#define PG8_LAS __attribute__((address_space(3)))
typedef unsigned short bf16_t;
typedef short bf16x8 __attribute__((ext_vector_type(8)));
typedef float f32x4 __attribute__((ext_vector_type(4)));
typedef unsigned u32x4 __attribute__((ext_vector_type(4)));
constexpr int BM = 256, BK = 64, HALF = 128, HTB = HALF * BK * 2  , STAGE_BYTES = 8 * HTB, NXCD = 8, WGM = 8;

__host__ __device__ __forceinline__ int lds_byte(int r, int c) { const int st = (r >> 4) * 2 + (c >> 5), rr = r & 15, cc = c & 31, ob = rr * 64 + cc * 2; return st * 1024 + (ob ^ (((ob >> 9) & 1) << 5)); }
__host__ __device__ __forceinline__ void stage_rc(int b, int& R, int& C) { const int st = b / 1024, sb = b % 1024, swz = sb ^ (((sb >> 9) & 1) << 5); R = (st >> 1) * 16 + swz / 64; C = (st & 1) * 32 + (swz % 64) / 2; }
__host__ __device__ __forceinline__ int perm32(int rho) { const int n = rho >> 4, i = rho & 15; return 8 * (i >> 2) + 4 * n + (i & 3); }

struct Unit { int pm, pn; };
struct Gemm { const bf16_t* A; const bf16_t* Bt; int M, N, K; };

struct StaticOrder {
    int nM, nN, nwg, G, c;
    __host__ __device__ void init(int M, int N, int G_, int c_) { nM = M / BM; nN = N / BM; nwg = nM * nN; G = G_; c = c_; }
    __host__ __device__ bool next(int i, Unit& u) const {
        const long L = (long)i * G + c; if (L >= nwg) return false;
        int wgid = (int)L; { const int q = nwg / NXCD, r = nwg % NXCD, xcd = wgid % NXCD, off = wgid / NXCD; wgid = (xcd < r ? xcd * (q + 1) : r * (q + 1) + (xcd - r) * q) + off; }
        const int nig = WGM * nN, gid = wgid / nig, fm = gid * WGM, gsz = (nM - fm) < WGM ? (nM - fm) : WGM;
        u.pm = fm + ((wgid % nig) % gsz); u.pn = (wgid % nig) / gsz; return true;
    }
    __device__ __forceinline__ void a_ready(const Unit&) const {}
    __device__ __forceinline__ void done(const Unit&) const {}
};
__device__ __forceinline__ unsigned cvt_pk_bf16(float lo, float hi) { unsigned r; asm volatile("v_cvt_pk_bf16_f32 %0, %1, %2" : "=v"(r) : "v"(lo), "v"(hi)); return r; }
template <class Epi, class Sched, bool ALIGN_EPI = false, bool SP2 = false>
__device__ __forceinline__ void gemm_phase(PG8_LAS unsigned char* lds, const Gemm g, const Sched& S, const Epi& E) {
    int tid_ = threadIdx.x; asm volatile("" : "+v"(tid_));
    const int tid = tid_, wid = __builtin_amdgcn_readfirstlane(tid >> 6), lane = tid & 63, wr = wid >> 2, wc = wid & 3, fr = lane & 15, fq = lane >> 4;
    const int K = g.K, nt = K / BK;
    unsigned voffA[2], voffB[2];
#pragma unroll
    for (int i = 0; i < 2; ++i) { int R, C; stage_rc(tid * 16 + i * 8192, R, C); const int Rb = Epi::PERM ? ((R & ~31) + perm32(R & 31)) : R;
        voffA[i] = (unsigned)(R * K + C) * 2u; voffB[i] = (unsigned)(Rb * K + C) * 2u; }
    const size_t kstep = (size_t)(BK * 2);
    const size_t hstep = (size_t)HALF * K * 2;
    const size_t tstep = 2 * hstep;
    const unsigned ldsw = (unsigned)wid * 1024u;
    const int aoff = lds_byte(wr * 64 + fr, fq * 8), boff = lds_byte(wc * 32 + fr, fq * 8);
#define PG8_SA(b, h) (((b) * 2 + (h)) * HTB)
#define PG8_SB(b, h) ((4 + (b) * 2 + (h)) * HTB)
#define PG8_STAGE(bufoff, gbase, voff) do { _Pragma("unroll") for (int _i = 0; _i < 2; ++_i) \
        __builtin_amdgcn_global_load_lds((const unsigned*)((const char*)(gbase) + (voff)[_i]), (PG8_LAS unsigned*)(lds + (bufoff) + ldsw + _i * 8192), 16, 0, 0); } while (0)
#define PG8_LDA(dst, b, h) do { _Pragma("unroll") for (int m = 0; m < 4; ++m) _Pragma("unroll") for (int k = 0; k < 2; ++k) dst[m][k] = *(const PG8_LAS bf16x8*)(lds + PG8_SA(b, h) + aoff + m * 2048 + k * 1024); } while (0)
#define PG8_LDB(dst, b, h) do { _Pragma("unroll") for (int n = 0; n < 2; ++n) _Pragma("unroll") for (int k = 0; k < 2; ++k) dst[n][k] = *(const PG8_LAS bf16x8*)(lds + PG8_SB(b, h) + boff + n * 2048 + k * 1024); } while (0)
#define PG8_MMA(ai, bj, At, Bt) do { __builtin_amdgcn_s_setprio(1); _Pragma("unroll") for (int m = 0; m < 4; ++m) _Pragma("unroll") for (int n = 0; n < 2; ++n) _Pragma("unroll") for (int k = 0; k < 2; ++k) \
        acc[ai][bj][m][n] = __builtin_amdgcn_mfma_f32_16x16x32_bf16(Bt[n][k], At[m][k], acc[ai][bj][m][n], 0, 0, 0); __builtin_amdgcn_s_setprio(0); } while (0)
#define PG8_WAIT_V(n) asm volatile("s_waitcnt vmcnt(" #n ")" ::: "memory")
#define PG8_WAIT_L(n) asm volatile("s_waitcnt lgkmcnt(" #n ")" ::: "memory")
#define PG8_BAR __builtin_amdgcn_s_barrier()
#define PG8_SCHED __builtin_amdgcn_sched_barrier(0)
    Unit cur, nxt; int ui = 0;
    if (!S.next(0, cur)) return;
    f32x4 acc[2][2][4][2];
#pragma unroll
    for (int a = 0; a < 2; ++a)
#pragma unroll
        for (int b = 0; b < 2; ++b)
#pragma unroll
            for (int m = 0; m < 4; ++m)
#pragma unroll
                for (int n = 0; n < 2; ++n) acc[a][b][m][n] = (f32x4){0.f, 0.f, 0.f, 0.f};
    bf16x8 At[4][2], B0[2][2], B1[2][2];
    const char* cA = (const char*)g.A + (size_t)cur.pm * tstep; const char* cB = (const char*)g.Bt + (size_t)cur.pn * tstep;
    S.a_ready(cur);
    if constexpr (SP2) {
        PG8_STAGE(PG8_SB(0, 0), cB, voffB); PG8_STAGE(PG8_SB(0, 1), cB + hstep, voffB); PG8_STAGE(PG8_SA(0, 0), cA, voffA); PG8_STAGE(PG8_SA(0, 1), cA + hstep, voffA);
        if (wr == 1) PG8_BAR;
        PG8_WAIT_V(2); PG8_BAR;
        PG8_STAGE(PG8_SB(1, 0), cB + kstep, voffB); PG8_STAGE(PG8_SA(1, 0), cA + kstep, voffA); PG8_STAGE(PG8_SB(1, 1), cB + hstep + kstep, voffB);
        PG8_WAIT_V(6); PG8_BAR;
    } else {
        PG8_STAGE(PG8_SB(0, 0), cB, voffB); PG8_STAGE(PG8_SA(0, 0), cA, voffA); PG8_STAGE(PG8_SB(0, 1), cB + hstep, voffB); PG8_STAGE(PG8_SA(0, 1), cA + hstep, voffA);
        if (wr == 1) PG8_BAR;
        PG8_WAIT_V(4); PG8_BAR;
        PG8_STAGE(PG8_SB(1, 0), cB + kstep, voffB); PG8_STAGE(PG8_SA(1, 0), cA + kstep, voffA); PG8_STAGE(PG8_SB(1, 1), cB + hstep + kstep, voffB);
        PG8_WAIT_V(6); PG8_BAR;
    }
    for (;;) {
        const bool has_next = S.next(ui + 1, nxt);
        const char* nA = has_next ? (const char*)g.A + (size_t)nxt.pm * tstep : cA; const char* nB = has_next ? (const char*)g.Bt + (size_t)nxt.pn * tstep : cB;
        for (int t = 0; t < nt; t += 2) {
            const bool last = (t == nt - 2);
            const char* a1 = cA + (size_t)(t + 1) * kstep;
            const char* a2 = last ? nA : cA + (size_t)(t + 2) * kstep; const char* b2 = last ? nB : cB + (size_t)(t + 2) * kstep;
            const char* a3 = a2 + kstep; const char* b3 = b2 + kstep;
            if (last && has_next) S.a_ready(nxt);
            if constexpr (SP2) {
            PG8_LDB(B0, 0, 0); PG8_LDB(B1, 0, 1); PG8_SCHED; PG8_LDA(At, 0, 0); PG8_STAGE(PG8_SA(1, 1), a1 + hstep, voffA);
            PG8_WAIT_V(8); PG8_WAIT_L(0); PG8_BAR; PG8_MMA(0, 0, At, B0); PG8_MMA(0, 1, At, B1); PG8_BAR; PG8_SCHED;
            PG8_LDA(At, 0, 1); PG8_STAGE(PG8_SB(0, 0), b2, voffB); PG8_STAGE(PG8_SB(0, 1), b2 + hstep, voffB); PG8_STAGE(PG8_SA(0, 0), a2, voffA);
            PG8_WAIT_V(8); PG8_WAIT_L(0); PG8_BAR; PG8_MMA(1, 0, At, B0); PG8_MMA(1, 1, At, B1); PG8_BAR; PG8_SCHED;
            PG8_LDB(B0, 1, 0); PG8_LDB(B1, 1, 1); PG8_SCHED; PG8_LDA(At, 1, 0); PG8_STAGE(PG8_SA(0, 1), a2 + hstep, voffA);
            PG8_WAIT_V(8); PG8_WAIT_L(0); PG8_BAR; PG8_MMA(0, 0, At, B0); PG8_MMA(0, 1, At, B1); PG8_BAR; PG8_SCHED;
            PG8_LDA(At, 1, 1); PG8_STAGE(PG8_SB(1, 0), b3, voffB); PG8_STAGE(PG8_SB(1, 1), b3 + hstep, voffB); PG8_STAGE(PG8_SA(1, 0), a3, voffA);
            PG8_WAIT_V(8); PG8_WAIT_L(0); PG8_BAR; PG8_MMA(1, 0, At, B0); PG8_MMA(1, 1, At, B1); PG8_BAR; PG8_SCHED;
            } else {
            PG8_LDB(B0, 0, 0); PG8_SCHED; PG8_LDA(At, 0, 0); PG8_STAGE(PG8_SA(1, 1), a1 + hstep, voffA);
            PG8_WAIT_L(8); PG8_BAR; PG8_WAIT_L(0); PG8_MMA(0, 0, At, B0); PG8_BAR; PG8_SCHED;
            PG8_LDB(B1, 0, 1); PG8_STAGE(PG8_SB(0, 0), b2, voffB);
            PG8_BAR; PG8_WAIT_L(0); PG8_MMA(0, 1, At, B1); PG8_BAR;
            PG8_LDA(At, 0, 1); PG8_STAGE(PG8_SA(0, 0), a2, voffA);
            PG8_BAR; PG8_WAIT_L(0); PG8_MMA(1, 0, At, B0); PG8_BAR; PG8_SCHED;
            PG8_STAGE(PG8_SB(0, 1), b2 + hstep, voffB);
            PG8_WAIT_V(6); PG8_BAR; PG8_MMA(1, 1, At, B1); PG8_BAR;
            PG8_LDB(B0, 1, 0); PG8_SCHED; PG8_LDA(At, 1, 0); PG8_STAGE(PG8_SA(0, 1), a2 + hstep, voffA);
            PG8_WAIT_L(8); PG8_BAR; PG8_WAIT_L(0); PG8_MMA(0, 0, At, B0); PG8_BAR; PG8_SCHED;
            PG8_LDB(B1, 1, 1); PG8_STAGE(PG8_SB(1, 0), b3, voffB);
            PG8_BAR; PG8_WAIT_L(0); PG8_MMA(0, 1, At, B1); PG8_BAR;
            PG8_LDA(At, 1, 1); PG8_STAGE(PG8_SA(1, 0), a3, voffA);
            PG8_BAR; PG8_WAIT_L(0); PG8_MMA(1, 0, At, B0); PG8_BAR; PG8_SCHED;
            PG8_STAGE(PG8_SB(1, 1), b3 + hstep, voffB);
            PG8_WAIT_V(6); PG8_BAR; PG8_MMA(1, 1, At, B1); PG8_BAR;
            }
        }
        if constexpr (ALIGN_EPI) { if (wr == 0) PG8_BAR; }
        E(acc, cur, wr, wc, fr, fq, lds);
        if (!has_next) break;
#pragma unroll
        for (int a = 0; a < 2; ++a)
#pragma unroll
            for (int b = 0; b < 2; ++b)
#pragma unroll
                for (int m = 0; m < 4; ++m)
#pragma unroll
                    for (int n = 0; n < 2; ++n) acc[a][b][m][n] = (f32x4){0.f, 0.f, 0.f, 0.f};
        cur = nxt; cA = nA; cB = nB; ++ui;
        if constexpr (ALIGN_EPI) { if (wr == 1) PG8_BAR; }
    }
    PG8_WAIT_V(0);
    if constexpr (!ALIGN_EPI) { if (wr == 0) PG8_BAR; }
    PG8_BAR;
#undef PG8_SA
#undef PG8_SB
#undef PG8_STAGE
#undef PG8_LDA
#undef PG8_LDB
#undef PG8_MMA
#undef PG8_WAIT_V
#undef PG8_WAIT_L
#undef PG8_BAR
#undef PG8_SCHED
}
}
namespace pg8 {
constexpr int DMODEL = 2048;
constexpr float RMS_EPS = 1e-6f;
__device__ __forceinline__ float fast_exp(float x) { return __builtin_amdgcn_exp2f(x * 1.4426950408889634f); }
__device__ __forceinline__ float fast_log(float x) { return __builtin_amdgcn_logf(x) * 0.6931471805599453f; }
__device__ __forceinline__ float fast_rcp(float x) { return __builtin_amdgcn_rcpf(x); }
__device__ __forceinline__ float silu_f(float v) { return v * fast_rcp(1.0f + fast_exp(-v)); }
__device__ __forceinline__ u32x4 pack8_bf16(const f32x4 a, const f32x4 b) { u32x4 w; w.x = cvt_pk_bf16(a[0], a[1]); w.y = cvt_pk_bf16(a[2], a[3]); w.z = cvt_pk_bf16(b[0], b[1]); w.w = cvt_pk_bf16(b[2], b[3]); return w; }
__device__ __forceinline__ void row_scales(float (&rs)[2][4], const float* ss, int row0) {
#pragma unroll
    for (int ai = 0; ai < 2; ++ai)
#pragma unroll
        for (int m = 0; m < 4; ++m) rs[ai][m] = __builtin_amdgcn_rsqf(ss[row0 + ai * HALF + m * 16] * (1.0f / DMODEL) + RMS_EPS);
}

__device__ __forceinline__ void fz_one(float z, float l, float& k, float& logf) {
    const float e = fast_exp(-__builtin_fabsf(z)), inv = fast_rcp(1.0f + e), sm = e * inv;
    const float sig = z >= 0.f ? inv : sm, nsig = z >= 0.f ? sm : inv;
    k = (1.0f - l) * nsig; logf = fast_log(l + (1.0f - l) * sig);
}

struct EpiHgrnIn {
    static constexpr bool PERM = true, AFTER_DRAIN = false;
    bf16_t* QKVG; float* LOGF; const float* ss; const float* lb;
    static constexpr size_t TSTRIDE = (size_t)16384 * DMODEL;
    __device__ __forceinline__ void operator()(const f32x4 (&acc)[2][2][4][2], const Unit& u, int wr, int wc, int fr, int fq, PG8_LAS unsigned char*) const {
        const int row0 = u.pm * BM + wr * 64 + fr, type = u.pn >> 3, col0 = (u.pn & 7) * BM + wc * 32 + 8 * fq;
        if (type == 1) {
#pragma unroll
            for (int bj = 0; bj < 2; ++bj) { const f32x4 lb0 = *(const f32x4*)(lb + col0 + bj * HALF), lb1 = *(const f32x4*)(lb + col0 + bj * HALF + 4);
#pragma unroll
                for (int ai = 0; ai < 2; ++ai)
#pragma unroll
                    for (int m = 0; m < 4; ++m) { const int row = row0 + ai * HALF + m * 16; const size_t off = (size_t)row * DMODEL + col0 + bj * HALF;
                        const float rs = __builtin_amdgcn_rsqf(ss[row] * (1.0f / DMODEL) + RMS_EPS); f32x4 kk0, kk1, lf0, lf1;
#pragma unroll
                        for (int j = 0; j < 4; ++j) { float ka, la, kb, lb_; fz_one(acc[ai][bj][m][0][j] * rs, lb0[j], ka, la); fz_one(acc[ai][bj][m][1][j] * rs, lb1[j], kb, lb_); kk0[j] = ka; lf0[j] = la; kk1[j] = kb; lf1[j] = lb_; }
                        *(u32x4*)(QKVG + TSTRIDE + off) = pack8_bf16(kk0, kk1);
                        *(f32x4*)(LOGF + off) = lf0; *(f32x4*)(LOGF + off + 4) = lf1;
                        asm volatile("" ::: "memory"); } }
        } else {
            bf16_t* dst = QKVG + (size_t)(type == 0 ? 0 : type) * TSTRIDE;
#pragma unroll
            for (int ai = 0; ai < 2; ++ai)
#pragma unroll
                for (int m = 0; m < 4; ++m) { const int row = row0 + ai * HALF + m * 16; const size_t off = (size_t)row * DMODEL + col0;
                    const float rs = __builtin_amdgcn_rsqf(ss[row] * (1.0f / DMODEL) + RMS_EPS);
#pragma unroll
                    for (int bj = 0; bj < 2; ++bj) { f32x4 v0 = acc[ai][bj][m][0] * rs, v1 = acc[ai][bj][m][1] * rs;
                        if (type == 3) {
#pragma unroll
                            for (int j = 0; j < 4; ++j) { v0[j] = silu_f(v0[j]); v1[j] = silu_f(v1[j]); } }
                        *(u32x4*)(dst + off + bj * HALF) = pack8_bf16(v0, v1); }
                    asm volatile("" ::: "memory"); }
        }
    }
};

struct EpiRes {
    static constexpr bool PERM = true, AFTER_DRAIN = false;
    const float* resid; float* out; bf16_t* xb; float* ssn;
    __device__ __forceinline__ void operator()(const f32x4 (&acc)[2][2][4][2], const Unit& u, int wr, int wc, int fr, int fq, PG8_LAS unsigned char*) const {
        const int row0 = u.pm * BM + wr * 64 + fr, col0 = u.pn * BM + wc * 32 + 8 * fq;
#pragma unroll
        for (int ai = 0; ai < 2; ++ai)
#pragma unroll
            for (int m = 0; m < 4; ++m) { const int row = row0 + ai * HALF + m * 16; const size_t off = (size_t)row * DMODEL + col0; float s = 0.f;
#pragma unroll
                for (int bj = 0; bj < 2; ++bj) { const f32x4 r0 = *(const f32x4*)(resid + off + bj * HALF), r1 = *(const f32x4*)(resid + off + bj * HALF + 4);
                    const f32x4 x0 = acc[ai][bj][m][0] + r0, x1 = acc[ai][bj][m][1] + r1;
                    *(f32x4*)(out + off + bj * HALF) = x0; *(f32x4*)(out + off + bj * HALF + 4) = x1;
                    *(u32x4*)(xb + off + bj * HALF) = pack8_bf16(x0, x1);
                    s += (x0[0] * x0[0] + x0[1] * x0[1]) + (x0[2] * x0[2] + x0[3] * x0[3]) + (x1[0] * x1[0] + x1[1] * x1[1]) + (x1[2] * x1[2] + x1[3] * x1[3]); }
                s += __shfl_xor(s, 16); s += __shfl_xor(s, 32);
                if (fq == 0) unsafeAtomicAdd(ssn + row, s); }
    }
};

struct EpiFfn1 {
    static constexpr bool PERM = true, AFTER_DRAIN = false;
    bf16_t* H; int ldh; const float* ss;
    __device__ __forceinline__ void operator()(const f32x4 (&acc)[2][2][4][2], const Unit& u, int wr, int wc, int fr, int fq, PG8_LAS unsigned char*) const {
        const int row0 = u.pm * BM + wr * 64 + fr, col0 = u.pn * HALF + wc * 32 + 8 * fq;
        float rs[2][4]; row_scales(rs, ss, row0);
#pragma unroll
        for (int ai = 0; ai < 2; ++ai)
#pragma unroll
            for (int m = 0; m < 4; ++m) { f32x4 h[2];
#pragma unroll
                for (int n = 0; n < 2; ++n)
#pragma unroll
                    for (int j = 0; j < 4; ++j) { const float g = acc[ai][0][m][n][j] * rs[ai][m], up = acc[ai][1][m][n][j] * rs[ai][m]; h[n][j] = silu_f(g) * up; }
                *(u32x4*)(H + (size_t)(row0 + ai * HALF + m * 16) * ldh + col0) = pack8_bf16(h[0], h[1]); }
    }
};

constexpr int QKV_SCR_OFF = 131072;
struct EpiQkv {
    static constexpr bool PERM = true, AFTER_DRAIN = false;
    bf16_t *Qo, *Ko, *Vo; const float* ss; const float* qgain; const float* kgain; const float* rope;
    __device__ __forceinline__ void operator()(const f32x4 (&acc)[2][2][4][2], const Unit& u, int wr, int wc, int fr, int fq, PG8_LAS unsigned char* lds) const {
        const int kind = u.pn / 24, pt = u.pn - kind * 24, grp = pt >> 3;
        const int row0 = u.pm * BM + wr * 64 + fr, col0 = pt * BM + wc * 32 + 8 * fq;
        float rs[2][4]; row_scales(rs, ss, row0);
        if (kind == 2) {
#pragma unroll
            for (int ai = 0; ai < 2; ++ai)
#pragma unroll
                for (int m = 0; m < 4; ++m) { const size_t off = (size_t)(row0 + ai * HALF + m * 16) * 6144 + col0;
#pragma unroll
                    for (int bj = 0; bj < 2; ++bj) *(u32x4*)(Vo + off + bj * HALF) = pack8_bf16(acc[ai][bj][m][0] * rs[ai][m], acc[ai][bj][m][1] * rs[ai][m]); }
            return;
        }
        PG8_LAS float* scr = (PG8_LAS float*)(lds + QKV_SCR_OFF);
#pragma unroll
        for (int ai = 0; ai < 2; ++ai)
#pragma unroll
            for (int m = 0; m < 4; ++m)
#pragma unroll
                for (int bj = 0; bj < 2; ++bj) { const f32x4 a = acc[ai][bj][m][0] * rs[ai][m], b = acc[ai][bj][m][1] * rs[ai][m];
                    float s = (a[0] * a[0] + a[1] * a[1]) + (a[2] * a[2] + a[3] * a[3]) + (b[0] * b[0] + b[1] * b[1]) + (b[2] * b[2] + b[3] * b[3]);
                    s += __shfl_xor(s, 16); s += __shfl_xor(s, 32);
                    if (fq == 0) scr[((ai * HALF + wr * 64 + m * 16 + fr) * 2 + bj) * 4 + wc] = s; }
        asm volatile("s_waitcnt lgkmcnt(0)" ::: "memory"); __builtin_amdgcn_s_barrier(); asm volatile("" ::: "memory");
        const float* gain = (kind == 0 ? qgain : kgain) + grp * 128 + wc * 32 + 8 * fq;
        const f32x4 g0 = *(const f32x4*)gain, g1 = *(const f32x4*)(gain + 4);
        bf16_t* dst = kind == 0 ? Qo : Ko;
#pragma unroll
        for (int ai = 0; ai < 2; ++ai)
#pragma unroll
            for (int m = 0; m < 4; ++m) { const int row = row0 + ai * HALF + m * 16; const size_t off = (size_t)row * 6144 + col0;
                f32x4 c0 = {1.f, 1.f, 1.f, 1.f}, c1 = c0, s0 = {0.f, 0.f, 0.f, 0.f}, s1 = s0;
                if (wc == 0) { const float* rp = rope + (size_t)(row & 4095) * 32 + 8 * (fq & 1);
                    c0 = *(const f32x4*)rp; c1 = *(const f32x4*)(rp + 4); s0 = *(const f32x4*)(rp + 16); s1 = *(const f32x4*)(rp + 20);
                    if (fq < 2) { s0 = -s0; s1 = -s1; } }
#pragma unroll
                for (int bj = 0; bj < 2; ++bj) { const f32x4 p = *(const PG8_LAS f32x4*)(scr + ((ai * HALF + wr * 64 + m * 16 + fr) * 2 + bj) * 4);
                    const float sc = __builtin_amdgcn_rsqf(((p[0] + p[1]) + (p[2] + p[3])) * (1.0f / 128.0f) + RMS_EPS) * rs[ai][m];
                    f32x4 v0 = acc[ai][bj][m][0] * sc * g0, v1 = acc[ai][bj][m][1] * sc * g1;
                    if (wc == 0) { f32x4 p0, p1;
#pragma unroll
                        for (int j = 0; j < 4; ++j) { p0[j] = __shfl_xor(v0[j], 32); p1[j] = __shfl_xor(v1[j], 32); }
                        v0 = v0 * c0 + p0 * s0; v1 = v1 * c1 + p1 * s1; }
                    *(u32x4*)(dst + off + bj * HALF) = pack8_bf16(v0, v1); } }
    }
};
}
namespace att {
typedef unsigned short bf16;
typedef short bf16x8 __attribute__((ext_vector_type(8)));
typedef short s16x4 __attribute__((ext_vector_type(4)));
typedef float f32x16 __attribute__((ext_vector_type(16)));
typedef float f32x4 __attribute__((ext_vector_type(4)));
typedef unsigned u32x4 __attribute__((ext_vector_type(4)));
constexpr int D = 128, NW = 8, QBLK = 32, KVBLK = 64, QB = NW * QBLK;
constexpr int SHM_V = KVBLK * D * 2, SHM_K = KVBLK * D * 2;
constexpr int LDS_BYTES = 2 * SHM_V + 2 * SHM_K + NW * 64 * 4;
constexpr float SCALE = 0.08838834764831845f;
constexpr float THR = 8.f;
constexpr int W = 129;
constexpr bool SK = true;

#define KSWZ(row, colB) ((row) * 256 + ((colB) ^ (((row) & 7) << 4)))
#define SBAR() __builtin_amdgcn_sched_barrier(0)
__device__ __forceinline__ int v_st(int k, int c) { const int kk = (k & ~0xC) | ((k & 4) << 1) | ((k & 8) >> 1); return ((kk >> 3) * 4 + (c >> 5)) * 512 + ((kk & 7) * 32 + (c & 31)) * 2; }
__device__ __forceinline__ int v_rd_base(int lane) { return ((lane & 3) << 3) | (((lane >> 2) & 3) << 6) | (((lane >> 4) & 1) << 5) | (((lane >> 5) & 1) << 8); }
constexpr int v_rd_off(int d0, int ks, int half) { return d0 * 512 + ks * 4096 + half * 2048; }
__device__ __forceinline__ int crow(int r, int hi) { return (r & 3) + 8 * (r >> 2) + 4 * hi; }
__device__ __forceinline__ unsigned cvtpk(float lo, float hi) { unsigned r; asm volatile("v_cvt_pk_bf16_f32 %0, %1, %2" : "=v"(r) : "v"(lo), "v"(hi)); return r; }
__device__ __forceinline__ bf16x8 ld8(const bf16* p) { return *reinterpret_cast<const bf16x8*>(p); }
__device__ __forceinline__ bf16x8 ld8g(const char* ubase, unsigned voff) { return *reinterpret_cast<const bf16x8*>(ubase + voff); }
__device__ __forceinline__ void mask_tile(f32x16& p0, f32x16& p1, int dq, unsigned Wu) {
    const float NEG = -__builtin_inff();
#pragma unroll
    for (int r = 0; r < 16; ++r) {
        const int c = (r & 3) + 8 * (r >> 2);
        if ((unsigned)(dq - c) >= Wu) p0[r] = NEG;
        if ((unsigned)(dq - c - 32) >= Wu) p1[r] = NEG;
    }
}
__device__ __forceinline__ void partialSM(f32x16& p0, f32x16& p1, float& m_reg, float& mn, float& alpha) {
    float pmax = p0[0];
#pragma unroll
    for (int r = 1; r < 16; ++r) pmax = fmaxf(pmax, p0[r]);
#pragma unroll
    for (int r = 0; r < 16; ++r) pmax = fmaxf(pmax, p1[r]);
    { auto rr = __builtin_amdgcn_permlane32_swap(__float_as_uint(pmax), __float_as_uint(pmax), false, false);
      pmax = fmaxf(__uint_as_float(rr[0]), __uint_as_float(rr[1])); }
    constexpr float C2 = 1.4426950408889634f * SCALE;
    if (__builtin_expect(__all((pmax - m_reg) * SCALE <= THR), 1)) { mn = m_reg; alpha = 1.f; }
    else { mn = fmaxf(m_reg, pmax); alpha = __builtin_amdgcn_exp2f((m_reg - mn) * C2); m_reg = mn; }
    const float mnL = -mn * C2;
#pragma unroll
    for (int r = 0; r < 16; ++r) p0[r] = fmaf(p0[r], C2, mnL);
#pragma unroll
    for (int r = 0; r < 16; ++r) p1[r] = fmaf(p1[r], C2, mnL);
#pragma unroll
    for (int r = 0; r < 16; ++r) p0[r] = __builtin_amdgcn_exp2f(p0[r]);
}
__device__ __forceinline__ void finishSM(f32x16& p0, f32x16& p1, float alpha, float& l_reg, bf16x8& pa0, bf16x8& pa1, bf16x8& pa2, bf16x8& pa3) {
#pragma unroll
    for (int r = 0; r < 16; ++r) p1[r] = __builtin_amdgcn_exp2f(p1[r]);
    float ps = 0;
#pragma unroll
    for (int r = 0; r < 16; ++r) ps += p0[r];
#pragma unroll
    for (int r = 0; r < 16; ++r) ps += p1[r];
    { auto rr = __builtin_amdgcn_permlane32_swap(__float_as_uint(ps), __float_as_uint(ps), false, false);
      ps = __uint_as_float(rr[0]) + __uint_as_float(rr[1]); }
    l_reg = l_reg * alpha + ps;
#define PK4(P, B_, OUT) do { unsigned a0 = cvtpk(P[B_+0], P[B_+1]), a1 = cvtpk(P[B_+2], P[B_+3]);                          \
        unsigned b0 = cvtpk(P[B_+4], P[B_+5]), b1 = cvtpk(P[B_+6], P[B_+7]);                                             \
        auto r0 = __builtin_amdgcn_permlane32_swap(a0, b0, false, false); auto r1 = __builtin_amdgcn_permlane32_swap(a1, b1, false, false); \
        u32x4 w = {r0[0], r1[0], r0[1], r1[1]}; OUT = *reinterpret_cast<bf16x8*>(&w); } while (0)
    PK4(p0, 0, pa0); PK4(p0, 8, pa1); PK4(p1, 0, pa2); PK4(p1, 8, pa3);
#undef PK4
}
template <int KB>
__device__ __forceinline__ void qkt(f32x16& p0, f32x16& p1, const char* K_lds, int r32, int hi, const bf16x8* qr, bool act) {
    if (SK && !act) { const float NEG = -__builtin_inff();
#pragma unroll
        for (int r = 0; r < 16; ++r) { p0[r] = NEG; p1[r] = NEG; } return; }
    p0 = f32x16{}; p1 = f32x16{};
    const char* kb[4];
#pragma unroll
    for (int dd = 0; dd < 4; ++dd) kb[dd] = K_lds + KB * SHM_K + KSWZ(r32, (dd * 16 + hi * 8) * 2);
#pragma unroll
    for (int d0 = 0; d0 < 8; ++d0) { const char* a = kb[d0 & 3] + (d0 >> 2) * 128;
        bf16x8 b0 = *reinterpret_cast<const bf16x8*>(a);
        bf16x8 b1 = *reinterpret_cast<const bf16x8*>(a + 32 * 256);
        p0 = __builtin_amdgcn_mfma_f32_32x32x16_bf16(b0, qr[d0], p0, 0, 0, 0);
        p1 = __builtin_amdgcn_mfma_f32_32x32x16_bf16(b1, qr[d0], p1, 0, 0, 0); }
}
template <int VB>
__device__ __forceinline__ void pv_tile(f32x16* o, int vb0, bf16x8 pa0, bf16x8 pa1, bf16x8 pa2, bf16x8 pa3, bool act) {
    if (SK && !act) return;
#define TRRD(dst, off) asm volatile("ds_read_b64_tr_b16 %0, %1 offset:%2" : "=&v"(dst) : "v"(vb0), "i"(off) : "memory")
#define PV_D0(d0) do { s16x4 l0, l1, l2, l3, h0, h1, h2, h3; constexpr int b_ = VB * SHM_V + v_rd_off(d0, 0, 0);   \
        TRRD(l0, b_); TRRD(h0, b_ + 2048); TRRD(l1, b_ + 4096); TRRD(h1, b_ + 6144); TRRD(l2, b_ + 8192); TRRD(h2, b_ + 10240); TRRD(l3, b_ + 12288); TRRD(h3, b_ + 14336); \
        asm volatile("s_waitcnt lgkmcnt(0)" ::: "memory"); SBAR();   \
        o[d0] = __builtin_amdgcn_mfma_f32_32x32x16_bf16(pa0, (bf16x8){l0[0], l0[1], l0[2], l0[3], h0[0], h0[1], h0[2], h0[3]}, o[d0], 0, 0, 0);   \
        o[d0] = __builtin_amdgcn_mfma_f32_32x32x16_bf16(pa1, (bf16x8){l1[0], l1[1], l1[2], l1[3], h1[0], h1[1], h1[2], h1[3]}, o[d0], 0, 0, 0);   \
        o[d0] = __builtin_amdgcn_mfma_f32_32x32x16_bf16(pa2, (bf16x8){l2[0], l2[1], l2[2], l2[3], h2[0], h2[1], h2[2], h2[3]}, o[d0], 0, 0, 0);   \
        o[d0] = __builtin_amdgcn_mfma_f32_32x32x16_bf16(pa3, (bf16x8){l3[0], l3[1], l3[2], l3[3], h3[0], h3[1], h3[2], h3[3]}, o[d0], 0, 0, 0); } while (0)
    PV_D0(0); PV_D0(1); PV_D0(2); PV_D0(3);
#undef PV_D0
#undef TRRD
}

struct BlockRef { const bf16* Q; const bf16* K; const bf16* V; bf16* O; float* LSE; int P0; };
struct Seam { bf16x8 qr[8]; bf16x8 st_v0, st_v1, st_k0, st_k1; };
__device__ __forceinline__ int swa_jlo(int P0) { const int lowk = P0 - W + 1; return lowk > 0 ? lowk / KVBLK : 0; }
#define VMW() asm volatile("s_waitcnt vmcnt(0)" ::: "memory")
#define VMWN(n) asm volatile("s_waitcnt vmcnt(%0)" :: "i"(n) : "memory")
#define SLOAD_H(Kp, Vp, k0, pitch) do { const char* kb_ = (const char*)(Kp) + (size_t)(k0) * (size_t)((pitch) * 2); const char* vb_ = (const char*)(Vp) + (size_t)(k0) * (size_t)((pitch) * 2); \
        S.st_v0 = ld8g(vb_, rowoff); S.st_v1 = ld8g(vb_ + 32 * (pitch) * 2, rowoff); S.st_k0 = ld8g(kb_, rowoff); S.st_k1 = ld8g(kb_ + 32 * (pitch) * 2, rowoff); } while (0)
#define SWRITE_HK(bf) do { *(bf16x8*)(K_lds + (bf) * SHM_K + kws) = S.st_k0; *(bf16x8*)(K_lds + (bf) * SHM_K + kws + 32 * 256) = S.st_k1; } while (0)
#define SWRITE_HV(bf) do { *(bf16x8*)(V_lds + (bf) * SHM_V + vst0) = S.st_v0; *(bf16x8*)(V_lds + (bf) * SHM_V + vst1) = S.st_v1; } while (0)
#define SWRITE_H(bf) do { SWRITE_HV(bf); SWRITE_HK(bf); } while (0)
template <int DIL> __device__ __forceinline__ void swa_prime(const BlockRef& cur, char* lds, Seam& S) {
    constexpr int PITCH = DIL * 6144;
    int tid_ = threadIdx.x; asm volatile("" : "+v"(tid_));
    const int tid = tid_, wid = __builtin_amdgcn_readfirstlane(tid >> 6), lane = tid & 63, r32 = lane & 31, hi = lane >> 5;
    const int sr = tid >> 4, sc = (tid & 15) * 8, kws = KSWZ(sr, sc * 2); char* K_lds = lds + 2 * SHM_V;
    const unsigned rowoff = (unsigned)(sr * PITCH + sc) * 2u, qoff = (unsigned)((wid * QBLK + r32) * PITCH + hi * 8) * 2u;
    const int kb0 = swa_jlo(cur.P0) * KVBLK;
#pragma unroll
    for (int d0 = 0; d0 < 8; ++d0) S.qr[d0] = ld8g((const char*)cur.Q + d0 * 32, qoff);
    SLOAD_H(cur.K, cur.V, kb0, PITCH); VMW(); SWRITE_HK(0);
    __syncthreads();
}
template <int DIL> __device__ __forceinline__ void swa_block(const BlockRef& cur, const BlockRef& nxt, char* lds, Seam& S) {
    constexpr int PITCH = DIL * 6144, LPITCH = DIL * 48, SKV = 4096 / DIL;
    int tid_ = threadIdx.x; asm volatile("" : "+v"(tid_));
    const int tid = tid_, wid = __builtin_amdgcn_readfirstlane(tid >> 6), lane = tid & 63, r32 = lane & 31, hi = lane >> 5;
    const int j_lo = swa_jlo(cur.P0);
    int j_hi = (cur.P0 + QB - 1) / KVBLK + 1; if (j_hi > SKV / KVBLK) j_hi = SKV / KVBLK;
    const int NT = j_hi - j_lo;
    const int kbn = swa_jlo(nxt.P0) * KVBLK;
    const int qlo = cur.P0 + wid * QBLK, qm = qlo + r32 - 4 * hi;
    char* V_lds = lds; char* K_lds = lds + 2 * SHM_V;
    float* ws = (float*)(lds + 2 * SHM_V + 2 * SHM_K) + wid * 64; float* li_l = ws, * al_l = ws + 32;
    float m_reg = -1e30f, l_reg = 0; f32x16 o[4] = {};
    const int sr = tid >> 4, sc = (tid & 15) * 8, vst0 = v_st(sr, sc), vst1 = v_st(32 + sr, sc), kws = KSWZ(sr, sc * 2);
    const unsigned rowoff = (unsigned)(sr * PITCH + sc) * 2u, qoff = (unsigned)((wid * QBLK + r32) * PITCH + hi * 8) * 2u;
    const int vb0 = (int)(uintptr_t)V_lds + v_rd_base(lane);
    const bf16* Kh = cur.K; const bf16* Vh = cur.V; constexpr int pitch = PITCH;
#define RESC(a) do { if (__any((a) < 1.f)) { if (hi == 0) al_l[r32] = (a); asm volatile("s_waitcnt lgkmcnt(0)" ::: "memory");              \
                     for (int d_ = 0; d_ < 4; ++d_) for (int r = 0; r < 16; ++r) o[d_][r] *= al_l[crow(r, hi)]; } } while (0)
#define KBASE(t) ((j_lo + (t)) * KVBLK)
#define ACT(t) (KBASE(t) <= qlo + QBLK - 1 && KBASE(t) + KVBLK - 1 >= qlo - W + 1)
#define MASKT(P0_, P1_, t) do { const int kb_ = KBASE(t); if ((!SK || ACT(t)) && (kb_ + KVBLK - 1 > qlo || kb_ <= qlo + QBLK - 1 - W)) mask_tile(P0_, P1_, qm - kb_, (unsigned)W); } while (0)
#define SEAM_K0() do { VMWN(8); SWRITE_HK(0); SBAR(); } while (0)
    f32x16 pA0, pA1, pB0, pB1; float mnA, mnB, alA, alB; bf16x8 pa0, pa1, pa2, pa3;
    SWRITE_HV(0); SBAR();
    if (NT > 1) { SLOAD_H(Kh, Vh, KBASE(1), pitch); }
    SBAR(); qkt<0>(pA0, pA1, K_lds, r32, hi, S.qr, ACT(0));
    MASKT(pA0, pA1, 0); partialSM(pA0, pA1, m_reg, mnA, alA);
    if (NT > 1) { VMW(); SWRITE_H(1); }
    __syncthreads();
#define HALF_STEP(PX0, PX1, mnX, alX, PY0, PY1, alY, t, KB, VB, SB) do {                                                      \
        SBAR(); qkt<KB>(PX0, PX1, K_lds, r32, hi, S.qr, ACT(t));                                             \
        finishSM(PY0, PY1, alY, l_reg, pa0, pa1, pa2, pa3); SBAR();                                                           \
        if ((t) + 1 < NT) { SLOAD_H(Kh, Vh, KBASE((t) + 1), pitch); SBAR(); }                                               \
        pv_tile<VB>(o, vb0, pa0, pa1, pa2, pa3, ACT((t) - 1)); MASKT(PX0, PX1, (t)); partialSM(PX0, PX1, m_reg, mnX, alX);                                        \
        __syncthreads();                                                                                                      \
        if ((t) + 1 < NT) { VMW(); SWRITE_H(SB); }                                                                          \
        RESC(alX); __syncthreads(); } while (0)
    for (int t = 1; t + 1 < NT; t += 2) {
        HALF_STEP(pB0, pB1, mnB, alB, pA0, pA1, alA, t, 1, 0, 0);
        HALF_STEP(pA0, pA1, mnA, alA, pB0, pB1, alB, t + 1, 0, 1, 1);
    }
    const bool even = (NT & 1) == 0;
    if (even) { SBAR(); qkt<1>(pB0, pB1, K_lds, r32, hi, S.qr, ACT(NT - 1)); SBAR(); }
    SLOAD_H(nxt.K, nxt.V, kbn, PITCH); SBAR();
#pragma unroll
    for (int d0 = 0; d0 < 8; ++d0) S.qr[d0] = ld8g((const char*)nxt.Q + d0 * 32, qoff);
    SBAR();
    finishSM(pA0, pA1, alA, l_reg, pa0, pa1, pa2, pa3); SBAR();
    pv_tile<0>(o, vb0, pa0, pa1, pa2, pa3, ACT(even ? NT - 2 : NT - 1));
    if (even) { MASKT(pB0, pB1, NT - 1); partialSM(pB0, pB1, m_reg, mnB, alB); __syncthreads(); RESC(alB);
        finishSM(pB0, pB1, alB, l_reg, pa0, pa1, pa2, pa3); SBAR(); pv_tile<1>(o, vb0, pa0, pa1, pa2, pa3, ACT(NT - 1)); }
    SBAR(); SEAM_K0();
    if (hi == 0) li_l[r32] = l_reg; asm volatile("s_waitcnt lgkmcnt(0)" ::: "memory");
    float rli[16];
#pragma unroll
    for (int r = 0; r < 16; ++r) rli[r] = __builtin_amdgcn_rcpf(li_l[crow(r, hi)]);
    { char* Ob = (char*)cur.O + (size_t)(wid * QBLK) * (size_t)(PITCH * 2); const unsigned ooff = (unsigned)(4 * hi * PITCH + r32) * 2u;
#pragma unroll
      for (int r = 0; r < 16; ++r) { char* Or = Ob + (size_t)((r & 3) + 8 * (r >> 2)) * (size_t)(PITCH * 2);
#pragma unroll
        for (int d0 = 0; d0 < 4; ++d0) { const float v = o[d0][r] * rli[r];
            const float vn = __shfl_xor(v, 1);
            if ((r32 & 1) == 0) *(unsigned*)(Or + d0 * 64 + ooff) = cvtpk(v, vn); } } }
    if (hi == 0) cur.LSE[(size_t)(wid * QBLK + r32) * (size_t)LPITCH] = m_reg * SCALE + __builtin_amdgcn_logf(l_reg) * 0.6931471805599453f;
    __syncthreads();
#undef RESC
#undef KBASE
#undef ACT
#undef MASKT
#undef SEAM_K0
#undef HALF_STEP
}
#undef VMW
#undef VMWN
#undef SLOAD_H
#undef SWRITE_HK
#undef SWRITE_HV
#undef SWRITE_H
#undef KSWZ
#undef SBAR

template <int DIL> __device__ __forceinline__ BlockRef make_ref(int idx, bf16* Q, const bf16* K, const bf16* V, float* LSE) {
    constexpr int GI = DIL == 1 ? 0 : (DIL == 4 ? 1 : 2), NQB = 16 / DIL, PITCH = DIL * 6144;
    const int j = idx & 15, h = (idx >> 4) & 15, b = idx >> 8, r = j / NQB, qb = j - r * NQB;
    const size_t base = (size_t)(b * 4096 + r) * 6144 + GI * 2048 + h * 128;
    BlockRef R; R.P0 = qb * QB;
    R.K = K + base; R.V = V + base; R.Q = Q + base + (size_t)R.P0 * (size_t)PITCH; R.O = Q + base + (size_t)R.P0 * (size_t)PITCH;
    R.LSE = LSE + (size_t)(b * 4096 + r + R.P0 * DIL) * 48 + GI * 16 + h;
    return R;
}
template <int DIL> __device__ __forceinline__ void attn_group(char* lds, bf16* Q, const bf16* K, const bf16* V, float* LSE) {
    const int total = 1024, stride = gridDim.x; int L = blockIdx.x; if (L >= total) return;
    BlockRef cur = make_ref<DIL>(L, Q, K, V, LSE); Seam S;
    swa_prime<DIL>(cur, lds, S);
    for (;;) {
        const int Ln = L + stride; const bool last = Ln >= total;
        const BlockRef nxt = last ? cur : make_ref<DIL>(Ln, Q, K, V, LSE);
        swa_block<DIL>(cur, nxt, lds, S);
        if (last) break;
        cur = nxt; L = Ln;
    }
}
__device__ __forceinline__ void attn_phase(char* lds, bf16* Q, const bf16* K, const bf16* V, float* LSE) {
#ifndef ATT_ONLY
    attn_group<1>(lds, Q, K, V, LSE);
    attn_group<4>(lds, Q, K, V, LSE);
    attn_group<16>(lds, Q, K, V, LSE);
#else
    attn_group<ATT_ONLY>(lds, Q, K, V, LSE);
#endif
}
}
constexpr int BATCH = 4, SEQ = 4096, DM = 2048, MROWS = BATCH * SEQ, FFH = 5632, NHEAD = 16, HDIM = 128;
constexpr int NWAVES = 8;
constexpr size_t MiB = 1u << 20;
constexpr size_t WS_CTL = 0, WS_SS = 1 * MiB, CTL_ZERO_BYTES = 2 * MiB;
constexpr size_t WS_LBS = 2 * MiB, WS_ROPE = 2 * MiB + 65536;
constexpr size_t WS_W = 4 * MiB;
constexpr size_t WS_WA_IN = WS_W, WS_WA_OUT = WS_W + 64 * MiB, WS_WF_IN = WS_W + 80 * MiB, WS_WF_OUT = WS_W + 256 * MiB,
                 WS_WQKV2 = WS_W + 344 * MiB, WS_WQ3 = WS_W + 416 * MiB, WS_WB_OUT = WS_W + 440 * MiB;
constexpr size_t WS_XB = 460 * MiB;
constexpr size_t WS_R1 = 524 * MiB;
constexpr size_t WS_R2 = 908 * MiB;
constexpr size_t WS_END = 1168 * MiB;
constexpr int CW_BAR = 1024;
constexpr int RING_BYTES = 131072, SCR_OFF = 131072, MISC_OFF = 131072 + 8192, LDS_BYTES = 147456;
static_assert(SCR_OFF == pg8::QKV_SCR_OFF, "LDS map");

#define GAS __attribute__((address_space(1)))
#define LAS __attribute__((address_space(3)))
typedef unsigned short bf16;
typedef unsigned v4u __attribute__((ext_vector_type(4)));
typedef unsigned v2u __attribute__((ext_vector_type(2)));
typedef float f32x4 __attribute__((ext_vector_type(4)));
#define LDS_WAIT() asm volatile("s_waitcnt lgkmcnt(0)" ::: "memory")
__device__ __forceinline__ unsigned f2bf(float f) { unsigned u = __builtin_bit_cast(unsigned, f); return (u + 0x7fffu + ((u >> 16) & 1u)) >> 16; }
__device__ __forceinline__ unsigned pk2(float lo, float hi) { return f2bf(lo) | (f2bf(hi) << 16); }
__device__ __forceinline__ float bflo(unsigned w) { return __builtin_bit_cast(float, w << 16); }
__device__ __forceinline__ float bfhi(unsigned w) { return __builtin_bit_cast(float, w & 0xffff0000u); }

#define XB_TMO      128
#define XB_XCNT(j)  (256  + 64 * (j))
#define XB_XSUB(j)  (1280 + 64 * (j))
#define XB_XGEN(j)  (2304 + 64 * (j))
#define XB_TOP      3328
#define XB_TOPGEN   3392
#define XCD_BAR_WORDS 3456
#define XB_SPIN_CAP (1u << 18)

__device__ __forceinline__ unsigned xb_ld(unsigned* p)              { return __hip_atomic_load(p, __ATOMIC_RELAXED, __HIP_MEMORY_SCOPE_AGENT); }
__device__ __forceinline__ unsigned xb_add(unsigned* p, unsigned v) { return __hip_atomic_fetch_add(p, v, __ATOMIC_RELAXED, __HIP_MEMORY_SCOPE_AGENT); }
__device__ __forceinline__ unsigned xb_xcc_id() { return (unsigned)__builtin_amdgcn_s_getreg((3 << 11) | 20) & 0xFu; }
#define XB_SPIN(cond, bar) do { unsigned _sp = 0; while (cond) { __builtin_amdgcn_s_sleep(1); \
    if ((++_sp & 255u) == 0u) { if (xb_ld(&(bar)[XB_TMO])) break; if (_sp > XB_SPIN_CAP) { atomicAdd(&(bar)[XB_TMO], 1u); break; } } } } while (0)

struct XcdBarrier {
    unsigned* bar; unsigned x;
    volatile LAS unsigned* st;
};

__device__ __forceinline__ XcdBarrier xcd_barrier_post(unsigned* bar, volatile LAS unsigned* st) {
    XcdBarrier b; b.bar = bar; b.x = xb_xcc_id(); b.st = st;
    if (threadIdx.x == 0) (void)xb_add(&bar[XB_XCNT(b.x)], 1u);
    return b;
}
__device__ __forceinline__ void xcd_barrier_complete(unsigned* bar, unsigned x, unsigned& nloc, unsigned& nx) {
    const unsigned G = gridDim.x * gridDim.y * gridDim.z;
    unsigned sum, cnt, mine, sp = 0u;
    for (;;) {
        sum = 0u; cnt = 0u; mine = 0u;
#pragma unroll
        for (unsigned j = 0; j < 16; ++j) { const unsigned c = xb_ld(&bar[XB_XCNT(j)]); sum += c; cnt += (c > 0u) ? 1u : 0u; mine = (j == x) ? c : mine; }
        if (sum == G) break;
        __builtin_amdgcn_s_sleep(1);
        if ((++sp & 255u) == 0u) { if (xb_ld(&bar[XB_TMO])) break; if (sp > XB_SPIN_CAP) { atomicAdd(&bar[XB_TMO], 1u); break; } }
    }
    nloc = mine > 0u ? mine : 1u; nx = cnt > 0u ? cnt : 1u;
}

__device__ __forceinline__ void xcd_barrier(const XcdBarrier& b) {
    asm volatile("s_waitcnt vmcnt(0)" ::: "memory");
    __syncthreads();
    if (threadIdx.x == 0) {
        unsigned* bar = b.bar;
        __builtin_amdgcn_s_waitcnt(0);
        unsigned nloc = b.st[0], nx = b.st[1];
        if (nloc == 0u) { xcd_barrier_complete(bar, b.x, nloc, nx); b.st[0] = nloc; b.st[1] = nx; }
        const unsigned old = xb_add(&bar[XB_XSUB(b.x)], 1u);
        const unsigned gen = old / nloc;
        if (old + 1u == (gen + 1u) * nloc) {
            __builtin_amdgcn_fence(__ATOMIC_RELEASE, "agent");
            asm volatile("s_waitcnt vmcnt(0)" ::: "memory");
            const unsigned og = xb_add(&bar[XB_TOP], 1u);
            const unsigned tg = og / nx;
            if (og + 1u == (tg + 1u) * nx) xb_add(&bar[XB_TOPGEN], 1u);
            else XB_SPIN(xb_ld(&bar[XB_TOPGEN]) == tg, bar);
            __builtin_amdgcn_fence(__ATOMIC_ACQUIRE, "agent");
            xb_add(&bar[XB_XGEN(b.x)], 1u);
            asm volatile("s_waitcnt vmcnt(0)" ::: "memory");
        } else {
            XB_SPIN(xb_ld(&bar[XB_XGEN(b.x)]) == gen, bar);
            __builtin_amdgcn_fence(__ATOMIC_ACQUIRE, "agent");
            asm volatile("s_waitcnt vmcnt(0)" ::: "memory");
        }
    }
    __syncthreads();
}


__device__ __forceinline__ float wave_sum(float v) {
#pragma unroll
    for (int o = 1; o < 64; o <<= 1) v += __shfl_xor(v, o);
    return v;
}
__device__ __forceinline__ void conv_item(const float* W, int ldw, int K, const float* gain, bf16* WT, int k0, int n0, int nd0, LAS float* scr, int lane) {
#pragma unroll 8
    for (int i = 0; i < 32; ++i) { const int kk = 2 * i + (lane >> 5); float w = W[(size_t)(k0 + kk) * ldw + n0 + (lane & 31)]; if (gain) w *= gain[k0 + kk]; scr[kk * 33 + (lane & 31)] = w; }
    LDS_WAIT(); asm volatile("" ::: "memory");
    const int c = lane & 7;
#pragma unroll
    for (int j = 0; j < 4; ++j) { const int n = (lane >> 3) + 8 * j; const LAS float* s = scr + (8 * c) * 33 + n;
        v4u o; o.x = pk2(s[0 * 33], s[1 * 33]); o.y = pk2(s[2 * 33], s[3 * 33]); o.z = pk2(s[4 * 33], s[5 * 33]); o.w = pk2(s[6 * 33], s[7 * 33]);
        *(GAS v4u*)(WT + (size_t)(nd0 + n) * K + k0 + 8 * c) = o; }
    LDS_WAIT(); asm volatile("" ::: "memory");
}

struct Args { const float* in[16]; float* out; unsigned char* ws; };

__device__ __forceinline__ void prologue(const Args& a, LAS unsigned char* lds, int gw, int NGW, int lane, int wave) {
    unsigned char* ws = a.ws;
    { float* lbs = (float*)(ws + WS_LBS); const float* alb = a.in[5];
      for (int i = gw * 64 + lane; i < DM; i += NGW * 64) { const float a0 = alb[i], a1 = alb[DM + i]; float s1 = 1.0f / (1.0f + expf(a0 - a1)); s1 = fminf(fmaxf(s1, 0.0f), 1.0f - 1e-6f); lbs[i] = 0.0f; lbs[DM + i] = s1; } }
    { float* rope = (float*)(ws + WS_ROPE);
      for (int i = gw * 64 + lane; i < SEQ * 16; i += NGW * 64) { const int pos = i >> 4, j = i & 15; double inv = 1.0;
          for (int q = 0; q < j; ++q) inv *= 0.4403666026717805;
          const double ang = (double)pos * inv, nrev = __builtin_rint(ang * 0.15915494309189535);
          const double r = (ang - nrev * 6.283185307179586) - nrev * 2.4492935982947064e-16, r2 = r * r;
          double ts = r, sn = r, tc = 1.0, cs = 1.0;
          for (int q = 1; q <= 14; ++q) { tc *= -r2 / (double)((2 * q - 1) * (2 * q)); cs += tc; ts *= -r2 / (double)((2 * q) * (2 * q + 1)); sn += ts; }
          rope[pos * 32 + j] = (float)cs; rope[pos * 32 + 16 + j] = (float)sn; } }
    { const float* x = a.in[0]; bf16* xb = (bf16*)(ws + WS_XB); float* ss0 = (float*)(ws + WS_SS);
      for (int m = gw; m < MROWS; m += NGW) { const GAS f32x4* xr = (const GAS f32x4*)(x + (size_t)m * DM) + lane; GAS v2u* o8 = (GAS v2u*)(xb + (size_t)m * DM) + lane; float s = 0.f;
#pragma unroll
          for (int j = 0; j < 8; ++j) { const f32x4 v = xr[64 * j]; s += (v.x * v.x + v.y * v.y) + (v.z * v.z + v.w * v.w); v2u w; w.x = pk2(v.x, v.y); w.y = pk2(v.z, v.w); o8[64 * j] = w; }
          s = wave_sum(s); if (lane == 0) ss0[m] = s; } }
    LAS float* scr = (LAS float*)(lds + wave * 16384);
    for (int job = 0; job < 17; ++job) {
        const float* W; const float* gain = nullptr; bf16* dst; int K = DM, N, mode = 0, rowoff = 0;
        if (job < 2)       { W = a.in[2] + (size_t)job * DM * 8192; N = 8192; gain = a.in[1] + job * DM; dst = (bf16*)(ws + WS_WA_IN) + (size_t)job * 8192 * DM; }
        else if (job < 4)  { const int l = job - 2; W = a.in[4] + (size_t)l * DM * DM; N = DM; dst = (bf16*)(ws + WS_WA_OUT) + (size_t)l * DM * DM; }
        else if (job < 8)  { const int l = job - 4; W = a.in[14] + (size_t)l * DM * 2 * FFH; N = 2 * FFH; gain = a.in[13] + l * DM; dst = (bf16*)(ws + WS_WF_IN) + (size_t)l * 2 * FFH * DM; mode = 1; }
        else if (job < 12) { const int l = job - 8; W = a.in[15] + (size_t)l * FFH * DM; K = FFH; N = DM; dst = (bf16*)(ws + WS_WF_OUT) + (size_t)l * DM * FFH; }
        else if (job == 12) { W = a.in[10]; N = 6144; gain = a.in[9]; dst = (bf16*)(ws + WS_WQKV2); }
        else if (job == 13) { W = a.in[7]; N = 12288; gain = a.in[6]; dst = (bf16*)(ws + WS_WQKV2); rowoff = 6144; }
        else if (job == 14) { W = a.in[10] + (size_t)DM * 6144; N = 6144; gain = a.in[9] + DM; dst = (bf16*)(ws + WS_WQ3); }
        else { const int l = job - 15; W = a.in[12] + (size_t)l * DM * DM; N = DM; dst = (bf16*)(ws + WS_WB_OUT) + (size_t)l * DM * DM; }
        const int nblk = N / 32, nitems = (K / 64) * nblk;
        for (int it = gw; it < nitems; it += NGW) { const int kb = it / nblk, nb = it - kb * nblk, n0 = 32 * nb; int nd0 = n0 + rowoff;
            if (mode == 1) { const int up = n0 >= FFH, jn = up ? n0 - FFH : n0; nd0 = 256 * (jn >> 7) + 128 * up + (jn & 127); }
            conv_item(W, N, K, gain, dst, 64 * kb, n0, nd0, scr, lane); }
    }
}

__device__ __forceinline__ void hgrn_naive(LAS unsigned char* lds, int bh, const bf16* Qb, const bf16* Kb, bf16* Vb, const float* LOGF, const bf16* SGb, const float* ogain) {
    int tid_ = threadIdx.x; asm volatile("" : "+v"(tid_));
    const int tid = tid_, b = bh >> 4, h = bh & 15, v = tid & 127, kg = tid >> 7;
    LAS float* Lf = (LAS float*)lds; LAS float* Lk = Lf + 2048; LAS float* Lq = Lk + 2048; LAS float* Lv = Lq + 2048; LAS float* Lp = Lv + 2048;
    float S[32];
#pragma unroll
    for (int j = 0; j < 32; ++j) S[j] = 0.f;
    const int stok = tid >> 5, sch = (tid & 31) * 4;
    for (int t0 = 0; t0 < SEQ; t0 += 16) {
        { const size_t off = (size_t)(b * SEQ + t0 + stok) * DM + h * HDIM + sch;
          const f32x4 lf = *(const f32x4*)(LOGF + off); const v2u kq = *(const v2u*)(Kb + off), qq = *(const v2u*)(Qb + off), vq = *(const v2u*)(Vb + off);
          *(LAS f32x4*)(Lf + stok * 128 + sch) = (f32x4){__expf(lf.x), __expf(lf.y), __expf(lf.z), __expf(lf.w)};
          *(LAS f32x4*)(Lk + stok * 128 + sch) = (f32x4){bflo(kq.x), bfhi(kq.x), bflo(kq.y), bfhi(kq.y)};
          *(LAS f32x4*)(Lq + stok * 128 + sch) = (f32x4){bflo(qq.x), bfhi(qq.x), bflo(qq.y), bfhi(qq.y)};
          *(LAS f32x4*)(Lv + stok * 128 + sch) = (f32x4){bflo(vq.x), bfhi(vq.x), bflo(vq.y), bfhi(vq.y)}; }
        __syncthreads();
        for (int tok = 0; tok < 16; ++tok) { const float vv = Lv[tok * 128 + v]; float acc = 0.f;
#pragma unroll
            for (int j4 = 0; j4 < 8; ++j4) { const f32x4 f = *(const LAS f32x4*)(Lf + tok * 128 + kg * 32 + 4 * j4), kk = *(const LAS f32x4*)(Lk + tok * 128 + kg * 32 + 4 * j4), qq = *(const LAS f32x4*)(Lq + tok * 128 + kg * 32 + 4 * j4);
#pragma unroll
                for (int e = 0; e < 4; ++e) { S[4 * j4 + e] = f[e] * S[4 * j4 + e] + kk[e] * vv; acc += qq[e] * S[4 * j4 + e]; } }
            Lp[(tok * 4 + kg) * 128 + v] = acc; }
        __syncthreads();
        { f32x4 o = *(const LAS f32x4*)(Lp + (stok * 4 + 0) * 128 + sch);
#pragma unroll
          for (int g = 1; g < 4; ++g) o += *(const LAS f32x4*)(Lp + (stok * 4 + g) * 128 + sch);
          float s = (o.x * o.x + o.y * o.y) + (o.z * o.z + o.w * o.w);
#pragma unroll
          for (int d = 1; d < 32; d <<= 1) s += __shfl_xor(s, d);
          const float sc = 1.0f / sqrtf(s * (1.0f / HDIM) + 1e-6f);
          const size_t off = (size_t)(b * SEQ + t0 + stok) * DM + h * HDIM + sch;
          const f32x4 gn = *(const f32x4*)(ogain + sch); const v2u sg = *(const v2u*)(SGb + off);
          v2u w; w.x = pk2(o.x * sc * gn.x * bflo(sg.x), o.y * sc * gn.y * bfhi(sg.x)); w.y = pk2(o.z * sc * gn.z * bflo(sg.y), o.w * sc * gn.w * bfhi(sg.y));
          *(v2u*)(Vb + off) = w; }
        __syncthreads();
    }
}

__device__ __forceinline__ void combine_phase(const bf16* OG, const float* LSE, bf16* OC) {
    const size_t nitem = (size_t)MROWS * (DM / 8), stride = (size_t)gridDim.x * blockDim.x;
    for (size_t i = (size_t)blockIdx.x * blockDim.x + threadIdx.x; i < nitem; i += stride) {
        const size_t tok = i >> 8; const int c = (int)(i & 255) * 8, h = c >> 7;
        const float l0 = LSE[tok * 48 + h], l1 = LSE[tok * 48 + 16 + h], l2 = LSE[tok * 48 + 32 + h];
        const float mx = fmaxf(l0, fmaxf(l1, l2)); float w0 = __expf(l0 - mx), w1 = __expf(l1 - mx), w2 = __expf(l2 - mx); const float inv = 1.0f / (w0 + w1 + w2); w0 *= inv; w1 *= inv; w2 *= inv;
        const v4u a = *(const v4u*)(OG + tok * 6144 + c), bb = *(const v4u*)(OG + tok * 6144 + 2048 + c), cc = *(const v4u*)(OG + tok * 6144 + 4096 + c);
        v4u o;
#pragma unroll
        for (int e = 0; e < 4; ++e) o[e] = pk2(w0 * bflo(a[e]) + w1 * bflo(bb[e]) + w2 * bflo(cc[e]), w0 * bfhi(a[e]) + w1 * bfhi(bb[e]) + w2 * bfhi(cc[e]));
        *(v4u*)(OC + tok * DM + c) = o;
    }
}

#define GRID_BAR() xcd_barrier(bar)
template <int LAYER>
__device__ __forceinline__ void layer_phases(const Args& args, LAS unsigned char* lds, unsigned char* lds_raw, const XcdBarrier& bar) {
    unsigned char* ws = args.ws; const int G = gridDim.x;
    bf16* XB = (bf16*)(ws + WS_XB); float* SS = (float*)(ws + WS_SS); float* out = args.out;
    constexpr int ssi = 2 * LAYER;
    if constexpr (LAYER < 2) {
        bf16* Aq = (bf16*)(ws + WS_R1); bf16* Ak = Aq + (size_t)MROWS * DM; bf16* Av = Ak + (size_t)MROWS * DM; bf16* Asg = Av + (size_t)MROWS * DM; float* Alogf = (float*)(ws + WS_R1 + 256 * MiB);
#ifndef DIS_G1
        {
            pg8::Gemm g{XB, (const bf16*)(ws + WS_WA_IN) + (size_t)LAYER * 8192 * DM, MROWS, 8192, DM}; pg8::StaticOrder S; S.init(MROWS, 8192, G, (int)blockIdx.x);
            pg8::EpiHgrnIn E{Aq, Alogf, SS + (size_t)ssi * MROWS, (const float*)(ws + WS_LBS) + LAYER * DM};
            pg8::gemm_phase<pg8::EpiHgrnIn, pg8::StaticOrder, true, true>(lds, g, S, E);
        }
#endif
        GRID_BAR();
#ifndef DIS_HGRN
        for (int bh = blockIdx.x; bh < BATCH * NHEAD; bh += G) hgrn_naive(lds, bh, Aq, Ak, Av, Alogf, Asg, args.in[3] + LAYER * HDIM);
#endif
        GRID_BAR();
#ifndef DIS_G3
        {
            pg8::Gemm g{Av, (const bf16*)(ws + WS_WA_OUT) + (size_t)LAYER * DM * DM, MROWS, DM, DM}; pg8::StaticOrder S; S.init(MROWS, DM, G, (int)blockIdx.x);
            pg8::EpiRes E{LAYER == 0 ? args.in[0] : (const float*)out, out, XB, SS + (size_t)(ssi + 1) * MROWS};
            pg8::gemm_phase<pg8::EpiRes, pg8::StaticOrder, true, true>(lds, g, S, E);
        }
#endif
    } else {
        bf16* KB = (bf16*)(ws + WS_R1); bf16* VB = (bf16*)(ws + WS_R1 + 192 * MiB);
        bf16* QO = (bf16*)(ws + WS_R2); bf16* OC = (bf16*)(ws + WS_R2 + 192 * MiB); float* LSE = (float*)(ws + WS_R2 + 256 * MiB);
#ifndef DIS_G2
        {
            constexpr int N = LAYER == 2 ? 18432 : 6144;
            pg8::Gemm g{XB, LAYER == 2 ? (const bf16*)(ws + WS_WQKV2) : (const bf16*)(ws + WS_WQ3), MROWS, N, DM}; pg8::StaticOrder S; S.init(MROWS, N, G, (int)blockIdx.x);
            pg8::EpiQkv E{QO, KB, VB, SS + (size_t)ssi * MROWS, args.in[11] + (LAYER - 2) * 3 * HDIM, args.in[8], (const float*)(ws + WS_ROPE)};
            pg8::gemm_phase<pg8::EpiQkv, pg8::StaticOrder, true, true>(lds, g, S, E);
        }
#endif
        GRID_BAR();
#ifndef DIS_ATTN
        att::attn_phase((char*)lds_raw, QO, KB, VB, LSE);
#endif
        GRID_BAR();
#ifndef DIS_COMB
        combine_phase(QO, LSE, OC);
#endif
        GRID_BAR();
#ifndef DIS_G3
        {
            pg8::Gemm g{OC, (const bf16*)(ws + WS_WB_OUT) + (size_t)(LAYER - 2) * DM * DM, MROWS, DM, DM}; pg8::StaticOrder S; S.init(MROWS, DM, G, (int)blockIdx.x);
            pg8::EpiRes E{out, out, XB, SS + (size_t)(ssi + 1) * MROWS};
            pg8::gemm_phase<pg8::EpiRes, pg8::StaticOrder, true, true>(lds, g, S, E);
        }
#endif
    }
    GRID_BAR();
    bf16* HB = (bf16*)(ws + WS_R2);
#ifndef DIS_G4
    {
        pg8::Gemm g{XB, (const bf16*)(ws + WS_WF_IN) + (size_t)LAYER * 2 * FFH * DM, MROWS, 2 * FFH, DM}; pg8::StaticOrder S; S.init(MROWS, 2 * FFH, G, (int)blockIdx.x);
        pg8::EpiFfn1 E{HB, FFH, SS + (size_t)(ssi + 1) * MROWS};
        pg8::gemm_phase<pg8::EpiFfn1, pg8::StaticOrder, true, true>(lds, g, S, E);
    }
#endif
    GRID_BAR();
#ifndef DIS_G5
    {
        pg8::Gemm g{HB, (const bf16*)(ws + WS_WF_OUT) + (size_t)LAYER * DM * FFH, MROWS, DM, FFH}; pg8::StaticOrder S; S.init(MROWS, DM, G, (int)blockIdx.x);
        pg8::EpiRes E{out, out, XB, SS + (size_t)(ssi + 2) * MROWS};
        pg8::gemm_phase<pg8::EpiRes, pg8::StaticOrder, true, true>(lds, g, S, E);
    }
#endif
    if constexpr (LAYER < 3) GRID_BAR();
}

__global__ void __launch_bounds__(NWAVES * 64, 2) yoco_fwd(Args args) {
    extern __shared__ __attribute__((aligned(16))) unsigned char lds_raw[];
    LAS unsigned char* lds = (LAS unsigned char*)lds_raw;
    const int tid = threadIdx.x;
    volatile LAS unsigned* MISC = (volatile LAS unsigned*)(lds + MISC_OFF);
    if (tid < 64) MISC[tid] = 0u;
    __syncthreads();
    XcdBarrier bar = xcd_barrier_post((unsigned*)(args.ws + WS_CTL) + CW_BAR, MISC + 8);
#ifndef DIS_PRO
    { const int lane = tid & 63, wave = __builtin_amdgcn_readfirstlane(tid >> 6), G = gridDim.x;
      const int vcu = (G % 8 == 0) ? ((int)blockIdx.x % 8) * (G / 8) + (int)blockIdx.x / 8 : (int)blockIdx.x;
      prologue(args, lds, vcu * NWAVES + wave, G * NWAVES, lane, wave); }
#endif
    GRID_BAR();
#ifndef ONLY_LAYER
    layer_phases<0>(args, lds, lds_raw, bar);
    layer_phases<1>(args, lds, lds_raw, bar);
    layer_phases<2>(args, lds, lds_raw, bar);
    layer_phases<3>(args, lds, lds_raw, bar);
#else
    layer_phases<ONLY_LAYER>(args, lds, lds_raw, bar);
#endif
}

extern "C" void kernel_launch(void* const* d_in, const int* in_sizes, int n_in, void* d_out, int out_size, void* d_ws, size_t ws_size, hipStream_t stream) {
    static int grid = 0;
    if (grid == 0) {
        if (n_in != 16 || out_size != MROWS * DM || ws_size < WS_END) { fprintf(stderr, "kernel_launch: unexpected shapes (n_in %d out %d ws %zu)\n", n_in, out_size, ws_size); grid = -1; return; }
        int dev = 0, cus = 0, per_cu = 0;
        if (hipGetDevice(&dev) != hipSuccess || hipDeviceGetAttribute(&cus, hipDeviceAttributeMultiprocessorCount, dev) != hipSuccess) { grid = -1; return; }
        if (hipFuncSetAttribute((const void*)yoco_fwd, hipFuncAttributeMaxDynamicSharedMemorySize, LDS_BYTES) != hipSuccess) { fprintf(stderr, "kernel_launch: hipFuncSetAttribute failed\n"); grid = -1; return; }
        if (hipOccupancyMaxActiveBlocksPerMultiprocessor(&per_cu, (const void*)yoco_fwd, NWAVES * 64, LDS_BYTES) != hipSuccess || per_cu < 1) { fprintf(stderr, "kernel_launch: occupancy query says %d\n", per_cu); }
        (void)hipGetLastError();
        grid = cus;
    }
    if (grid < 0) return;
    (void)hipMemsetAsync((char*)d_ws + WS_CTL, 0, CTL_ZERO_BYTES, stream);
    Args a{};
    for (int i = 0; i < 16; ++i) a.in[i] = (const float*)d_in[i];
    a.out = (float*)d_out; a.ws = (unsigned char*)d_ws;
    hipLaunchKernelGGL(yoco_fwd, dim3(grid), dim3(NWAVES * 64), LDS_BYTES, stream, a);
}
```

```cpp
#include <hip/hip_runtime.h>
#include <cstdio>
#include <cstdint>
namespace pg8 {
#define PG8_LAS __attribute__((address_space(3)))
typedef unsigned short bf16_t;
typedef short bf16x8 __attribute__((ext_vector_type(8)));
typedef float f32x4 __attribute__((ext_vector_type(4)));
typedef unsigned u32x4 __attribute__((ext_vector_type(4)));
constexpr int BM = 256, BK = 64, HALF = 128, HTB = HALF * BK * 2  , STAGE_BYTES = 8 * HTB, NXCD = 8, WGM = 8;

__host__ __device__ __forceinline__ int lds_byte(int r, int c) { const int st = (r >> 4) * 2 + (c >> 5), rr = r & 15, cc = c & 31, ob = rr * 64 + cc * 2; return st * 1024 + (ob ^ (((ob >> 9) & 1) << 5)); }
__host__ __device__ __forceinline__ void stage_rc(int b, int& R, int& C) { const int st = b / 1024, sb = b % 1024, swz = sb ^ (((sb >> 9) & 1) << 5); R = (st >> 1) * 16 + swz / 64; C = (st & 1) * 32 + (swz % 64) / 2; }
__host__ __device__ __forceinline__ int perm32(int rho) { const int n = rho >> 4, i = rho & 15; return 8 * (i >> 2) + 4 * n + (i & 3); }

struct Unit { int pm, pn; };
struct Gemm { const bf16_t* A; const bf16_t* Bt; int M, N, K; };

struct StaticOrder {
    int nM, nN, nwg, G, c;
    __host__ __device__ void init(int M, int N, int G_, int c_) { nM = M / BM; nN = N / BM; nwg = nM * nN; G = G_; c = c_; }
    __host__ __device__ bool next(int i, Unit& u) const {
        const long L = (long)i * G + c; if (L >= nwg) return false;
        int wgid = (int)L; { const int q = nwg / NXCD, r = nwg % NXCD, xcd = wgid % NXCD, off = wgid / NXCD; wgid = (xcd < r ? xcd * (q + 1) : r * (q + 1) + (xcd - r) * q) + off; }
        const int nig = WGM * nN, gid = wgid / nig, fm = gid * WGM, gsz = (nM - fm) < WGM ? (nM - fm) : WGM;
        u.pm = fm + ((wgid % nig) % gsz); u.pn = (wgid % nig) / gsz; return true;
    }
    __device__ __forceinline__ void a_ready(const Unit&) const {}
    __device__ __forceinline__ void done(const Unit&) const {}
};
__device__ __forceinline__ unsigned cvt_pk_bf16(float lo, float hi) { unsigned r; asm volatile("v_cvt_pk_bf16_f32 %0, %1, %2" : "=v"(r) : "v"(lo), "v"(hi)); return r; }
template <class Epi, class Sched, bool ALIGN_EPI = false, bool SP2 = false>
__device__ __forceinline__ void gemm_phase(PG8_LAS unsigned char* lds, const Gemm g, const Sched& S, const Epi& E) {
    int tid_ = threadIdx.x; asm volatile("" : "+v"(tid_));
    const int tid = tid_, wid = __builtin_amdgcn_readfirstlane(tid >> 6), lane = tid & 63, wr = wid >> 2, wc = wid & 3, fr = lane & 15, fq = lane >> 4;
    const int K = g.K, nt = K / BK;
    unsigned voffA[2], voffB[2];
#pragma unroll
    for (int i = 0; i < 2; ++i) { int R, C; stage_rc(tid * 16 + i * 8192, R, C); const int Rb = Epi::PERM ? ((R & ~31) + perm32(R & 31)) : R;
        voffA[i] = (unsigned)(R * K + C) * 2u; voffB[i] = (unsigned)(Rb * K + C) * 2u; }
    const size_t kstep = (size_t)(BK * 2);
    const size_t hstep = (size_t)HALF * K * 2;
    const size_t tstep = 2 * hstep;
    const unsigned ldsw = (unsigned)wid * 1024u;
    const int aoff = lds_byte(wr * 64 + fr, fq * 8), boff = lds_byte(wc * 32 + fr, fq * 8);
#define PG8_SA(b, h) (((b) * 2 + (h)) * HTB)
#define PG8_SB(b, h) ((4 + (b) * 2 + (h)) * HTB)
#define PG8_STAGE(bufoff, gbase, voff) do { _Pragma("unroll") for (int _i = 0; _i < 2; ++_i) \
        __builtin_amdgcn_global_load_lds((const unsigned*)((const char*)(gbase) + (voff)[_i]), (PG8_LAS unsigned*)(lds + (bufoff) + ldsw + _i * 8192), 16, 0, 0); } while (0)
#define PG8_LDA(dst, b, h) do { _Pragma("unroll") for (int m = 0; m < 4; ++m) _Pragma("unroll") for (int k = 0; k < 2; ++k) dst[m][k] = *(const PG8_LAS bf16x8*)(lds + PG8_SA(b, h) + aoff + m * 2048 + k * 1024); } while (0)
#define PG8_LDB(dst, b, h) do { _Pragma("unroll") for (int n = 0; n < 2; ++n) _Pragma("unroll") for (int k = 0; k < 2; ++k) dst[n][k] = *(const PG8_LAS bf16x8*)(lds + PG8_SB(b, h) + boff + n * 2048 + k * 1024); } while (0)
#define PG8_MMA(ai, bj, At, Bt) do { __builtin_amdgcn_s_setprio(1); _Pragma("unroll") for (int m = 0; m < 4; ++m) _Pragma("unroll") for (int n = 0; n < 2; ++n) _Pragma("unroll") for (int k = 0; k < 2; ++k) \
        acc[ai][bj][m][n] = __builtin_amdgcn_mfma_f32_16x16x32_bf16(Bt[n][k], At[m][k], acc[ai][bj][m][n], 0, 0, 0); __builtin_amdgcn_s_setprio(0); } while (0)
#define PG8_WAIT_V(n) asm volatile("s_waitcnt vmcnt(" #n ")" ::: "memory")
#define PG8_WAIT_L(n) asm volatile("s_waitcnt lgkmcnt(" #n ")" ::: "memory")
#define PG8_BAR __builtin_amdgcn_s_barrier()
#define PG8_SCHED __builtin_amdgcn_sched_barrier(0)
    Unit cur, nxt; int ui = 0;
    if (!S.next(0, cur)) return;
    f32x4 acc[2][2][4][2];
#pragma unroll
    for (int a = 0; a < 2; ++a)
#pragma unroll
        for (int b = 0; b < 2; ++b)
#pragma unroll
            for (int m = 0; m < 4; ++m)
#pragma unroll
                for (int n = 0; n < 2; ++n) acc[a][b][m][n] = (f32x4){0.f, 0.f, 0.f, 0.f};
    bf16x8 At[4][2], B0[2][2], B1[2][2];
    const char* cA = (const char*)g.A + (size_t)cur.pm * tstep; const char* cB = (const char*)g.Bt + (size_t)cur.pn * tstep;
    S.a_ready(cur);
    if constexpr (SP2) {
        PG8_STAGE(PG8_SB(0, 0), cB, voffB); PG8_STAGE(PG8_SB(0, 1), cB + hstep, voffB); PG8_STAGE(PG8_SA(0, 0), cA, voffA); PG8_STAGE(PG8_SA(0, 1), cA + hstep, voffA);
        if (wr == 1) PG8_BAR;
        PG8_WAIT_V(2); PG8_BAR;
        PG8_STAGE(PG8_SB(1, 0), cB + kstep, voffB); PG8_STAGE(PG8_SA(1, 0), cA + kstep, voffA); PG8_STAGE(PG8_SB(1, 1), cB + hstep + kstep, voffB);
        PG8_WAIT_V(6); PG8_BAR;
    } else {
        PG8_STAGE(PG8_SB(0, 0), cB, voffB); PG8_STAGE(PG8_SA(0, 0), cA, voffA); PG8_STAGE(PG8_SB(0, 1), cB + hstep, voffB); PG8_STAGE(PG8_SA(0, 1), cA + hstep, voffA);
        if (wr == 1) PG8_BAR;
        PG8_WAIT_V(4); PG8_BAR;
        PG8_STAGE(PG8_SB(1, 0), cB + kstep, voffB); PG8_STAGE(PG8_SA(1, 0), cA + kstep, voffA); PG8_STAGE(PG8_SB(1, 1), cB + hstep + kstep, voffB);
        PG8_WAIT_V(6); PG8_BAR;
    }
    for (;;) {
        const bool has_next = S.next(ui + 1, nxt);
        const char* nA = has_next ? (const char*)g.A + (size_t)nxt.pm * tstep : cA; const char* nB = has_next ? (const char*)g.Bt + (size_t)nxt.pn * tstep : cB;
        for (int t = 0; t < nt; t += 2) {
            const bool last = (t == nt - 2);
            const char* a1 = cA + (size_t)(t + 1) * kstep;
            const char* a2 = last ? nA : cA + (size_t)(t + 2) * kstep; const char* b2 = last ? nB : cB + (size_t)(t + 2) * kstep;
            const char* a3 = a2 + kstep; const char* b3 = b2 + kstep;
            if (last && has_next) S.a_ready(nxt);
            if constexpr (SP2) {
            PG8_LDB(B0, 0, 0); PG8_LDB(B1, 0, 1); PG8_SCHED; PG8_LDA(At, 0, 0); PG8_STAGE(PG8_SA(1, 1), a1 + hstep, voffA);
            PG8_WAIT_V(8); PG8_WAIT_L(0); PG8_BAR; PG8_MMA(0, 0, At, B0); PG8_MMA(0, 1, At, B1); PG8_BAR; PG8_SCHED;
            PG8_LDA(At, 0, 1); PG8_STAGE(PG8_SB(0, 0), b2, voffB); PG8_STAGE(PG8_SB(0, 1), b2 + hstep, voffB); PG8_STAGE(PG8_SA(0, 0), a2, voffA);
            PG8_WAIT_V(8); PG8_WAIT_L(0); PG8_BAR; PG8_MMA(1, 0, At, B0); PG8_MMA(1, 1, At, B1); PG8_BAR; PG8_SCHED;
            PG8_LDB(B0, 1, 0); PG8_LDB(B1, 1, 1); PG8_SCHED; PG8_LDA(At, 1, 0); PG8_STAGE(PG8_SA(0, 1), a2 + hstep, voffA);
            PG8_WAIT_V(8); PG8_WAIT_L(0); PG8_BAR; PG8_MMA(0, 0, At, B0); PG8_MMA(0, 1, At, B1); PG8_BAR; PG8_SCHED;
            PG8_LDA(At, 1, 1); PG8_STAGE(PG8_SB(1, 0), b3, voffB); PG8_STAGE(PG8_SB(1, 1), b3 + hstep, voffB); PG8_STAGE(PG8_SA(1, 0), a3, voffA);
            PG8_WAIT_V(8); PG8_WAIT_L(0); PG8_BAR; PG8_MMA(1, 0, At, B0); PG8_MMA(1, 1, At, B1); PG8_BAR; PG8_SCHED;
            } else {
            PG8_LDB(B0, 0, 0); PG8_SCHED; PG8_LDA(At, 0, 0); PG8_STAGE(PG8_SA(1, 1), a1 + hstep, voffA);
            PG8_WAIT_L(8); PG8_BAR; PG8_WAIT_L(0); PG8_MMA(0, 0, At, B0); PG8_BAR; PG8_SCHED;
            PG8_LDB(B1, 0, 1); PG8_STAGE(PG8_SB(0, 0), b2, voffB);
            PG8_BAR; PG8_WAIT_L(0); PG8_MMA(0, 1, At, B1); PG8_BAR;
            PG8_LDA(At, 0, 1); PG8_STAGE(PG8_SA(0, 0), a2, voffA);
            PG8_BAR; PG8_WAIT_L(0); PG8_MMA(1, 0, At, B0); PG8_BAR; PG8_SCHED;
            PG8_STAGE(PG8_SB(0, 1), b2 + hstep, voffB);
            PG8_WAIT_V(6); PG8_BAR; PG8_MMA(1, 1, At, B1); PG8_BAR;
            PG8_LDB(B0, 1, 0); PG8_SCHED; PG8_LDA(At, 1, 0); PG8_STAGE(PG8_SA(0, 1), a2 + hstep, voffA);
            PG8_WAIT_L(8); PG8_BAR; PG8_WAIT_L(0); PG8_MMA(0, 0, At, B0); PG8_BAR; PG8_SCHED;
            PG8_LDB(B1, 1, 1); PG8_STAGE(PG8_SB(1, 0), b3, voffB);
            PG8_BAR; PG8_WAIT_L(0); PG8_MMA(0, 1, At, B1); PG8_BAR;
            PG8_LDA(At, 1, 1); PG8_STAGE(PG8_SA(1, 0), a3, voffA);
            PG8_BAR; PG8_WAIT_L(0); PG8_MMA(1, 0, At, B0); PG8_BAR; PG8_SCHED;
            PG8_STAGE(PG8_SB(1, 1), b3 + hstep, voffB);
            PG8_WAIT_V(6); PG8_BAR; PG8_MMA(1, 1, At, B1); PG8_BAR;
            }
        }
        if constexpr (ALIGN_EPI) { if (wr == 0) PG8_BAR; }
        E(acc, cur, wr, wc, fr, fq, lds);
        if (!has_next) break;
#pragma unroll
        for (int a = 0; a < 2; ++a)
#pragma unroll
            for (int b = 0; b < 2; ++b)
#pragma unroll
                for (int m = 0; m < 4; ++m)
#pragma unroll
                    for (int n = 0; n < 2; ++n) acc[a][b][m][n] = (f32x4){0.f, 0.f, 0.f, 0.f};
        cur = nxt; cA = nA; cB = nB; ++ui;
        if constexpr (ALIGN_EPI) { if (wr == 1) PG8_BAR; }
    }
    PG8_WAIT_V(0);
    if constexpr (!ALIGN_EPI) { if (wr == 0) PG8_BAR; }
    PG8_BAR;
#undef PG8_SA
#undef PG8_SB
#undef PG8_STAGE
#undef PG8_LDA
#undef PG8_LDB
#undef PG8_MMA
#undef PG8_WAIT_V
#undef PG8_WAIT_L
#undef PG8_BAR
#undef PG8_SCHED
}
}
namespace pg8 {
constexpr int DMODEL = 2048;
constexpr float RMS_EPS = 1e-6f;
__device__ __forceinline__ float fast_exp(float x) { return __builtin_amdgcn_exp2f(x * 1.4426950408889634f); }
__device__ __forceinline__ float fast_log(float x) { return __builtin_amdgcn_logf(x) * 0.6931471805599453f; }
__device__ __forceinline__ float fast_rcp(float x) { return __builtin_amdgcn_rcpf(x); }
__device__ __forceinline__ float silu_f(float v) { return v * fast_rcp(1.0f + fast_exp(-v)); }
__device__ __forceinline__ u32x4 pack8_bf16(const f32x4 a, const f32x4 b) { u32x4 w; w.x = cvt_pk_bf16(a[0], a[1]); w.y = cvt_pk_bf16(a[2], a[3]); w.z = cvt_pk_bf16(b[0], b[1]); w.w = cvt_pk_bf16(b[2], b[3]); return w; }
typedef unsigned long long ssq_t;
__device__ __forceinline__ float ss_rsq(const ssq_t* ss, int row) { return __builtin_amdgcn_rsqf((float)ss[row] * (2.3283064365386963e-10f / DMODEL) + RMS_EPS); }
__device__ __forceinline__ void row_scales(float (&rs)[2][4], const ssq_t* ss, int row0) {
#pragma unroll
    for (int ai = 0; ai < 2; ++ai)
#pragma unroll
        for (int m = 0; m < 4; ++m) rs[ai][m] = ss_rsq(ss, row0 + ai * HALF + m * 16);
}

__device__ __forceinline__ void fz_one(float z, float l, float& k, float& logf) {
    const float e = fast_exp(-__builtin_fabsf(z)), inv = fast_rcp(1.0f + e), sm = e * inv;
    const float sig = z >= 0.f ? inv : sm, nsig = z >= 0.f ? sm : inv;
    k = (1.0f - l) * nsig; logf = fast_log(l + (1.0f - l) * sig);
}

struct EpiHgrnIn {
    static constexpr bool PERM = true, AFTER_DRAIN = false;
    bf16_t* QKVG; float* LOGF; const ssq_t* ss; const float* lb;
    static constexpr size_t TSTRIDE = (size_t)16384 * DMODEL;
    __device__ __forceinline__ void operator()(const f32x4 (&acc)[2][2][4][2], const Unit& u, int wr, int wc, int fr, int fq, PG8_LAS unsigned char*) const {
        const int row0 = u.pm * BM + wr * 64 + fr, type = u.pn >> 3, col0 = (u.pn & 7) * BM + wc * 32 + 8 * fq;
        if (type == 1) {
#pragma unroll
            for (int bj = 0; bj < 2; ++bj) { const f32x4 lb0 = *(const f32x4*)(lb + col0 + bj * HALF), lb1 = *(const f32x4*)(lb + col0 + bj * HALF + 4);
#pragma unroll
                for (int ai = 0; ai < 2; ++ai)
#pragma unroll
                    for (int m = 0; m < 4; ++m) { const int row = row0 + ai * HALF + m * 16; const size_t off = (size_t)row * DMODEL + col0 + bj * HALF;
                        const float rs = ss_rsq(ss, row); f32x4 kk0, kk1, lf0, lf1;
#pragma unroll
                        for (int j = 0; j < 4; ++j) { float ka, la, kb, lb_; fz_one(acc[ai][bj][m][0][j] * rs, lb0[j], ka, la); fz_one(acc[ai][bj][m][1][j] * rs, lb1[j], kb, lb_); kk0[j] = ka; lf0[j] = la; kk1[j] = kb; lf1[j] = lb_; }
                        *(u32x4*)(QKVG + TSTRIDE + off) = pack8_bf16(kk0, kk1);
                        *(f32x4*)(LOGF + off) = lf0; *(f32x4*)(LOGF + off + 4) = lf1;
                        asm volatile("" ::: "memory"); } }
        } else {
            bf16_t* dst = QKVG + (size_t)(type == 0 ? 0 : type) * TSTRIDE;
#pragma unroll
            for (int ai = 0; ai < 2; ++ai)
#pragma unroll
                for (int m = 0; m < 4; ++m) { const int row = row0 + ai * HALF + m * 16; const size_t off = (size_t)row * DMODEL + col0;
                    const float rs = ss_rsq(ss, row);
#pragma unroll
                    for (int bj = 0; bj < 2; ++bj) { f32x4 v0 = acc[ai][bj][m][0] * rs, v1 = acc[ai][bj][m][1] * rs;
                        if (type == 3) {
#pragma unroll
                            for (int j = 0; j < 4; ++j) { v0[j] = silu_f(v0[j]); v1[j] = silu_f(v1[j]); } }
                        *(u32x4*)(dst + off + bj * HALF) = pack8_bf16(v0, v1); }
                    asm volatile("" ::: "memory"); }
        }
    }
};

struct EpiRes {
    static constexpr bool PERM = true, AFTER_DRAIN = false;
    const float* resid; float* out; bf16_t* xb; ssq_t* ssn;
    __device__ __forceinline__ void operator()(const f32x4 (&acc)[2][2][4][2], const Unit& u, int wr, int wc, int fr, int fq, PG8_LAS unsigned char*) const {
        const int row0 = u.pm * BM + wr * 64 + fr, col0 = u.pn * BM + wc * 32 + 8 * fq;
#pragma unroll
        for (int ai = 0; ai < 2; ++ai)
#pragma unroll
            for (int m = 0; m < 4; ++m) { const int row = row0 + ai * HALF + m * 16; const size_t off = (size_t)row * DMODEL + col0; float s = 0.f;
#pragma unroll
                for (int bj = 0; bj < 2; ++bj) { const f32x4 r0 = *(const f32x4*)(resid + off + bj * HALF), r1 = *(const f32x4*)(resid + off + bj * HALF + 4);
                    const f32x4 x0 = acc[ai][bj][m][0] + r0, x1 = acc[ai][bj][m][1] + r1;
                    *(f32x4*)(out + off + bj * HALF) = x0; *(f32x4*)(out + off + bj * HALF + 4) = x1;
                    *(u32x4*)(xb + off + bj * HALF) = pack8_bf16(x0, x1);
                    s += (x0[0] * x0[0] + x0[1] * x0[1]) + (x0[2] * x0[2] + x0[3] * x0[3]) + (x1[0] * x1[0] + x1[1] * x1[1]) + (x1[2] * x1[2] + x1[3] * x1[3]); }
                s += __shfl_xor(s, 16); s += __shfl_xor(s, 32);
                if (fq == 0) atomicAdd(ssn + row, (ssq_t)(s * 4294967296.0f)); }
    }
};

struct EpiFfn1 {
    static constexpr bool PERM = true, AFTER_DRAIN = false;
    bf16_t* H; int ldh; const ssq_t* ss;
    __device__ __forceinline__ void operator()(const f32x4 (&acc)[2][2][4][2], const Unit& u, int wr, int wc, int fr, int fq, PG8_LAS unsigned char*) const {
        const int row0 = u.pm * BM + wr * 64 + fr, col0 = u.pn * HALF + wc * 32 + 8 * fq;
        float rs[2][4]; row_scales(rs, ss, row0);
#pragma unroll
        for (int ai = 0; ai < 2; ++ai)
#pragma unroll
            for (int m = 0; m < 4; ++m) { f32x4 h[2];
#pragma unroll
                for (int n = 0; n < 2; ++n)
#pragma unroll
                    for (int j = 0; j < 4; ++j) { const float g = acc[ai][0][m][n][j] * rs[ai][m], up = acc[ai][1][m][n][j] * rs[ai][m]; h[n][j] = silu_f(g) * up; }
                *(u32x4*)(H + (size_t)(row0 + ai * HALF + m * 16) * ldh + col0) = pack8_bf16(h[0], h[1]); }
    }
};

constexpr int QKV_SCR_OFF = 131072;
struct EpiQkv {
    static constexpr bool PERM = true, AFTER_DRAIN = false;
    bf16_t *Qo, *Ko, *Vo; const ssq_t* ss; const float* qgain; const float* kgain; const float* rope;
    __device__ __forceinline__ void operator()(const f32x4 (&acc)[2][2][4][2], const Unit& u, int wr, int wc, int fr, int fq, PG8_LAS unsigned char* lds) const {
        const int kind = u.pn / 24, pt = u.pn - kind * 24, grp = pt >> 3;
        const int row0 = u.pm * BM + wr * 64 + fr, col0 = pt * BM + wc * 32 + 8 * fq;
        float rs[2][4]; row_scales(rs, ss, row0);
        if (kind == 2) {
#pragma unroll
            for (int ai = 0; ai < 2; ++ai)
#pragma unroll
                for (int m = 0; m < 4; ++m) { const size_t off = (size_t)(row0 + ai * HALF + m * 16) * 6144 + col0;
#pragma unroll
                    for (int bj = 0; bj < 2; ++bj) *(u32x4*)(Vo + off + bj * HALF) = pack8_bf16(acc[ai][bj][m][0] * rs[ai][m], acc[ai][bj][m][1] * rs[ai][m]); }
            return;
        }
        PG8_LAS float* scr = (PG8_LAS float*)(lds + QKV_SCR_OFF);
#pragma unroll
        for (int ai = 0; ai < 2; ++ai)
#pragma unroll
            for (int m = 0; m < 4; ++m)
#pragma unroll
                for (int bj = 0; bj < 2; ++bj) { const f32x4 a = acc[ai][bj][m][0] * rs[ai][m], b = acc[ai][bj][m][1] * rs[ai][m];
                    float s = (a[0] * a[0] + a[1] * a[1]) + (a[2] * a[2] + a[3] * a[3]) + (b[0] * b[0] + b[1] * b[1]) + (b[2] * b[2] + b[3] * b[3]);
                    s += __shfl_xor(s, 16); s += __shfl_xor(s, 32);
                    if (fq == 0) scr[((ai * HALF + wr * 64 + m * 16 + fr) * 2 + bj) * 4 + wc] = s; }
        asm volatile("s_waitcnt lgkmcnt(0)" ::: "memory"); __builtin_amdgcn_s_barrier(); asm volatile("" ::: "memory");
        const float* gain = (kind == 0 ? qgain : kgain) + grp * 128 + wc * 32 + 8 * fq;
        const f32x4 g0 = *(const f32x4*)gain, g1 = *(const f32x4*)(gain + 4);
        bf16_t* dst = kind == 0 ? Qo : Ko;
#pragma unroll
        for (int ai = 0; ai < 2; ++ai)
#pragma unroll
            for (int m = 0; m < 4; ++m) { const int row = row0 + ai * HALF + m * 16; const size_t off = (size_t)row * 6144 + col0;
                f32x4 c0 = {1.f, 1.f, 1.f, 1.f}, c1 = c0, s0 = {0.f, 0.f, 0.f, 0.f}, s1 = s0;
                if (wc == 0) { const float* rp = rope + (size_t)(row & 4095) * 32 + 8 * (fq & 1);
                    c0 = *(const f32x4*)rp; c1 = *(const f32x4*)(rp + 4); s0 = *(const f32x4*)(rp + 16); s1 = *(const f32x4*)(rp + 20);
                    if (fq < 2) { s0 = -s0; s1 = -s1; } }
#pragma unroll
                for (int bj = 0; bj < 2; ++bj) { const f32x4 p = *(const PG8_LAS f32x4*)(scr + ((ai * HALF + wr * 64 + m * 16 + fr) * 2 + bj) * 4);
                    const float sc = __builtin_amdgcn_rsqf(((p[0] + p[1]) + (p[2] + p[3])) * (1.0f / 128.0f) + RMS_EPS) * rs[ai][m];
                    f32x4 v0 = acc[ai][bj][m][0] * sc * g0, v1 = acc[ai][bj][m][1] * sc * g1;
                    if (wc == 0) { f32x4 p0, p1;
#pragma unroll
                        for (int j = 0; j < 4; ++j) { p0[j] = __shfl_xor(v0[j], 32); p1[j] = __shfl_xor(v1[j], 32); }
                        v0 = v0 * c0 + p0 * s0; v1 = v1 * c1 + p1 * s1; }
                    *(u32x4*)(dst + off + bj * HALF) = pack8_bf16(v0, v1); } }
    }
};
}
namespace att {
typedef unsigned short bf16;
typedef short bf16x8 __attribute__((ext_vector_type(8)));
typedef short s16x4 __attribute__((ext_vector_type(4)));
typedef float f32x16 __attribute__((ext_vector_type(16)));
typedef float f32x4 __attribute__((ext_vector_type(4)));
typedef unsigned u32x4 __attribute__((ext_vector_type(4)));
constexpr int D = 128, NW = 8, QBLK = 32, KVBLK = 64, QB = NW * QBLK;
constexpr int SHM_V = KVBLK * D * 2, SHM_K = KVBLK * D * 2;
constexpr int LDS_BYTES = 2 * SHM_V + 2 * SHM_K + NW * 64 * 4;
constexpr float SCALE = 0.08838834764831845f;
constexpr float THR = 8.f;
constexpr int W = 129;
constexpr bool SK = true;

#define KSWZ(row, colB) ((row) * 256 + ((colB) ^ (((row) & 7) << 4)))
#define SBAR() __builtin_amdgcn_sched_barrier(0)
__device__ __forceinline__ int v_st(int k, int c) { const int kk = (k & ~0xC) | ((k & 4) << 1) | ((k & 8) >> 1); return ((kk >> 3) * 4 + (c >> 5)) * 512 + ((kk & 7) * 32 + (c & 31)) * 2; }
__device__ __forceinline__ int v_rd_base(int lane) { return ((lane & 3) << 3) | (((lane >> 2) & 3) << 6) | (((lane >> 4) & 1) << 5) | (((lane >> 5) & 1) << 8); }
constexpr int v_rd_off(int d0, int ks, int half) { return d0 * 512 + ks * 4096 + half * 2048; }
__device__ __forceinline__ int crow(int r, int hi) { return (r & 3) + 8 * (r >> 2) + 4 * hi; }
__device__ __forceinline__ unsigned cvtpk(float lo, float hi) { unsigned r; asm volatile("v_cvt_pk_bf16_f32 %0, %1, %2" : "=v"(r) : "v"(lo), "v"(hi)); return r; }
__device__ __forceinline__ bf16x8 ld8(const bf16* p) { return *reinterpret_cast<const bf16x8*>(p); }
__device__ __forceinline__ bf16x8 ld8g(const char* ubase, unsigned voff) { return *reinterpret_cast<const bf16x8*>(ubase + voff); }
__device__ __forceinline__ void mask_tile(f32x16& p0, f32x16& p1, int dq, unsigned Wu) {
    const float NEG = -__builtin_inff();
#pragma unroll
    for (int r = 0; r < 16; ++r) {
        const int c = (r & 3) + 8 * (r >> 2);
        if ((unsigned)(dq - c) >= Wu) p0[r] = NEG;
        if ((unsigned)(dq - c - 32) >= Wu) p1[r] = NEG;
    }
}
__device__ __forceinline__ void partialSM(f32x16& p0, f32x16& p1, float& m_reg, float& mn, float& alpha) {
    float pmax = p0[0];
#pragma unroll
    for (int r = 1; r < 16; ++r) pmax = fmaxf(pmax, p0[r]);
#pragma unroll
    for (int r = 0; r < 16; ++r) pmax = fmaxf(pmax, p1[r]);
    { auto rr = __builtin_amdgcn_permlane32_swap(__float_as_uint(pmax), __float_as_uint(pmax), false, false);
      pmax = fmaxf(__uint_as_float(rr[0]), __uint_as_float(rr[1])); }
    constexpr float C2 = 1.4426950408889634f * SCALE;
    if (__builtin_expect(__all((pmax - m_reg) * SCALE <= THR), 1)) { mn = m_reg; alpha = 1.f; }
    else { mn = fmaxf(m_reg, pmax); alpha = __builtin_amdgcn_exp2f((m_reg - mn) * C2); m_reg = mn; }
    const float mnL = -mn * C2;
#pragma unroll
    for (int r = 0; r < 16; ++r) p0[r] = fmaf(p0[r], C2, mnL);
#pragma unroll
    for (int r = 0; r < 16; ++r) p1[r] = fmaf(p1[r], C2, mnL);
#pragma unroll
    for (int r = 0; r < 16; ++r) p0[r] = __builtin_amdgcn_exp2f(p0[r]);
}
__device__ __forceinline__ void finishSM(f32x16& p0, f32x16& p1, float alpha, float& l_reg, bf16x8& pa0, bf16x8& pa1, bf16x8& pa2, bf16x8& pa3) {
#pragma unroll
    for (int r = 0; r < 16; ++r) p1[r] = __builtin_amdgcn_exp2f(p1[r]);
    float ps = 0;
#pragma unroll
    for (int r = 0; r < 16; ++r) ps += p0[r];
#pragma unroll
    for (int r = 0; r < 16; ++r) ps += p1[r];
    { auto rr = __builtin_amdgcn_permlane32_swap(__float_as_uint(ps), __float_as_uint(ps), false, false);
      ps = __uint_as_float(rr[0]) + __uint_as_float(rr[1]); }
    l_reg = l_reg * alpha + ps;
#define PK4(P, B_, OUT) do { unsigned a0 = cvtpk(P[B_+0], P[B_+1]), a1 = cvtpk(P[B_+2], P[B_+3]);                          \
        unsigned b0 = cvtpk(P[B_+4], P[B_+5]), b1 = cvtpk(P[B_+6], P[B_+7]);                                             \
        auto r0 = __builtin_amdgcn_permlane32_swap(a0, b0, false, false); auto r1 = __builtin_amdgcn_permlane32_swap(a1, b1, false, false); \
        u32x4 w = {r0[0], r1[0], r0[1], r1[1]}; OUT = *reinterpret_cast<bf16x8*>(&w); } while (0)
    PK4(p0, 0, pa0); PK4(p0, 8, pa1); PK4(p1, 0, pa2); PK4(p1, 8, pa3);
#undef PK4
}
template <int KB>
__device__ __forceinline__ void qkt(f32x16& p0, f32x16& p1, const char* K_lds, int r32, int hi, const bf16x8* qr, bool act) {
    if (SK && !act) { const float NEG = -__builtin_inff();
#pragma unroll
        for (int r = 0; r < 16; ++r) { p0[r] = NEG; p1[r] = NEG; } return; }
    p0 = f32x16{}; p1 = f32x16{};
    const char* kb[4];
#pragma unroll
    for (int dd = 0; dd < 4; ++dd) kb[dd] = K_lds + KB * SHM_K + KSWZ(r32, (dd * 16 + hi * 8) * 2);
#pragma unroll
    for (int d0 = 0; d0 < 8; ++d0) { const char* a = kb[d0 & 3] + (d0 >> 2) * 128;
        bf16x8 b0 = *reinterpret_cast<const bf16x8*>(a);
        bf16x8 b1 = *reinterpret_cast<const bf16x8*>(a + 32 * 256);
        p0 = __builtin_amdgcn_mfma_f32_32x32x16_bf16(b0, qr[d0], p0, 0, 0, 0);
        p1 = __builtin_amdgcn_mfma_f32_32x32x16_bf16(b1, qr[d0], p1, 0, 0, 0); }
}
template <int VB>
__device__ __forceinline__ void pv_tile(f32x16* o, int vb0, bf16x8 pa0, bf16x8 pa1, bf16x8 pa2, bf16x8 pa3, bool act) {
    if (SK && !act) return;
#define TRRD(dst, off) asm volatile("ds_read_b64_tr_b16 %0, %1 offset:%2" : "=&v"(dst) : "v"(vb0), "i"(off) : "memory")
#define PV_D0(d0) do { s16x4 l0, l1, l2, l3, h0, h1, h2, h3; constexpr int b_ = VB * SHM_V + v_rd_off(d0, 0, 0);   \
        TRRD(l0, b_); TRRD(h0, b_ + 2048); TRRD(l1, b_ + 4096); TRRD(h1, b_ + 6144); TRRD(l2, b_ + 8192); TRRD(h2, b_ + 10240); TRRD(l3, b_ + 12288); TRRD(h3, b_ + 14336); \
        asm volatile("s_waitcnt lgkmcnt(0)" ::: "memory"); SBAR();   \
        o[d0] = __builtin_amdgcn_mfma_f32_32x32x16_bf16(pa0, (bf16x8){l0[0], l0[1], l0[2], l0[3], h0[0], h0[1], h0[2], h0[3]}, o[d0], 0, 0, 0);   \
        o[d0] = __builtin_amdgcn_mfma_f32_32x32x16_bf16(pa1, (bf16x8){l1[0], l1[1], l1[2], l1[3], h1[0], h1[1], h1[2], h1[3]}, o[d0], 0, 0, 0);   \
        o[d0] = __builtin_amdgcn_mfma_f32_32x32x16_bf16(pa2, (bf16x8){l2[0], l2[1], l2[2], l2[3], h2[0], h2[1], h2[2], h2[3]}, o[d0], 0, 0, 0);   \
        o[d0] = __builtin_amdgcn_mfma_f32_32x32x16_bf16(pa3, (bf16x8){l3[0], l3[1], l3[2], l3[3], h3[0], h3[1], h3[2], h3[3]}, o[d0], 0, 0, 0); } while (0)
    PV_D0(0); PV_D0(1); PV_D0(2); PV_D0(3);
#undef PV_D0
#undef TRRD
}

struct BlockRef { const bf16* Q; const bf16* K; const bf16* V; bf16* O; float* LSE; int P0; };
struct Seam { bf16x8 qr[8]; bf16x8 st_v0, st_v1, st_k0, st_k1; };
__device__ __forceinline__ int swa_jlo(int P0) { const int lowk = P0 - W + 1; return lowk > 0 ? lowk / KVBLK : 0; }
#define VMW() asm volatile("s_waitcnt vmcnt(0)" ::: "memory")
#define VMWN(n) asm volatile("s_waitcnt vmcnt(%0)" :: "i"(n) : "memory")
#define SLOAD_H(Kp, Vp, k0, pitch) do { const char* kb_ = (const char*)(Kp) + (size_t)(k0) * (size_t)((pitch) * 2); const char* vb_ = (const char*)(Vp) + (size_t)(k0) * (size_t)((pitch) * 2); \
        S.st_v0 = ld8g(vb_, rowoff); S.st_v1 = ld8g(vb_ + 32 * (pitch) * 2, rowoff); S.st_k0 = ld8g(kb_, rowoff); S.st_k1 = ld8g(kb_ + 32 * (pitch) * 2, rowoff); } while (0)
#define SWRITE_HK(bf) do { *(bf16x8*)(K_lds + (bf) * SHM_K + kws) = S.st_k0; *(bf16x8*)(K_lds + (bf) * SHM_K + kws + 32 * 256) = S.st_k1; } while (0)
#define SWRITE_HV(bf) do { *(bf16x8*)(V_lds + (bf) * SHM_V + vst0) = S.st_v0; *(bf16x8*)(V_lds + (bf) * SHM_V + vst1) = S.st_v1; } while (0)
#define SWRITE_H(bf) do { SWRITE_HV(bf); SWRITE_HK(bf); } while (0)
template <int DIL> __device__ __forceinline__ void swa_prime(const BlockRef& cur, char* lds, Seam& S) {
    constexpr int PITCH = DIL * 6144;
    int tid_ = threadIdx.x; asm volatile("" : "+v"(tid_));
    const int tid = tid_, wid = __builtin_amdgcn_readfirstlane(tid >> 6), lane = tid & 63, r32 = lane & 31, hi = lane >> 5;
    const int sr = tid >> 4, sc = (tid & 15) * 8, kws = KSWZ(sr, sc * 2); char* K_lds = lds + 2 * SHM_V;
    const unsigned rowoff = (unsigned)(sr * PITCH + sc) * 2u, qoff = (unsigned)((wid * QBLK + r32) * PITCH + hi * 8) * 2u;
    const int kb0 = swa_jlo(cur.P0) * KVBLK;
#pragma unroll
    for (int d0 = 0; d0 < 8; ++d0) S.qr[d0] = ld8g((const char*)cur.Q + d0 * 32, qoff);
    SLOAD_H(cur.K, cur.V, kb0, PITCH); VMW(); SWRITE_HK(0);
    __syncthreads();
}
template <int DIL> __device__ __forceinline__ void swa_block(const BlockRef& cur, const BlockRef& nxt, char* lds, Seam& S) {
    constexpr int PITCH = DIL * 6144, LPITCH = DIL * 48, SKV = 4096 / DIL;
    int tid_ = threadIdx.x; asm volatile("" : "+v"(tid_));
    const int tid = tid_, wid = __builtin_amdgcn_readfirstlane(tid >> 6), lane = tid & 63, r32 = lane & 31, hi = lane >> 5;
    const int j_lo = swa_jlo(cur.P0);
    int j_hi = (cur.P0 + QB - 1) / KVBLK + 1; if (j_hi > SKV / KVBLK) j_hi = SKV / KVBLK;
    const int NT = j_hi - j_lo;
    const int kbn = swa_jlo(nxt.P0) * KVBLK;
    const int qlo = cur.P0 + wid * QBLK, qm = qlo + r32 - 4 * hi;
    char* V_lds = lds; char* K_lds = lds + 2 * SHM_V;
    float* ws = (float*)(lds + 2 * SHM_V + 2 * SHM_K) + wid * 64; float* li_l = ws, * al_l = ws + 32;
    float m_reg = -1e30f, l_reg = 0; f32x16 o[4] = {};
    const int sr = tid >> 4, sc = (tid & 15) * 8, vst0 = v_st(sr, sc), vst1 = v_st(32 + sr, sc), kws = KSWZ(sr, sc * 2);
    const unsigned rowoff = (unsigned)(sr * PITCH + sc) * 2u, qoff = (unsigned)((wid * QBLK + r32) * PITCH + hi * 8) * 2u;
    const int vb0 = (int)(uintptr_t)V_lds + v_rd_base(lane);
    const bf16* Kh = cur.K; const bf16* Vh = cur.V; constexpr int pitch = PITCH;
#define RESC(a) do { if (__any((a) < 1.f)) { if (hi == 0) al_l[r32] = (a); asm volatile("s_waitcnt lgkmcnt(0)" ::: "memory");              \
                     for (int d_ = 0; d_ < 4; ++d_) for (int r = 0; r < 16; ++r) o[d_][r] *= al_l[crow(r, hi)]; } } while (0)
#define KBASE(t) ((j_lo + (t)) * KVBLK)
#define ACT(t) (KBASE(t) <= qlo + QBLK - 1 && KBASE(t) + KVBLK - 1 >= qlo - W + 1)
#define MASKT(P0_, P1_, t) do { const int kb_ = KBASE(t); if ((!SK || ACT(t)) && (kb_ + KVBLK - 1 > qlo || kb_ <= qlo + QBLK - 1 - W)) mask_tile(P0_, P1_, qm - kb_, (unsigned)W); } while (0)
#define SEAM_K0() do { VMWN(8); SWRITE_HK(0); SBAR(); } while (0)
    f32x16 pA0, pA1, pB0, pB1; float mnA, mnB, alA, alB; bf16x8 pa0, pa1, pa2, pa3;
    SWRITE_HV(0); SBAR();
    if (NT > 1) { SLOAD_H(Kh, Vh, KBASE(1), pitch); }
    SBAR(); qkt<0>(pA0, pA1, K_lds, r32, hi, S.qr, ACT(0));
    MASKT(pA0, pA1, 0); partialSM(pA0, pA1, m_reg, mnA, alA);
    if (NT > 1) { VMW(); SWRITE_H(1); }
    __syncthreads();
#define HALF_STEP(PX0, PX1, mnX, alX, PY0, PY1, alY, t, KB, VB, SB) do {                                                      \
        SBAR(); qkt<KB>(PX0, PX1, K_lds, r32, hi, S.qr, ACT(t));                                             \
        finishSM(PY0, PY1, alY, l_reg, pa0, pa1, pa2, pa3); SBAR();                                                           \
        if ((t) + 1 < NT) { SLOAD_H(Kh, Vh, KBASE((t) + 1), pitch); SBAR(); }                                               \
        pv_tile<VB>(o, vb0, pa0, pa1, pa2, pa3, ACT((t) - 1)); MASKT(PX0, PX1, (t)); partialSM(PX0, PX1, m_reg, mnX, alX);                                        \
        __syncthreads();                                                                                                      \
        if ((t) + 1 < NT) { VMW(); SWRITE_H(SB); }                                                                          \
        RESC(alX); __syncthreads(); } while (0)
    for (int t = 1; t + 1 < NT; t += 2) {
        HALF_STEP(pB0, pB1, mnB, alB, pA0, pA1, alA, t, 1, 0, 0);
        HALF_STEP(pA0, pA1, mnA, alA, pB0, pB1, alB, t + 1, 0, 1, 1);
    }
    const bool even = (NT & 1) == 0;
    if (even) { SBAR(); qkt<1>(pB0, pB1, K_lds, r32, hi, S.qr, ACT(NT - 1)); SBAR(); }
    SLOAD_H(nxt.K, nxt.V, kbn, PITCH); SBAR();
#pragma unroll
    for (int d0 = 0; d0 < 8; ++d0) S.qr[d0] = ld8g((const char*)nxt.Q + d0 * 32, qoff);
    SBAR();
    finishSM(pA0, pA1, alA, l_reg, pa0, pa1, pa2, pa3); SBAR();
    pv_tile<0>(o, vb0, pa0, pa1, pa2, pa3, ACT(even ? NT - 2 : NT - 1));
    if (even) { MASKT(pB0, pB1, NT - 1); partialSM(pB0, pB1, m_reg, mnB, alB); __syncthreads(); RESC(alB);
        finishSM(pB0, pB1, alB, l_reg, pa0, pa1, pa2, pa3); SBAR(); pv_tile<1>(o, vb0, pa0, pa1, pa2, pa3, ACT(NT - 1)); }
    SBAR(); SEAM_K0();
    if (hi == 0) li_l[r32] = l_reg; asm volatile("s_waitcnt lgkmcnt(0)" ::: "memory");
    float rli[16];
#pragma unroll
    for (int r = 0; r < 16; ++r) rli[r] = __builtin_amdgcn_rcpf(li_l[crow(r, hi)]);
    { char* Ob = (char*)cur.O + (size_t)(wid * QBLK) * (size_t)(PITCH * 2); const unsigned ooff = (unsigned)(4 * hi * PITCH + r32) * 2u;
#pragma unroll
      for (int r = 0; r < 16; ++r) { char* Or = Ob + (size_t)((r & 3) + 8 * (r >> 2)) * (size_t)(PITCH * 2);
#pragma unroll
        for (int d0 = 0; d0 < 4; ++d0) { const float v = o[d0][r] * rli[r];
            const float vn = __shfl_xor(v, 1);
            if ((r32 & 1) == 0) *(unsigned*)(Or + d0 * 64 + ooff) = cvtpk(v, vn); } } }
    if (hi == 0) cur.LSE[(size_t)(wid * QBLK + r32) * (size_t)LPITCH] = m_reg * SCALE + __builtin_amdgcn_logf(l_reg) * 0.6931471805599453f;
    __syncthreads();
#undef RESC
#undef KBASE
#undef ACT
#undef MASKT
#undef SEAM_K0
#undef HALF_STEP
}
#undef VMW
#undef VMWN
#undef SLOAD_H
#undef SWRITE_HK
#undef SWRITE_HV
#undef SWRITE_H
#undef KSWZ
#undef SBAR

template <int DIL> __device__ __forceinline__ BlockRef make_ref(int idx, const bf16* Q, const bf16* K, const bf16* V, bf16* O, float* LSE) {
    constexpr int GI = DIL == 1 ? 0 : (DIL == 4 ? 1 : 2), NQB = 16 / DIL, PITCH = DIL * 6144;
    const int j = idx & 15, h = (idx >> 4) & 15, b = idx >> 8, r = j / NQB, qb = j - r * NQB;
    const size_t base = (size_t)(b * 4096 + r) * 6144 + GI * 2048 + h * 128;
    BlockRef R; R.P0 = qb * QB;
    R.K = K + base; R.V = V + base; R.Q = Q + base + (size_t)R.P0 * (size_t)PITCH; R.O = O + base + (size_t)R.P0 * (size_t)PITCH;
    R.LSE = LSE + (size_t)(b * 4096 + r + R.P0 * DIL) * 48 + GI * 16 + h;
    return R;
}
template <int DIL> __device__ __forceinline__ void attn_group(char* lds, const bf16* Q, const bf16* K, const bf16* V, bf16* O, float* LSE) {
    const int total = 1024, stride = gridDim.x; int L = blockIdx.x; if (L >= total) return;
    BlockRef cur = make_ref<DIL>(L, Q, K, V, O, LSE); Seam S;
    swa_prime<DIL>(cur, lds, S);
    for (;;) {
        const int Ln = L + stride; const bool last = Ln >= total;
        const BlockRef nxt = last ? cur : make_ref<DIL>(Ln, Q, K, V, O, LSE);
        swa_block<DIL>(cur, nxt, lds, S);
        if (last) break;
        cur = nxt; L = Ln;
    }
}
__device__ __forceinline__ void attn_phase(char* lds, const bf16* Q, const bf16* K, const bf16* V, bf16* O, float* LSE) {
#ifndef ATT_ONLY
    attn_group<1>(lds, Q, K, V, O, LSE);
    attn_group<4>(lds, Q, K, V, O, LSE);
    attn_group<16>(lds, Q, K, V, O, LSE);
#else
    attn_group<ATT_ONLY>(lds, Q, K, V, O, LSE);
#endif
}
}
namespace hg {
typedef short bf16x8 __attribute__((ext_vector_type(8)));
typedef short s16x4 __attribute__((ext_vector_type(4)));
typedef float f32x16 __attribute__((ext_vector_type(16)));
typedef float f32x4 __attribute__((ext_vector_type(4)));
typedef float f32x2 __attribute__((ext_vector_type(2)));
typedef unsigned u32x4 __attribute__((ext_vector_type(4)));
#define HLAS __attribute__((address_space(3)))
constexpr int QT_OFF = 0, QT_ST = 264;
constexpr int QH_OFF = 16896, QH_ST = 272;
constexpr int KC_OFF = 34304, KC_ST = 272;
constexpr int KCT_OFF = 51712, KCT_ST = 144;
constexpr int VT_OFF = 70144, VT_ST = 144;
constexpr int GAM_OFF = 88576;
constexpr int TOT_OFF = 89088;
constexpr int OB_OFF = 93184, OB_ST = 132;
constexpr int LDS_END = OB_OFF + 64 * OB_ST * 4;
static_assert(LDS_END <= 131072, "hgrn LDS map");
typedef __bf16 bf16x2_t __attribute__((ext_vector_type(2)));
__device__ __forceinline__ unsigned cvtpk(float lo, float hi) { const f32x2 v = {lo, hi}; const bf16x2_t b = __builtin_convertvector(v, bf16x2_t); return __builtin_bit_cast(unsigned, b); }
__device__ __forceinline__ float ex(float x) { return __builtin_amdgcn_exp2f(x * 1.4426950408889634f); }
__device__ __forceinline__ float blo(unsigned w) { return __builtin_bit_cast(float, w << 16); }
__device__ __forceinline__ float bhi(unsigned w) { return __builtin_bit_cast(float, w & 0xffff0000u); }
__device__ __forceinline__ bf16x8 pack8(const f32x16& x, int o) {
    u32x4 w = {cvtpk(x[o + 0], x[o + 1]), cvtpk(x[o + 2], x[o + 3]), cvtpk(x[o + 4], x[o + 5]), cvtpk(x[o + 6], x[o + 7])}; return __builtin_bit_cast(bf16x8, w); }
__device__ __forceinline__ bf16x8 ld2x8(const HLAS unsigned char* p) {
    const s16x4 lo = *(const HLAS s16x4*)p, hi = *(const HLAS s16x4*)(p + 16); return (bf16x8){lo[0], lo[1], lo[2], lo[3], hi[0], hi[1], hi[2], hi[3]}; }

__device__ __forceinline__ void hgrn_chunked(HLAS unsigned char* lds, int bh, const unsigned short* Qb, const unsigned short* Kb, const unsigned short* Vb, unsigned short* Ob, const float* LOGF, const unsigned short* SGb, const float* ogain) {
    constexpr int SEQ_ = 4096, DM_ = 2048, HD_ = 128;
    int tid_ = threadIdx.x; asm volatile("" : "+v"(tid_));
    const int tid = tid_, wid = __builtin_amdgcn_readfirstlane(tid >> 6), lane = tid & 63, wt = wid >> 2, wv = wid & 3, c = lane & 31, hi = lane >> 5;
    const int b = bh >> 4, h = bh & 15;
    const size_t goff0 = (size_t)(b * SEQ_ + 8 * wid) * DM_ + h * HD_ + 2 * lane;
    const int t4 = tid >> 3, seg = tid & 7;
    f32x4 gn[4];
#pragma unroll
    for (int i = 0; i < 4; ++i) gn[i] = *(const f32x4*)(ogain + 16 * seg + 4 * i);
    f32x16 S[4];
#pragma unroll
    for (int kt = 0; kt < 4; ++kt)
#pragma unroll
        for (int r = 0; r < 16; ++r) S[kt][r] = 0.f;
    f32x2 lf[8]; unsigned qv[8], kv[8], vv[8];
#define HG_LOAD(t0_) do { _Pragma("unroll") for (int i = 0; i < 8; ++i) { const size_t o_ = goff0 + (size_t)((t0_) + i) * DM_; \
        lf[i] = *(const f32x2*)(LOGF + o_); qv[i] = *(const unsigned*)(Qb + o_); kv[i] = *(const unsigned*)(Kb + o_); vv[i] = *(const unsigned*)(Vb + o_); } } while (0)
#ifndef HG_NOPREFETCH
    HG_LOAD(0);
#endif
    HLAS float* TOT = (HLAS float*)(lds + TOT_OFF); HLAS float* GAM = (HLAS float*)(lds + GAM_OFF); HLAS float* OB = (HLAS float*)(lds + OB_OFF);
    for (int ch = 0; ch < SEQ_ / 64; ++ch) {
        const int t0 = ch * 64;
#ifdef HG_NOPREFETCH
        HG_LOAD(t0);
#endif
        float c0[8], c1[8];
        c0[0] = lf[0][0]; c1[0] = lf[0][1];
#pragma unroll
        for (int i = 1; i < 8; ++i) { c0[i] = c0[i - 1] + lf[i][0]; c1[i] = c1[i - 1] + lf[i][1]; }
        *(HLAS f32x2*)(TOT + wid * 128 + 2 * lane) = (f32x2){c0[7], c1[7]};
        __syncthreads();
        {
            float pre0 = 0.f, pre1 = 0.f, tot0 = 0.f, tot1 = 0.f;
#pragma unroll
            for (int w = 0; w < 8; ++w) { const f32x2 tv = *(const HLAS f32x2*)(TOT + w * 128 + 2 * lane); tot0 += tv[0]; tot1 += tv[1]; if (w < wid) { pre0 += tv[0]; pre1 += tv[1]; } }
            float kc0[8], kc1[8];
#pragma unroll
            for (int i = 0; i < 8; ++i) { const float b0 = pre0 + c0[i], b1 = pre1 + c1[i];
                const float q0 = blo(qv[i]), q1 = bhi(qv[i]), k0 = blo(kv[i]), k1 = bhi(kv[i]);
                const int t = 8 * wid + i;
                *(HLAS unsigned*)(lds + QT_OFF + t * QT_ST + lane * 4) = cvtpk(q0 * ex(b0), q1 * ex(b1));
                *(HLAS unsigned*)(lds + QH_OFF + t * QH_ST + lane * 4) = cvtpk(q0 * ex(fminf(b0 - tot0, 80.f)), q1 * ex(fminf(b1 - tot1, 80.f)));
                kc0[i] = k0 * ex(tot0 - b0); kc1[i] = k1 * ex(tot1 - b1);
                *(HLAS unsigned*)(lds + KC_OFF + t * KC_ST + lane * 4) = cvtpk(kc0[i], kc1[i]); }
            *(HLAS u32x4*)(lds + KCT_OFF + (2 * lane) * KCT_ST + wid * 16) = (u32x4){cvtpk(kc0[0], kc0[1]), cvtpk(kc0[2], kc0[3]), cvtpk(kc0[4], kc0[5]), cvtpk(kc0[6], kc0[7])};
            *(HLAS u32x4*)(lds + KCT_OFF + (2 * lane + 1) * KCT_ST + wid * 16) = (u32x4){cvtpk(kc1[0], kc1[1]), cvtpk(kc1[2], kc1[3]), cvtpk(kc1[4], kc1[5]), cvtpk(kc1[6], kc1[7])};
            *(HLAS u32x4*)(lds + VT_OFF + (2 * lane) * VT_ST + wid * 16) = (u32x4){(vv[0] & 0xffffu) | (vv[1] << 16), (vv[2] & 0xffffu) | (vv[3] << 16), (vv[4] & 0xffffu) | (vv[5] << 16), (vv[6] & 0xffffu) | (vv[7] << 16)};
            *(HLAS u32x4*)(lds + VT_OFF + (2 * lane + 1) * VT_ST + wid * 16) = (u32x4){(vv[0] >> 16) | (vv[1] & 0xffff0000u), (vv[2] >> 16) | (vv[3] & 0xffff0000u), (vv[4] >> 16) | (vv[5] & 0xffff0000u), (vv[6] >> 16) | (vv[7] & 0xffff0000u)};
            if (wid == 0) *(HLAS f32x2*)(GAM + 2 * lane) = (f32x2){ex(tot0), ex(tot1)};
        }
#ifndef HG_NOPREFETCH
        if (ch + 1 < SEQ_ / 64) HG_LOAD(t0 + 64);
#endif
        const size_t ooff = (size_t)(b * SEQ_ + t0 + t4) * DM_ + h * HD_ + 16 * seg;
        const u32x4 sg0 = *(const u32x4*)(SGb + ooff), sg1 = *(const u32x4*)(SGb + ooff + 8);
        __syncthreads();
        {
            f32x16 O, X0, X1;
#pragma unroll
            for (int r = 0; r < 16; ++r) { O[r] = 0.f; X0[r] = 0.f; X1[r] = 0.f; }
            const HLAS unsigned char* qhp = lds + QH_OFF + (32 * wt + c) * QH_ST + hi * 16;
            { const HLAS unsigned char* kp = lds + KC_OFF + c * KC_ST + hi * 16;
#pragma unroll
              for (int ks = 0; ks < 8; ++ks) X0 = __builtin_amdgcn_mfma_f32_32x32x16_bf16(*(const HLAS bf16x8*)(kp + ks * 32), *(const HLAS bf16x8*)(qhp + ks * 32), X0, 0, 0, 0); }
            if (wt == 1) { const HLAS unsigned char* kp = lds + KC_OFF + (32 + c) * KC_ST + hi * 16;
#pragma unroll
              for (int ks = 0; ks < 8; ++ks) X1 = __builtin_amdgcn_mfma_f32_32x32x16_bf16(*(const HLAS bf16x8*)(kp + ks * 32), *(const HLAS bf16x8*)(qhp + ks * 32), X1, 0, 0, 0); }
#pragma unroll
            for (int r = 0; r < 16; ++r) { const bool drop = ((r & 3) + 8 * (r >> 2) + 4 * hi) > c; if (wt == 0) { if (drop) X0[r] = 0.f; } else { if (drop) X1[r] = 0.f; } }
            const HLAS unsigned char* vrow = lds + VT_OFF + (32 * wv + c) * VT_ST;
#pragma unroll
            for (int st = 0; st < 2; ++st) O = __builtin_amdgcn_mfma_f32_32x32x16_bf16(pack8(X0, 8 * st), ld2x8(vrow + (16 * st + 4 * hi) * 2), O, 0, 0, 0);
            if (wt == 1) {
#pragma unroll
                for (int st = 0; st < 2; ++st) O = __builtin_amdgcn_mfma_f32_32x32x16_bf16(pack8(X1, 8 * st), ld2x8(vrow + (32 + 16 * st + 4 * hi) * 2), O, 0, 0, 0); }
            const HLAS unsigned char* qtp = lds + QT_OFF + (32 * wt + c) * QT_ST + 8 * hi;
#pragma unroll
            for (int kt = 0; kt < 4; ++kt)
#pragma unroll
                for (int st = 0; st < 2; ++st) O = __builtin_amdgcn_mfma_f32_32x32x16_bf16(ld2x8(qtp + (32 * kt + 16 * st) * 2), pack8(S[kt], 8 * st), O, 0, 0, 0);
            bf16x8 vb[4];
#pragma unroll
            for (int st = 0; st < 4; ++st) vb[st] = *(const HLAS bf16x8*)(vrow + (16 * st + 8 * hi) * 2);
#pragma unroll
            for (int kt = 0; kt < 4; ++kt) {
#pragma unroll
                for (int g = 0; g < 4; ++g) { const f32x4 gm = *(const HLAS f32x4*)(GAM + 32 * kt + 8 * g + 4 * hi);
#pragma unroll
                    for (int j = 0; j < 4; ++j) S[kt][4 * g + j] *= gm[j]; }
                const HLAS unsigned char* kp = lds + KCT_OFF + (32 * kt + c) * KCT_ST + hi * 16;
#pragma unroll
                for (int st = 0; st < 4; ++st) S[kt] = __builtin_amdgcn_mfma_f32_32x32x16_bf16(*(const HLAS bf16x8*)(kp + st * 32), vb[st], S[kt], 0, 0, 0);
            }
#pragma unroll
            for (int r = 0; r < 16; ++r) OB[(32 * wt + (r & 3) + 8 * (r >> 2) + 4 * hi) * OB_ST + 32 * wv + c] = O[r];
        }
        __syncthreads();
        {
            f32x4 o[4]; float s = 0.f;
#pragma unroll
            for (int i = 0; i < 4; ++i) { o[i] = *(const HLAS f32x4*)(OB + t4 * OB_ST + 16 * seg + 4 * i); s += (o[i][0] * o[i][0] + o[i][1] * o[i][1]) + (o[i][2] * o[i][2] + o[i][3] * o[i][3]); }
            s += __shfl_xor(s, 1); s += __shfl_xor(s, 2); s += __shfl_xor(s, 4);
            const float sc = __builtin_amdgcn_rsqf(s * (1.0f / HD_) + 1e-6f);
            u32x4 w0, w1;
#pragma unroll
            for (int e = 0; e < 4; ++e) { const int i = e >> 1, j = (e & 1) * 2;
                w0[e] = cvtpk(o[i][j] * sc * gn[i][j] * blo(sg0[e]), o[i][j + 1] * sc * gn[i][j + 1] * bhi(sg0[e]));
                w1[e] = cvtpk(o[2 + i][j] * sc * gn[2 + i][j] * blo(sg1[e]), o[2 + i][j + 1] * sc * gn[2 + i][j + 1] * bhi(sg1[e])); }
            *(u32x4*)(Ob + ooff) = w0; *(u32x4*)(Ob + ooff + 8) = w1;
        }
#ifdef HG_NOPREFETCH
        __syncthreads();
#endif
    }
#undef HG_LOAD
}
#undef HLAS
}
constexpr int BATCH = 4, SEQ = 4096, DM = 2048, MROWS = BATCH * SEQ, FFH = 5632, NHEAD = 16, HDIM = 128;
constexpr int NWAVES = 8;
constexpr size_t MiB = 1u << 20;
constexpr size_t WS_CTL = 0, WS_SS = 1 * MiB, CTL_ZERO_BYTES = 3 * MiB;
constexpr size_t WS_LBS = 3 * MiB, WS_ROPE = 3 * MiB + 65536;
constexpr size_t WS_W = 4 * MiB;
constexpr size_t WS_WA_IN = WS_W, WS_WA_OUT = WS_W + 64 * MiB, WS_WF_IN = WS_W + 80 * MiB, WS_WF_OUT = WS_W + 256 * MiB,
                 WS_WQKV2 = WS_W + 344 * MiB, WS_WQ3 = WS_W + 416 * MiB, WS_WB_OUT = WS_W + 440 * MiB;
constexpr size_t WS_XB = 460 * MiB;
constexpr size_t WS_R1 = 524 * MiB;
constexpr size_t WS_R2 = 908 * MiB;
constexpr size_t WS_OG = 1168 * MiB;
constexpr size_t WS_END = 1360 * MiB;
constexpr int CW_BAR = 1024;
constexpr int RING_BYTES = 131072, SCR_OFF = 131072, MISC_OFF = 131072 + 8192, LDS_BYTES = 147456;
static_assert(SCR_OFF == pg8::QKV_SCR_OFF, "LDS map");

#define GAS __attribute__((address_space(1)))
#define LAS __attribute__((address_space(3)))
typedef unsigned short bf16;
typedef unsigned v4u __attribute__((ext_vector_type(4)));
typedef unsigned v2u __attribute__((ext_vector_type(2)));
typedef float f32x4 __attribute__((ext_vector_type(4)));
#define LDS_WAIT() asm volatile("s_waitcnt lgkmcnt(0)" ::: "memory")
__device__ __forceinline__ unsigned f2bf(float f) { unsigned u = __builtin_bit_cast(unsigned, f); return (u + 0x7fffu + ((u >> 16) & 1u)) >> 16; }
__device__ __forceinline__ unsigned pk2(float lo, float hi) { return f2bf(lo) | (f2bf(hi) << 16); }
__device__ __forceinline__ float bflo(unsigned w) { return __builtin_bit_cast(float, w << 16); }
__device__ __forceinline__ float bfhi(unsigned w) { return __builtin_bit_cast(float, w & 0xffff0000u); }

#define XB_TMO      128
#define XB_XCNT(j)  (256  + 64 * (j))
#define XB_XSUB(j)  (1280 + 64 * (j))
#define XB_XGEN(j)  (2304 + 64 * (j))
#define XB_TOP      3328
#define XB_TOPGEN   3392
#define XCD_BAR_WORDS 3456
#define XB_SPIN_CAP (1u << 18)

__device__ __forceinline__ unsigned xb_ld(unsigned* p)              { return __hip_atomic_load(p, __ATOMIC_RELAXED, __HIP_MEMORY_SCOPE_AGENT); }
__device__ __forceinline__ unsigned xb_add(unsigned* p, unsigned v) { return __hip_atomic_fetch_add(p, v, __ATOMIC_RELAXED, __HIP_MEMORY_SCOPE_AGENT); }
__device__ __forceinline__ unsigned xb_xcc_id() { return (unsigned)__builtin_amdgcn_s_getreg((3 << 11) | 20) & 0xFu; }
#define XB_SPIN(cond, bar) do { unsigned _sp = 0; while (cond) { __builtin_amdgcn_s_sleep(1); \
    if ((++_sp & 255u) == 0u) { if (xb_ld(&(bar)[XB_TMO])) break; if (_sp > XB_SPIN_CAP) { atomicAdd(&(bar)[XB_TMO], 1u); break; } } } } while (0)

struct XcdBarrier {
    unsigned* bar; unsigned x;
    volatile LAS unsigned* st;
};

__device__ __forceinline__ XcdBarrier xcd_barrier_post(unsigned* bar, volatile LAS unsigned* st) {
    XcdBarrier b; b.bar = bar; b.x = xb_xcc_id(); b.st = st;
    if (threadIdx.x == 0) (void)xb_add(&bar[XB_XCNT(b.x)], 1u);
    return b;
}
__device__ __forceinline__ void xcd_barrier_complete(unsigned* bar, unsigned x, unsigned& nloc, unsigned& nx) {
    const unsigned G = gridDim.x * gridDim.y * gridDim.z;
    unsigned sum, cnt, mine, sp = 0u;
    for (;;) {
        sum = 0u; cnt = 0u; mine = 0u;
#pragma unroll
        for (unsigned j = 0; j < 16; ++j) { const unsigned c = xb_ld(&bar[XB_XCNT(j)]); sum += c; cnt += (c > 0u) ? 1u : 0u; mine = (j == x) ? c : mine; }
        if (sum == G) break;
        __builtin_amdgcn_s_sleep(1);
        if ((++sp & 255u) == 0u) { if (xb_ld(&bar[XB_TMO])) break; if (sp > XB_SPIN_CAP) { atomicAdd(&bar[XB_TMO], 1u); break; } }
    }
    nloc = mine > 0u ? mine : 1u; nx = cnt > 0u ? cnt : 1u;
}

__device__ __forceinline__ void xcd_barrier(const XcdBarrier& b) {
    asm volatile("s_waitcnt vmcnt(0)" ::: "memory");
    __syncthreads();
    if (threadIdx.x == 0) {
        unsigned* bar = b.bar;
        __builtin_amdgcn_s_waitcnt(0);
        unsigned nloc = b.st[0], nx = b.st[1];
        if (nloc == 0u) { xcd_barrier_complete(bar, b.x, nloc, nx); b.st[0] = nloc; b.st[1] = nx; }
        const unsigned old = xb_add(&bar[XB_XSUB(b.x)], 1u);
        const unsigned gen = old / nloc;
        if (old + 1u == (gen + 1u) * nloc) {
            __builtin_amdgcn_fence(__ATOMIC_RELEASE, "agent");
            asm volatile("s_waitcnt vmcnt(0)" ::: "memory");
            const unsigned og = xb_add(&bar[XB_TOP], 1u);
            const unsigned tg = og / nx;
            if (og + 1u == (tg + 1u) * nx) xb_add(&bar[XB_TOPGEN], 1u);
            else XB_SPIN(xb_ld(&bar[XB_TOPGEN]) == tg, bar);
            __builtin_amdgcn_fence(__ATOMIC_ACQUIRE, "agent");
            xb_add(&bar[XB_XGEN(b.x)], 1u);
            asm volatile("s_waitcnt vmcnt(0)" ::: "memory");
        } else {
            XB_SPIN(xb_ld(&bar[XB_XGEN(b.x)]) == gen, bar);
            __builtin_amdgcn_fence(__ATOMIC_ACQUIRE, "agent");
            asm volatile("s_waitcnt vmcnt(0)" ::: "memory");
        }
    }
    __syncthreads();
}


__device__ __forceinline__ float wave_sum(float v) {
#pragma unroll
    for (int o = 1; o < 64; o <<= 1) v += __shfl_xor(v, o);
    return v;
}
__device__ __forceinline__ void conv_item(const float* W, int ldw, int K, const float* gain, bf16* WT, int k0, int n0, int nd0, LAS float* scr, int lane) {
#pragma unroll 8
    for (int i = 0; i < 32; ++i) { const int kk = 2 * i + (lane >> 5); float w = W[(size_t)(k0 + kk) * ldw + n0 + (lane & 31)]; if (gain) w *= gain[k0 + kk]; scr[kk * 33 + (lane & 31)] = w; }
    LDS_WAIT(); asm volatile("" ::: "memory");
    const int c = lane & 7;
#pragma unroll
    for (int j = 0; j < 4; ++j) { const int n = (lane >> 3) + 8 * j; const LAS float* s = scr + (8 * c) * 33 + n;
        v4u o; o.x = pk2(s[0 * 33], s[1 * 33]); o.y = pk2(s[2 * 33], s[3 * 33]); o.z = pk2(s[4 * 33], s[5 * 33]); o.w = pk2(s[6 * 33], s[7 * 33]);
        *(GAS v4u*)(WT + (size_t)(nd0 + n) * K + k0 + 8 * c) = o; }
    LDS_WAIT(); asm volatile("" ::: "memory");
}

struct Args { const float* in[16]; float* out; unsigned char* ws; };

__device__ __forceinline__ void prologue(const Args& a, LAS unsigned char* lds, int gw, int NGW, int lane, int wave) {
    unsigned char* ws = a.ws;
    { float* lbs = (float*)(ws + WS_LBS); const float* alb = a.in[5];
      for (int i = gw * 64 + lane; i < DM; i += NGW * 64) { const float a0 = alb[i], a1 = alb[DM + i]; float s1 = 1.0f / (1.0f + expf(a0 - a1)); s1 = fminf(fmaxf(s1, 0.0f), 1.0f - 1e-6f); lbs[i] = 0.0f; lbs[DM + i] = s1; } }
    { float* rope = (float*)(ws + WS_ROPE);
      for (int i = gw * 64 + lane; i < SEQ * 16; i += NGW * 64) { const int pos = i >> 4, j = i & 15; double inv = 1.0;
          for (int q = 0; q < j; ++q) inv *= 0.4403666026717805;
          const double ang = (double)pos * inv, nrev = __builtin_rint(ang * 0.15915494309189535);
          const double r = (ang - nrev * 6.283185307179586) - nrev * 2.4492935982947064e-16, r2 = r * r;
          double ts = r, sn = r, tc = 1.0, cs = 1.0;
          for (int q = 1; q <= 14; ++q) { tc *= -r2 / (double)((2 * q - 1) * (2 * q)); cs += tc; ts *= -r2 / (double)((2 * q) * (2 * q + 1)); sn += ts; }
          rope[pos * 32 + j] = (float)cs; rope[pos * 32 + 16 + j] = (float)sn; } }
    { const float* x = a.in[0]; bf16* xb = (bf16*)(ws + WS_XB); pg8::ssq_t* ss0 = (pg8::ssq_t*)(ws + WS_SS);
      for (int m = gw; m < MROWS; m += NGW) { const GAS f32x4* xr = (const GAS f32x4*)(x + (size_t)m * DM) + lane; GAS v2u* o8 = (GAS v2u*)(xb + (size_t)m * DM) + lane; float s = 0.f;
#pragma unroll
          for (int j = 0; j < 8; ++j) { const f32x4 v = xr[64 * j]; s += (v.x * v.x + v.y * v.y) + (v.z * v.z + v.w * v.w); v2u w; w.x = pk2(v.x, v.y); w.y = pk2(v.z, v.w); o8[64 * j] = w; }
          s = wave_sum(s); if (lane == 0) ss0[m] = (pg8::ssq_t)(s * 4294967296.0f); } }
    LAS float* scr = (LAS float*)(lds + wave * 16384);
    for (int job = 0; job < 17; ++job) {
        const float* W; const float* gain = nullptr; bf16* dst; int K = DM, N, mode = 0, rowoff = 0;
        if (job < 2)       { W = a.in[2] + (size_t)job * DM * 8192; N = 8192; gain = a.in[1] + job * DM; dst = (bf16*)(ws + WS_WA_IN) + (size_t)job * 8192 * DM; }
        else if (job < 4)  { const int l = job - 2; W = a.in[4] + (size_t)l * DM * DM; N = DM; dst = (bf16*)(ws + WS_WA_OUT) + (size_t)l * DM * DM; }
        else if (job < 8)  { const int l = job - 4; W = a.in[14] + (size_t)l * DM * 2 * FFH; N = 2 * FFH; gain = a.in[13] + l * DM; dst = (bf16*)(ws + WS_WF_IN) + (size_t)l * 2 * FFH * DM; mode = 1; }
        else if (job < 12) { const int l = job - 8; W = a.in[15] + (size_t)l * FFH * DM; K = FFH; N = DM; dst = (bf16*)(ws + WS_WF_OUT) + (size_t)l * DM * FFH; }
        else if (job == 12) { W = a.in[10]; N = 6144; gain = a.in[9]; dst = (bf16*)(ws + WS_WQKV2); }
        else if (job == 13) { W = a.in[7]; N = 12288; gain = a.in[6]; dst = (bf16*)(ws + WS_WQKV2); rowoff = 6144; }
        else if (job == 14) { W = a.in[10] + (size_t)DM * 6144; N = 6144; gain = a.in[9] + DM; dst = (bf16*)(ws + WS_WQ3); }
        else { const int l = job - 15; W = a.in[12] + (size_t)l * DM * DM; N = DM; dst = (bf16*)(ws + WS_WB_OUT) + (size_t)l * DM * DM; }
        const int nblk = N / 32, nitems = (K / 64) * nblk;
        for (int it = gw; it < nitems; it += NGW) { const int kb = it / nblk, nb = it - kb * nblk, n0 = 32 * nb; int nd0 = n0 + rowoff;
            if (mode == 1) { const int up = n0 >= FFH, jn = up ? n0 - FFH : n0; nd0 = 256 * (jn >> 7) + 128 * up + (jn & 127); }
            conv_item(W, N, K, gain, dst, 64 * kb, n0, nd0, scr, lane); }
    }
}

__device__ __forceinline__ void hgrn_naive(LAS unsigned char* lds, int bh, const bf16* Qb, const bf16* Kb, bf16* Vb, const float* LOGF, const bf16* SGb, const float* ogain) {
    int tid_ = threadIdx.x; asm volatile("" : "+v"(tid_));
    const int tid = tid_, b = bh >> 4, h = bh & 15, v = tid & 127, kg = tid >> 7;
    LAS float* Lf = (LAS float*)lds; LAS float* Lk = Lf + 2048; LAS float* Lq = Lk + 2048; LAS float* Lv = Lq + 2048; LAS float* Lp = Lv + 2048;
    float S[32];
#pragma unroll
    for (int j = 0; j < 32; ++j) S[j] = 0.f;
    const int stok = tid >> 5, sch = (tid & 31) * 4;
    for (int t0 = 0; t0 < SEQ; t0 += 16) {
        { const size_t off = (size_t)(b * SEQ + t0 + stok) * DM + h * HDIM + sch;
          const f32x4 lf = *(const f32x4*)(LOGF + off); const v2u kq = *(const v2u*)(Kb + off), qq = *(const v2u*)(Qb + off), vq = *(const v2u*)(Vb + off);
          *(LAS f32x4*)(Lf + stok * 128 + sch) = (f32x4){__expf(lf.x), __expf(lf.y), __expf(lf.z), __expf(lf.w)};
          *(LAS f32x4*)(Lk + stok * 128 + sch) = (f32x4){bflo(kq.x), bfhi(kq.x), bflo(kq.y), bfhi(kq.y)};
          *(LAS f32x4*)(Lq + stok * 128 + sch) = (f32x4){bflo(qq.x), bfhi(qq.x), bflo(qq.y), bfhi(qq.y)};
          *(LAS f32x4*)(Lv + stok * 128 + sch) = (f32x4){bflo(vq.x), bfhi(vq.x), bflo(vq.y), bfhi(vq.y)}; }
        __syncthreads();
        for (int tok = 0; tok < 16; ++tok) { const float vv = Lv[tok * 128 + v]; float acc = 0.f;
#pragma unroll
            for (int j4 = 0; j4 < 8; ++j4) { const f32x4 f = *(const LAS f32x4*)(Lf + tok * 128 + kg * 32 + 4 * j4), kk = *(const LAS f32x4*)(Lk + tok * 128 + kg * 32 + 4 * j4), qq = *(const LAS f32x4*)(Lq + tok * 128 + kg * 32 + 4 * j4);
#pragma unroll
                for (int e = 0; e < 4; ++e) { S[4 * j4 + e] = f[e] * S[4 * j4 + e] + kk[e] * vv; acc += qq[e] * S[4 * j4 + e]; } }
            Lp[(tok * 4 + kg) * 128 + v] = acc; }
        __syncthreads();
        { f32x4 o = *(const LAS f32x4*)(Lp + (stok * 4 + 0) * 128 + sch);
#pragma unroll
          for (int g = 1; g < 4; ++g) o += *(const LAS f32x4*)(Lp + (stok * 4 + g) * 128 + sch);
          float s = (o.x * o.x + o.y * o.y) + (o.z * o.z + o.w * o.w);
#pragma unroll
          for (int d = 1; d < 32; d <<= 1) s += __shfl_xor(s, d);
          const float sc = 1.0f / sqrtf(s * (1.0f / HDIM) + 1e-6f);
          const size_t off = (size_t)(b * SEQ + t0 + stok) * DM + h * HDIM + sch;
          const f32x4 gn = *(const f32x4*)(ogain + sch); const v2u sg = *(const v2u*)(SGb + off);
          v2u w; w.x = pk2(o.x * sc * gn.x * bflo(sg.x), o.y * sc * gn.y * bfhi(sg.x)); w.y = pk2(o.z * sc * gn.z * bflo(sg.y), o.w * sc * gn.w * bfhi(sg.y));
          *(v2u*)(Vb + off) = w; }
        __syncthreads();
    }
}

__device__ __forceinline__ void combine_phase(const bf16* OG, const float* LSE, bf16* OC) {
    const size_t nitem = (size_t)MROWS * (DM / 8), stride = (size_t)gridDim.x * blockDim.x;
    for (size_t i = (size_t)blockIdx.x * blockDim.x + threadIdx.x; i < nitem; i += stride) {
        const size_t tok = i >> 8; const int c = (int)(i & 255) * 8, h = c >> 7;
        const float l0 = LSE[tok * 48 + h], l1 = LSE[tok * 48 + 16 + h], l2 = LSE[tok * 48 + 32 + h];
        const float mx = fmaxf(l0, fmaxf(l1, l2)); float w0 = __expf(l0 - mx), w1 = __expf(l1 - mx), w2 = __expf(l2 - mx); const float inv = 1.0f / (w0 + w1 + w2); w0 *= inv; w1 *= inv; w2 *= inv;
        const v4u a = *(const v4u*)(OG + tok * 6144 + c), bb = *(const v4u*)(OG + tok * 6144 + 2048 + c), cc = *(const v4u*)(OG + tok * 6144 + 4096 + c);
        v4u o;
#pragma unroll
        for (int e = 0; e < 4; ++e) o[e] = pk2(w0 * bflo(a[e]) + w1 * bflo(bb[e]) + w2 * bflo(cc[e]), w0 * bfhi(a[e]) + w1 * bfhi(bb[e]) + w2 * bfhi(cc[e]));
        *(v4u*)(OC + tok * DM + c) = o;
    }
}

#define GRID_BAR() xcd_barrier(bar)
template <int LAYER>
__device__ __forceinline__ void layer_phases(const Args& args, LAS unsigned char* lds, unsigned char* lds_raw, const XcdBarrier& bar) {
    unsigned char* ws = args.ws; const int G = gridDim.x;
    bf16* XB = (bf16*)(ws + WS_XB); pg8::ssq_t* SS = (pg8::ssq_t*)(ws + WS_SS); float* out = args.out;
    constexpr int ssi = 2 * LAYER;
    if constexpr (LAYER < 2) {
#ifdef HG_SEPARATE_O
        bf16* HGO = (bf16*)(ws + WS_OG);
#else
        bf16* HGO = (bf16*)(ws + WS_R1) + 2 * (size_t)MROWS * DM;
#endif
        bf16* Aq = (bf16*)(ws + WS_R1); bf16* Ak = Aq + (size_t)MROWS * DM; bf16* Av = Ak + (size_t)MROWS * DM; bf16* Asg = Av + (size_t)MROWS * DM; float* Alogf = (float*)(ws + WS_R1 + 256 * MiB);
#ifndef DIS_G1
        {
            pg8::Gemm g{XB, (const bf16*)(ws + WS_WA_IN) + (size_t)LAYER * 8192 * DM, MROWS, 8192, DM}; pg8::StaticOrder S; S.init(MROWS, 8192, G, (int)blockIdx.x);
            pg8::EpiHgrnIn E{Aq, Alogf, SS + (size_t)ssi * MROWS, (const float*)(ws + WS_LBS) + LAYER * DM};
            pg8::gemm_phase<pg8::EpiHgrnIn, pg8::StaticOrder, true, true>(lds, g, S, E);
#ifdef PROBE_REP_GEMM
            pg8::gemm_phase<pg8::EpiHgrnIn, pg8::StaticOrder, true, true>(lds, g, S, E);
#endif
        }
#endif
        GRID_BAR();
#ifndef DIS_HGRN
#ifdef HGRN_BOTH
        for (int bh = blockIdx.x; bh < BATCH * NHEAD; bh += G) hg::hgrn_chunked(lds, bh, Aq, Ak, Av, (bf16*)(ws + WS_OG), Alogf, Asg, args.in[3] + LAYER * HDIM);
        __syncthreads();
        for (int bh = blockIdx.x; bh < BATCH * NHEAD; bh += G) hg::hgrn_chunked(lds, bh, Aq, Ak, Av, (bf16*)(ws + WS_OG + 64 * MiB), Alogf, Asg, args.in[3] + LAYER * HDIM);
        __syncthreads();
        for (int bh = blockIdx.x; bh < BATCH * NHEAD; bh += G) hgrn_naive(lds, bh, Aq, Ak, Av, Alogf, Asg, args.in[3] + LAYER * HDIM);
        GRID_BAR();
        {
            const unsigned* A = (const unsigned*)(ws + WS_OG); const unsigned* B = (const unsigned*)(ws + WS_OG + 64 * MiB); const unsigned* R = (const unsigned*)Av;
            unsigned nbit = 0, ntol = 0;
            for (size_t i = (size_t)blockIdx.x * blockDim.x + threadIdx.x; i < (size_t)MROWS * DM / 2; i += (size_t)gridDim.x * blockDim.x) {
                const unsigned a = A[i], b2 = B[i], r = R[i]; if (a != b2) ++nbit;
                if (fabsf(bflo(a) - bflo(r)) > 0.25f || fabsf(bfhi(a) - bfhi(r)) > 0.25f) ++ntol; }
            if (nbit) atomicAdd((unsigned*)(ws + WS_CTL) + 512, nbit);
            if (ntol) atomicAdd((unsigned*)(ws + WS_CTL) + 513, ntol);
        }
#elif defined(HGRN_NAIVE)
        for (int bh = blockIdx.x; bh < BATCH * NHEAD; bh += G) hgrn_naive(lds, bh, Aq, Ak, Av, Alogf, Asg, args.in[3] + LAYER * HDIM);
#else
        for (int bh = blockIdx.x; bh < BATCH * NHEAD; bh += G) hg::hgrn_chunked(lds, bh, Aq, Ak, Av, HGO, Alogf, Asg, args.in[3] + LAYER * HDIM);
#endif
#endif
        GRID_BAR();
#ifndef DIS_G3
        {
            pg8::Gemm g{HGO, (const bf16*)(ws + WS_WA_OUT) + (size_t)LAYER * DM * DM, MROWS, DM, DM}; pg8::StaticOrder S; S.init(MROWS, DM, G, (int)blockIdx.x);
            pg8::EpiRes E{LAYER == 0 ? args.in[0] : (const float*)out, out, XB, SS + (size_t)(ssi + 1) * MROWS};
            pg8::gemm_phase<pg8::EpiRes, pg8::StaticOrder, true, true>(lds, g, S, E);
        }
#endif
    } else {
        bf16* KB = (bf16*)(ws + WS_R1); bf16* VB = (bf16*)(ws + WS_R1 + 192 * MiB);
        bf16* QO = (bf16*)(ws + WS_R2); bf16* OG = (bf16*)(ws + WS_OG); bf16* OC = (bf16*)(ws + WS_R2 + 192 * MiB); float* LSE = (float*)(ws + WS_R2 + 256 * MiB);
#ifndef DIS_G2
        {
            constexpr int N = LAYER == 2 ? 18432 : 6144;
            pg8::Gemm g{XB, LAYER == 2 ? (const bf16*)(ws + WS_WQKV2) : (const bf16*)(ws + WS_WQ3), MROWS, N, DM}; pg8::StaticOrder S; S.init(MROWS, N, G, (int)blockIdx.x);
            pg8::EpiQkv E{QO, KB, VB, SS + (size_t)ssi * MROWS, args.in[11] + (LAYER - 2) * 3 * HDIM, args.in[8], (const float*)(ws + WS_ROPE)};
            pg8::gemm_phase<pg8::EpiQkv, pg8::StaticOrder, true, true>(lds, g, S, E);
#ifdef PROBE_REP_GEMM
            pg8::gemm_phase<pg8::EpiQkv, pg8::StaticOrder, true, true>(lds, g, S, E);
#endif
        }
#endif
        GRID_BAR();
#ifndef DIS_ATTN
        att::attn_phase((char*)lds_raw, QO, KB, VB, OG, LSE);
#ifdef PROBE_REP_ATTN
        att::attn_phase((char*)lds_raw, QO, KB, VB, OG, LSE);
#endif
#endif
        GRID_BAR();
#ifndef DIS_COMB
        combine_phase(OG, LSE, OC);
#endif
        GRID_BAR();
#ifndef DIS_G3
        {
            pg8::Gemm g{OC, (const bf16*)(ws + WS_WB_OUT) + (size_t)(LAYER - 2) * DM * DM, MROWS, DM, DM}; pg8::StaticOrder S; S.init(MROWS, DM, G, (int)blockIdx.x);
            pg8::EpiRes E{out, out, XB, SS + (size_t)(ssi + 1) * MROWS};
            pg8::gemm_phase<pg8::EpiRes, pg8::StaticOrder, true, true>(lds, g, S, E);
        }
#endif
    }
    GRID_BAR();
    bf16* HB = (bf16*)(ws + WS_R2);
#ifndef DIS_G4
    {
        pg8::Gemm g{XB, (const bf16*)(ws + WS_WF_IN) + (size_t)LAYER * 2 * FFH * DM, MROWS, 2 * FFH, DM}; pg8::StaticOrder S; S.init(MROWS, 2 * FFH, G, (int)blockIdx.x);
        pg8::EpiFfn1 E{HB, FFH, SS + (size_t)(ssi + 1) * MROWS};
        pg8::gemm_phase<pg8::EpiFfn1, pg8::StaticOrder, true, true>(lds, g, S, E);
#ifdef PROBE_REP_GEMM
            pg8::gemm_phase<pg8::EpiFfn1, pg8::StaticOrder, true, true>(lds, g, S, E);
#endif
    }
#endif
    GRID_BAR();
#ifndef DIS_G5
    {
        pg8::Gemm g{HB, (const bf16*)(ws + WS_WF_OUT) + (size_t)LAYER * DM * FFH, MROWS, DM, FFH}; pg8::StaticOrder S; S.init(MROWS, DM, G, (int)blockIdx.x);
        pg8::EpiRes E{out, out, XB, SS + (size_t)(ssi + 2) * MROWS};
        pg8::gemm_phase<pg8::EpiRes, pg8::StaticOrder, true, true>(lds, g, S, E);
    }
#endif
    if constexpr (LAYER < 3) GRID_BAR();
}

__global__ void __launch_bounds__(NWAVES * 64, 2) yoco_fwd(Args args) {
    extern __shared__ __attribute__((aligned(16))) unsigned char lds_raw[];
    LAS unsigned char* lds = (LAS unsigned char*)lds_raw;
    const int tid = threadIdx.x;
    volatile LAS unsigned* MISC = (volatile LAS unsigned*)(lds + MISC_OFF);
    if (tid < 64) MISC[tid] = 0u;
    __syncthreads();
    XcdBarrier bar = xcd_barrier_post((unsigned*)(args.ws + WS_CTL) + CW_BAR, MISC + 8);
#ifndef DIS_PRO
    { const int lane = tid & 63, wave = __builtin_amdgcn_readfirstlane(tid >> 6), G = gridDim.x;
      const int vcu = (G % 8 == 0) ? ((int)blockIdx.x % 8) * (G / 8) + (int)blockIdx.x / 8 : (int)blockIdx.x;
      prologue(args, lds, vcu * NWAVES + wave, G * NWAVES, lane, wave);
#ifdef PROBE_REP_PRO
      prologue(args, lds, vcu * NWAVES + wave, G * NWAVES, lane, wave);
#endif
    }
#endif
    GRID_BAR();
#ifndef ONLY_LAYER
    layer_phases<0>(args, lds, lds_raw, bar);
    layer_phases<1>(args, lds, lds_raw, bar);
    layer_phases<2>(args, lds, lds_raw, bar);
    layer_phases<3>(args, lds, lds_raw, bar);
#else
    layer_phases<ONLY_LAYER>(args, lds, lds_raw, bar);
#endif
#ifdef HGRN_BOTH
    GRID_BAR();
    { const unsigned nbit = __hip_atomic_load((unsigned*)(args.ws + WS_CTL) + 512, __ATOMIC_RELAXED, __HIP_MEMORY_SCOPE_AGENT), ntol = __hip_atomic_load((unsigned*)(args.ws + WS_CTL) + 513, __ATOMIC_RELAXED, __HIP_MEMORY_SCOPE_AGENT);
      if (nbit > 0 && blockIdx.x == 0 && threadIdx.x < 64) args.out[threadIdx.x] = __builtin_nanf("");
      if (ntol > 1000) { for (size_t i = (size_t)blockIdx.x * blockDim.x + threadIdx.x; i < (size_t)MROWS * DM; i += (size_t)gridDim.x * blockDim.x) args.out[i] *= 2.0f; } }
#endif
}

extern "C" void kernel_launch(void* const* d_in, const int* in_sizes, int n_in, void* d_out, int out_size, void* d_ws, size_t ws_size, hipStream_t stream) {
    static int grid = 0;
    if (grid == 0) {
        if (n_in != 16 || out_size != MROWS * DM || ws_size < WS_END) { fprintf(stderr, "kernel_launch: unexpected shapes (n_in %d out %d ws %zu)\n", n_in, out_size, ws_size); grid = -1; return; }
        int dev = 0, cus = 0, per_cu = 0;
        if (hipGetDevice(&dev) != hipSuccess || hipDeviceGetAttribute(&cus, hipDeviceAttributeMultiprocessorCount, dev) != hipSuccess) { grid = -1; return; }
        if (hipFuncSetAttribute((const void*)yoco_fwd, hipFuncAttributeMaxDynamicSharedMemorySize, LDS_BYTES) != hipSuccess) { fprintf(stderr, "kernel_launch: hipFuncSetAttribute failed\n"); grid = -1; return; }
        if (hipOccupancyMaxActiveBlocksPerMultiprocessor(&per_cu, (const void*)yoco_fwd, NWAVES * 64, LDS_BYTES) != hipSuccess || per_cu < 1) { fprintf(stderr, "kernel_launch: occupancy query says %d\n", per_cu); }
        (void)hipGetLastError();
        grid = cus;
    }
    if (grid < 0) return;
    (void)hipMemsetAsync((char*)d_ws + WS_CTL, 0, CTL_ZERO_BYTES, stream);
    Args a{};
    for (int i = 0; i < 16; ++i) a.in[i] = (const float*)d_in[i];
    a.out = (float*)d_out; a.ws = (unsigned char*)d_ws;
    hipLaunchKernelGGL(yoco_fwd, dim3(grid), dim3(NWAVES * 64), LDS_BYTES, stream, a);
}
```

```cpp
#include <hip/hip_runtime.h>
#include <cstdio>
#include <cstdint>
namespace pg8 {
#define PG8_LAS __attribute__((address_space(3)))
typedef unsigned short bf16_t;
typedef short bf16x8 __attribute__((ext_vector_type(8)));
typedef float f32x4 __attribute__((ext_vector_type(4)));
typedef unsigned u32x4 __attribute__((ext_vector_type(4)));
constexpr int BM = 256, BK = 64, HALF = 128, HTB = HALF * BK * 2  , STAGE_BYTES = 8 * HTB, NXCD = 8, WGM = 8;

__host__ __device__ __forceinline__ int lds_byte(int r, int c) { const int st = (r >> 4) * 2 + (c >> 5), rr = r & 15, cc = c & 31, ob = rr * 64 + cc * 2; return st * 1024 + (ob ^ (((ob >> 9) & 1) << 5)); }
__host__ __device__ __forceinline__ void stage_rc(int b, int& R, int& C) { const int st = b / 1024, sb = b % 1024, swz = sb ^ (((sb >> 9) & 1) << 5); R = (st >> 1) * 16 + swz / 64; C = (st & 1) * 32 + (swz % 64) / 2; }
__host__ __device__ __forceinline__ int perm32(int rho) { const int n = rho >> 4, i = rho & 15; return 8 * (i >> 2) + 4 * n + (i & 3); }

struct Unit { int pm, pn; };
struct Gemm { const bf16_t* A; const bf16_t* Bt; int M, N, K; };

struct StaticOrder {
    int nM, nN, nwg, G, c;
    __host__ __device__ void init(int M, int N, int G_, int c_) { nM = M / BM; nN = N / BM; nwg = nM * nN; G = G_; c = c_; }
    __host__ __device__ bool next(int i, Unit& u) const {
        const long L = (long)i * G + c; if (L >= nwg) return false;
        int wgid = (int)L; { const int q = nwg / NXCD, r = nwg % NXCD, xcd = wgid % NXCD, off = wgid / NXCD; wgid = (xcd < r ? xcd * (q + 1) : r * (q + 1) + (xcd - r) * q) + off; }
        const int nig = WGM * nN, gid = wgid / nig, fm = gid * WGM, gsz = (nM - fm) < WGM ? (nM - fm) : WGM;
        u.pm = fm + ((wgid % nig) % gsz); u.pn = (wgid % nig) / gsz; return true;
    }
    __device__ __forceinline__ void a_ready(const Unit&) const {}
    __device__ __forceinline__ void done(const Unit&) const {}
};
struct ProbeOrder00 : StaticOrder {
    __host__ __device__ bool next(int i, Unit& u) const { const long L = (long)i * G + c; if (L >= nwg) return false; u.pm = 0; u.pn = 0; return true; }
};
__device__ __forceinline__ unsigned cvt_pk_bf16(float lo, float hi) { unsigned r; asm volatile("v_cvt_pk_bf16_f32 %0, %1, %2" : "=v"(r) : "v"(lo), "v"(hi)); return r; }
template <class Epi, class Sched, bool ALIGN_EPI = false, bool SP2 = false>
__device__ __forceinline__ void gemm_phase(PG8_LAS unsigned char* lds, const Gemm g, const Sched& S, const Epi& E) {
    int tid_ = threadIdx.x; asm volatile("" : "+v"(tid_));
    const int tid = tid_, wid = __builtin_amdgcn_readfirstlane(tid >> 6), lane = tid & 63, wr = wid >> 2, wc = wid & 3, fr = lane & 15, fq = lane >> 4;
    const int K = g.K, nt = K / BK;
    unsigned voffA[2], voffB[2];
#pragma unroll
    for (int i = 0; i < 2; ++i) { int R, C; stage_rc(tid * 16 + i * 8192, R, C); const int Rb = Epi::PERM ? ((R & ~31) + perm32(R & 31)) : R;
        voffA[i] = (unsigned)(R * K + C) * 2u; voffB[i] = (unsigned)(Rb * K + C) * 2u; }
    const size_t kstep = (size_t)(BK * 2);
    const size_t hstep = (size_t)HALF * K * 2;
    const size_t tstep = 2 * hstep;
    const unsigned ldsw = (unsigned)wid * 1024u;
    const int aoff = lds_byte(wr * 64 + fr, fq * 8), boff = lds_byte(wc * 32 + fr, fq * 8);
#define PG8_SA(b, h) (((b) * 2 + (h)) * HTB)
#define PG8_SB(b, h) ((4 + (b) * 2 + (h)) * HTB)
#define PG8_STAGE(bufoff, gbase, voff) do { _Pragma("unroll") for (int _i = 0; _i < 2; ++_i) \
        __builtin_amdgcn_global_load_lds((const unsigned*)((const char*)(gbase) + (voff)[_i]), (PG8_LAS unsigned*)(lds + (bufoff) + ldsw + _i * 8192), 16, 0, 0); } while (0)
#define PG8_LDA(dst, b, h) do { _Pragma("unroll") for (int m = 0; m < 4; ++m) _Pragma("unroll") for (int k = 0; k < 2; ++k) dst[m][k] = *(const PG8_LAS bf16x8*)(lds + PG8_SA(b, h) + aoff + m * 2048 + k * 1024); } while (0)
#define PG8_LDB(dst, b, h) do { _Pragma("unroll") for (int n = 0; n < 2; ++n) _Pragma("unroll") for (int k = 0; k < 2; ++k) dst[n][k] = *(const PG8_LAS bf16x8*)(lds + PG8_SB(b, h) + boff + n * 2048 + k * 1024); } while (0)
#define PG8_MMA(ai, bj, At, Bt) do { __builtin_amdgcn_s_setprio(1); _Pragma("unroll") for (int m = 0; m < 4; ++m) _Pragma("unroll") for (int n = 0; n < 2; ++n) _Pragma("unroll") for (int k = 0; k < 2; ++k) \
        acc[ai][bj][m][n] = __builtin_amdgcn_mfma_f32_16x16x32_bf16(Bt[n][k], At[m][k], acc[ai][bj][m][n], 0, 0, 0); __builtin_amdgcn_s_setprio(0); } while (0)
#define PG8_WAIT_V(n) asm volatile("s_waitcnt vmcnt(" #n ")" ::: "memory")
#define PG8_WAIT_L(n) asm volatile("s_waitcnt lgkmcnt(" #n ")" ::: "memory")
#define PG8_BAR __builtin_amdgcn_s_barrier()
#define PG8_SCHED __builtin_amdgcn_sched_barrier(0)
    Unit cur, nxt; int ui = 0;
    if (!S.next(0, cur)) return;
    f32x4 acc[2][2][4][2];
#pragma unroll
    for (int a = 0; a < 2; ++a)
#pragma unroll
        for (int b = 0; b < 2; ++b)
#pragma unroll
            for (int m = 0; m < 4; ++m)
#pragma unroll
                for (int n = 0; n < 2; ++n) acc[a][b][m][n] = (f32x4){0.f, 0.f, 0.f, 0.f};
    bf16x8 At[4][2], B0[2][2], B1[2][2];
    const char* cA = (const char*)g.A + (size_t)cur.pm * tstep; const char* cB = (const char*)g.Bt + (size_t)cur.pn * tstep;
    S.a_ready(cur);
    if constexpr (SP2) {
        PG8_STAGE(PG8_SB(0, 0), cB, voffB); PG8_STAGE(PG8_SB(0, 1), cB + hstep, voffB); PG8_STAGE(PG8_SA(0, 0), cA, voffA); PG8_STAGE(PG8_SA(0, 1), cA + hstep, voffA);
        if (wr == 1) PG8_BAR;
        PG8_WAIT_V(2); PG8_BAR;
        PG8_STAGE(PG8_SB(1, 0), cB + kstep, voffB); PG8_STAGE(PG8_SA(1, 0), cA + kstep, voffA); PG8_STAGE(PG8_SB(1, 1), cB + hstep + kstep, voffB);
        PG8_WAIT_V(6); PG8_BAR;
    } else {
        PG8_STAGE(PG8_SB(0, 0), cB, voffB); PG8_STAGE(PG8_SA(0, 0), cA, voffA); PG8_STAGE(PG8_SB(0, 1), cB + hstep, voffB); PG8_STAGE(PG8_SA(0, 1), cA + hstep, voffA);
        if (wr == 1) PG8_BAR;
        PG8_WAIT_V(4); PG8_BAR;
        PG8_STAGE(PG8_SB(1, 0), cB + kstep, voffB); PG8_STAGE(PG8_SA(1, 0), cA + kstep, voffA); PG8_STAGE(PG8_SB(1, 1), cB + hstep + kstep, voffB);
        PG8_WAIT_V(6); PG8_BAR;
    }
    for (;;) {
        const bool has_next = S.next(ui + 1, nxt);
        const char* nA = has_next ? (const char*)g.A + (size_t)nxt.pm * tstep : cA; const char* nB = has_next ? (const char*)g.Bt + (size_t)nxt.pn * tstep : cB;
        for (int t = 0; t < nt; t += 2) {
            const bool last = (t == nt - 2);
            const char* a1 = cA + (size_t)(t + 1) * kstep;
            const char* a2 = last ? nA : cA + (size_t)(t + 2) * kstep; const char* b2 = last ? nB : cB + (size_t)(t + 2) * kstep;
            const char* a3 = a2 + kstep; const char* b3 = b2 + kstep;
            if (last && has_next) S.a_ready(nxt);
            if constexpr (SP2) {
            PG8_LDB(B0, 0, 0); PG8_LDB(B1, 0, 1); PG8_SCHED; PG8_LDA(At, 0, 0); PG8_STAGE(PG8_SA(1, 1), a1 + hstep, voffA);
            PG8_WAIT_V(8); PG8_WAIT_L(0); PG8_BAR; PG8_MMA(0, 0, At, B0); PG8_MMA(0, 1, At, B1); PG8_BAR; PG8_SCHED;
            PG8_LDA(At, 0, 1); PG8_STAGE(PG8_SB(0, 0), b2, voffB); PG8_STAGE(PG8_SB(0, 1), b2 + hstep, voffB); PG8_STAGE(PG8_SA(0, 0), a2, voffA);
            PG8_WAIT_V(8); PG8_WAIT_L(0); PG8_BAR; PG8_MMA(1, 0, At, B0); PG8_MMA(1, 1, At, B1); PG8_BAR; PG8_SCHED;
            PG8_LDB(B0, 1, 0); PG8_LDB(B1, 1, 1); PG8_SCHED; PG8_LDA(At, 1, 0); PG8_STAGE(PG8_SA(0, 1), a2 + hstep, voffA);
            PG8_WAIT_V(8); PG8_WAIT_L(0); PG8_BAR; PG8_MMA(0, 0, At, B0); PG8_MMA(0, 1, At, B1); PG8_BAR; PG8_SCHED;
            PG8_LDA(At, 1, 1); PG8_STAGE(PG8_SB(1, 0), b3, voffB); PG8_STAGE(PG8_SB(1, 1), b3 + hstep, voffB); PG8_STAGE(PG8_SA(1, 0), a3, voffA);
            PG8_WAIT_V(8); PG8_WAIT_L(0); PG8_BAR; PG8_MMA(1, 0, At, B0); PG8_MMA(1, 1, At, B1); PG8_BAR; PG8_SCHED;
            } else {
            PG8_LDB(B0, 0, 0); PG8_SCHED; PG8_LDA(At, 0, 0); PG8_STAGE(PG8_SA(1, 1), a1 + hstep, voffA);
            PG8_WAIT_L(8); PG8_BAR; PG8_WAIT_L(0); PG8_MMA(0, 0, At, B0); PG8_BAR; PG8_SCHED;
            PG8_LDB(B1, 0, 1); PG8_STAGE(PG8_SB(0, 0), b2, voffB);
            PG8_BAR; PG8_WAIT_L(0); PG8_MMA(0, 1, At, B1); PG8_BAR;
            PG8_LDA(At, 0, 1); PG8_STAGE(PG8_SA(0, 0), a2, voffA);
            PG8_BAR; PG8_WAIT_L(0); PG8_MMA(1, 0, At, B0); PG8_BAR; PG8_SCHED;
            PG8_STAGE(PG8_SB(0, 1), b2 + hstep, voffB);
            PG8_WAIT_V(6); PG8_BAR; PG8_MMA(1, 1, At, B1); PG8_BAR;
            PG8_LDB(B0, 1, 0); PG8_SCHED; PG8_LDA(At, 1, 0); PG8_STAGE(PG8_SA(0, 1), a2 + hstep, voffA);
            PG8_WAIT_L(8); PG8_BAR; PG8_WAIT_L(0); PG8_MMA(0, 0, At, B0); PG8_BAR; PG8_SCHED;
            PG8_LDB(B1, 1, 1); PG8_STAGE(PG8_SB(1, 0), b3, voffB);
            PG8_BAR; PG8_WAIT_L(0); PG8_MMA(0, 1, At, B1); PG8_BAR;
            PG8_LDA(At, 1, 1); PG8_STAGE(PG8_SA(1, 0), a3, voffA);
            PG8_BAR; PG8_WAIT_L(0); PG8_MMA(1, 0, At, B0); PG8_BAR; PG8_SCHED;
            PG8_STAGE(PG8_SB(1, 1), b3 + hstep, voffB);
            PG8_WAIT_V(6); PG8_BAR; PG8_MMA(1, 1, At, B1); PG8_BAR;
            }
        }
        if constexpr (ALIGN_EPI) { if (wr == 0) PG8_BAR; }
        E(acc, cur, wr, wc, fr, fq, lds);
        if (!has_next) break;
#pragma unroll
        for (int a = 0; a < 2; ++a)
#pragma unroll
            for (int b = 0; b < 2; ++b)
#pragma unroll
                for (int m = 0; m < 4; ++m)
#pragma unroll
                    for (int n = 0; n < 2; ++n) acc[a][b][m][n] = (f32x4){0.f, 0.f, 0.f, 0.f};
        cur = nxt; cA = nA; cB = nB; ++ui;
        if constexpr (ALIGN_EPI) { if (wr == 1) PG8_BAR; }
    }
    PG8_WAIT_V(0);
    if constexpr (!ALIGN_EPI) { if (wr == 0) PG8_BAR; }
    PG8_BAR;
#undef PG8_SA
#undef PG8_SB
#undef PG8_STAGE
#undef PG8_LDA
#undef PG8_LDB
#undef PG8_MMA
#undef PG8_WAIT_V
#undef PG8_WAIT_L
#undef PG8_BAR
#undef PG8_SCHED
}
}
namespace pg8 {
constexpr int DMODEL = 2048;
constexpr float RMS_EPS = 1e-6f;
__device__ __forceinline__ float fast_exp(float x) { return __builtin_amdgcn_exp2f(x * 1.4426950408889634f); }
__device__ __forceinline__ float fast_log(float x) { return __builtin_amdgcn_logf(x) * 0.6931471805599453f; }
__device__ __forceinline__ float fast_rcp(float x) { return __builtin_amdgcn_rcpf(x); }
__device__ __forceinline__ float silu_f(float v) { return v * fast_rcp(1.0f + fast_exp(-v)); }
__device__ __forceinline__ u32x4 pack8_bf16(const f32x4 a, const f32x4 b) { u32x4 w; w.x = cvt_pk_bf16(a[0], a[1]); w.y = cvt_pk_bf16(a[2], a[3]); w.z = cvt_pk_bf16(b[0], b[1]); w.w = cvt_pk_bf16(b[2], b[3]); return w; }
typedef unsigned long long ssq_t;
__device__ __forceinline__ float ss_rsq(const ssq_t* ss, int row) { return __builtin_amdgcn_rsqf((float)ss[row] * (2.3283064365386963e-10f / DMODEL) + RMS_EPS); }
__device__ __forceinline__ void row_scales(float (&rs)[2][4], const ssq_t* ss, int row0) {
#pragma unroll
    for (int ai = 0; ai < 2; ++ai)
#pragma unroll
        for (int m = 0; m < 4; ++m) rs[ai][m] = ss_rsq(ss, row0 + ai * HALF + m * 16);
}

__device__ __forceinline__ void fz_one(float z, float l, float& k, float& logf) {
    const float e = fast_exp(-__builtin_fabsf(z)), inv = fast_rcp(1.0f + e), sm = e * inv;
    const float sig = z >= 0.f ? inv : sm, nsig = z >= 0.f ? sm : inv;
    k = (1.0f - l) * nsig; logf = fast_log(l + (1.0f - l) * sig);
}

struct EpiHgrnIn {
    static constexpr bool PERM = true, AFTER_DRAIN = false;
    bf16_t* QKVG; float* LOGF; const ssq_t* ss; const float* lb;
    static constexpr size_t TSTRIDE = (size_t)16384 * DMODEL;
    __device__ __forceinline__ void operator()(const f32x4 (&acc)[2][2][4][2], const Unit& u, int wr, int wc, int fr, int fq, PG8_LAS unsigned char*) const {
        const int row0 = u.pm * BM + wr * 64 + fr, type = u.pn >> 3, col0 = (u.pn & 7) * BM + wc * 32 + 8 * fq;
        if (type == 1) {
#pragma unroll
            for (int bj = 0; bj < 2; ++bj) { const f32x4 lb0 = *(const f32x4*)(lb + col0 + bj * HALF), lb1 = *(const f32x4*)(lb + col0 + bj * HALF + 4);
#pragma unroll
                for (int ai = 0; ai < 2; ++ai)
#pragma unroll
                    for (int m = 0; m < 4; ++m) { const int row = row0 + ai * HALF + m * 16; const size_t off = (size_t)row * DMODEL + col0 + bj * HALF;
                        const float rs = ss_rsq(ss, row); f32x4 kk0, kk1, lf0, lf1;
#pragma unroll
                        for (int j = 0; j < 4; ++j) { float ka, la, kb, lb_; fz_one(acc[ai][bj][m][0][j] * rs, lb0[j], ka, la); fz_one(acc[ai][bj][m][1][j] * rs, lb1[j], kb, lb_); kk0[j] = ka; lf0[j] = la; kk1[j] = kb; lf1[j] = lb_; }
                        *(u32x4*)(QKVG + TSTRIDE + off) = pack8_bf16(kk0, kk1);
                        *(f32x4*)(LOGF + off) = lf0; *(f32x4*)(LOGF + off + 4) = lf1;
                        asm volatile("" ::: "memory"); } }
        } else {
            bf16_t* dst = QKVG + (size_t)(type == 0 ? 0 : type) * TSTRIDE;
#pragma unroll
            for (int ai = 0; ai < 2; ++ai)
#pragma unroll
                for (int m = 0; m < 4; ++m) { const int row = row0 + ai * HALF + m * 16; const size_t off = (size_t)row * DMODEL + col0;
                    const float rs = ss_rsq(ss, row);
#pragma unroll
                    for (int bj = 0; bj < 2; ++bj) { f32x4 v0 = acc[ai][bj][m][0] * rs, v1 = acc[ai][bj][m][1] * rs;
                        if (type == 3) {
#pragma unroll
                            for (int j = 0; j < 4; ++j) { v0[j] = silu_f(v0[j]); v1[j] = silu_f(v1[j]); } }
                        *(u32x4*)(dst + off + bj * HALF) = pack8_bf16(v0, v1); }
                    asm volatile("" ::: "memory"); }
        }
    }
};

struct EpiRes {
    static constexpr bool PERM = true, AFTER_DRAIN = false;
    const float* resid; float* out; bf16_t* xb; ssq_t* ssn;
    __device__ __forceinline__ void operator()(const f32x4 (&acc)[2][2][4][2], const Unit& u, int wr, int wc, int fr, int fq, PG8_LAS unsigned char*) const {
        const int row0 = u.pm * BM + wr * 64 + fr, col0 = u.pn * BM + wc * 32 + 8 * fq;
#pragma unroll
        for (int ai = 0; ai < 2; ++ai)
#pragma unroll
            for (int m = 0; m < 4; ++m) { const int row = row0 + ai * HALF + m * 16; const size_t off = (size_t)row * DMODEL + col0; float s = 0.f;
#pragma unroll
                for (int bj = 0; bj < 2; ++bj) { const f32x4 r0 = *(const f32x4*)(resid + off + bj * HALF), r1 = *(const f32x4*)(resid + off + bj * HALF + 4);
                    const f32x4 x0 = acc[ai][bj][m][0] + r0, x1 = acc[ai][bj][m][1] + r1;
                    *(f32x4*)(out + off + bj * HALF) = x0; *(f32x4*)(out + off + bj * HALF + 4) = x1;
                    *(u32x4*)(xb + off + bj * HALF) = pack8_bf16(x0, x1);
                    s += (x0[0] * x0[0] + x0[1] * x0[1]) + (x0[2] * x0[2] + x0[3] * x0[3]) + (x1[0] * x1[0] + x1[1] * x1[1]) + (x1[2] * x1[2] + x1[3] * x1[3]); }
                s += __shfl_xor(s, 16); s += __shfl_xor(s, 32);
                if (fq == 0) atomicAdd(ssn + row, (ssq_t)(s * 4294967296.0f)); }
    }
};

struct EpiFfn1 {
    static constexpr bool PERM = true, AFTER_DRAIN = false;
    bf16_t* H; int ldh; const ssq_t* ss;
    __device__ __forceinline__ void operator()(const f32x4 (&acc)[2][2][4][2], const Unit& u, int wr, int wc, int fr, int fq, PG8_LAS unsigned char*) const {
        const int row0 = u.pm * BM + wr * 64 + fr, col0 = u.pn * HALF + wc * 32 + 8 * fq;
        float rs[2][4]; row_scales(rs, ss, row0);
#pragma unroll
        for (int ai = 0; ai < 2; ++ai)
#pragma unroll
            for (int m = 0; m < 4; ++m) { f32x4 h[2];
#pragma unroll
                for (int n = 0; n < 2; ++n)
#pragma unroll
                    for (int j = 0; j < 4; ++j) { const float g = acc[ai][0][m][n][j] * rs[ai][m], up = acc[ai][1][m][n][j] * rs[ai][m]; h[n][j] = silu_f(g) * up; }
                *(u32x4*)(H + (size_t)(row0 + ai * HALF + m * 16) * ldh + col0) = pack8_bf16(h[0], h[1]); }
    }
};

constexpr int QKV_SCR_OFF = 131072;
struct EpiQkv {
    static constexpr bool PERM = true, AFTER_DRAIN = false;
    bf16_t *Qo, *Ko, *Vo; const ssq_t* ss; const float* qgain; const float* kgain; const float* rope;
    __device__ __forceinline__ void operator()(const f32x4 (&acc)[2][2][4][2], const Unit& u, int wr, int wc, int fr, int fq, PG8_LAS unsigned char* lds) const {
        const int kind = u.pn / 24, pt = u.pn - kind * 24, grp = pt >> 3;
        const int row0 = u.pm * BM + wr * 64 + fr, col0 = pt * BM + wc * 32 + 8 * fq;
        float rs[2][4]; row_scales(rs, ss, row0);
        if (kind == 2) {
#pragma unroll
            for (int ai = 0; ai < 2; ++ai)
#pragma unroll
                for (int m = 0; m < 4; ++m) { const size_t off = (size_t)(row0 + ai * HALF + m * 16) * 6144 + col0;
#pragma unroll
                    for (int bj = 0; bj < 2; ++bj) *(u32x4*)(Vo + off + bj * HALF) = pack8_bf16(acc[ai][bj][m][0] * rs[ai][m], acc[ai][bj][m][1] * rs[ai][m]); }
            return;
        }
        PG8_LAS float* scr = (PG8_LAS float*)(lds + QKV_SCR_OFF);
#pragma unroll
        for (int ai = 0; ai < 2; ++ai)
#pragma unroll
            for (int m = 0; m < 4; ++m)
#pragma unroll
                for (int bj = 0; bj < 2; ++bj) { const f32x4 a = acc[ai][bj][m][0] * rs[ai][m], b = acc[ai][bj][m][1] * rs[ai][m];
                    float s = (a[0] * a[0] + a[1] * a[1]) + (a[2] * a[2] + a[3] * a[3]) + (b[0] * b[0] + b[1] * b[1]) + (b[2] * b[2] + b[3] * b[3]);
                    s += __shfl_xor(s, 16); s += __shfl_xor(s, 32);
                    if (fq == 0) scr[((ai * HALF + wr * 64 + m * 16 + fr) * 2 + bj) * 4 + wc] = s; }
        asm volatile("s_waitcnt lgkmcnt(0)" ::: "memory"); __builtin_amdgcn_s_barrier(); asm volatile("" ::: "memory");
        const float* gain = (kind == 0 ? qgain : kgain) + grp * 128 + wc * 32 + 8 * fq;
        const f32x4 g0 = *(const f32x4*)gain, g1 = *(const f32x4*)(gain + 4);
        bf16_t* dst = kind == 0 ? Qo : Ko;
#pragma unroll
        for (int ai = 0; ai < 2; ++ai)
#pragma unroll
            for (int m = 0; m < 4; ++m) { const int row = row0 + ai * HALF + m * 16; const size_t off = (size_t)row * 6144 + col0;
                f32x4 c0 = {1.f, 1.f, 1.f, 1.f}, c1 = c0, s0 = {0.f, 0.f, 0.f, 0.f}, s1 = s0;
                if (wc == 0) { const float* rp = rope + (size_t)(row & 4095) * 32 + 8 * (fq & 1);
                    c0 = *(const f32x4*)rp; c1 = *(const f32x4*)(rp + 4); s0 = *(const f32x4*)(rp + 16); s1 = *(const f32x4*)(rp + 20);
                    if (fq < 2) { s0 = -s0; s1 = -s1; } }
#pragma unroll
                for (int bj = 0; bj < 2; ++bj) { const f32x4 p = *(const PG8_LAS f32x4*)(scr + ((ai * HALF + wr * 64 + m * 16 + fr) * 2 + bj) * 4);
                    const float sc = __builtin_amdgcn_rsqf(((p[0] + p[1]) + (p[2] + p[3])) * (1.0f / 128.0f) + RMS_EPS) * rs[ai][m];
                    f32x4 v0 = acc[ai][bj][m][0] * sc * g0, v1 = acc[ai][bj][m][1] * sc * g1;
                    if (wc == 0) { f32x4 p0, p1;
#pragma unroll
                        for (int j = 0; j < 4; ++j) { p0[j] = __shfl_xor(v0[j], 32); p1[j] = __shfl_xor(v1[j], 32); }
                        v0 = v0 * c0 + p0 * s0; v1 = v1 * c1 + p1 * s1; }
                    *(u32x4*)(dst + off + bj * HALF) = pack8_bf16(v0, v1); } }
    }
};
}
namespace att {
typedef unsigned short bf16;
typedef short bf16x8 __attribute__((ext_vector_type(8)));
typedef short s16x4 __attribute__((ext_vector_type(4)));
typedef float f32x16 __attribute__((ext_vector_type(16)));
typedef float f32x4 __attribute__((ext_vector_type(4)));
typedef unsigned u32x4 __attribute__((ext_vector_type(4)));
constexpr int D = 128, NW = 8, QBLK = 32, KVBLK = 64, QB = NW * QBLK;
constexpr int SHM_V = KVBLK * D * 2, SHM_K = KVBLK * D * 2;
constexpr int LDS_BYTES = 2 * SHM_V + 2 * SHM_K + NW * 64 * 4;
constexpr float SCALE = 0.08838834764831845f;
constexpr float THR = 8.f;
constexpr int W = 129;
constexpr bool SK = true;

#define KSWZ(row, colB) ((row) * 256 + ((colB) ^ (((row) & 7) << 4)))
#define SBAR() __builtin_amdgcn_sched_barrier(0)
__device__ __forceinline__ int v_st(int k, int c) { const int kk = (k & ~0xC) | ((k & 4) << 1) | ((k & 8) >> 1); return ((kk >> 3) * 4 + (c >> 5)) * 512 + ((kk & 7) * 32 + (c & 31)) * 2; }
__device__ __forceinline__ int v_rd_base(int lane) { return ((lane & 3) << 3) | (((lane >> 2) & 3) << 6) | (((lane >> 4) & 1) << 5) | (((lane >> 5) & 1) << 8); }
constexpr int v_rd_off(int d0, int ks, int half) { return d0 * 512 + ks * 4096 + half * 2048; }
__device__ __forceinline__ int crow(int r, int hi) { return (r & 3) + 8 * (r >> 2) + 4 * hi; }
__device__ __forceinline__ unsigned cvtpk(float lo, float hi) { unsigned r; asm volatile("v_cvt_pk_bf16_f32 %0, %1, %2" : "=v"(r) : "v"(lo), "v"(hi)); return r; }
__device__ __forceinline__ bf16x8 ld8(const bf16* p) { return *reinterpret_cast<const bf16x8*>(p); }
__device__ __forceinline__ bf16x8 ld8g(const char* ubase, unsigned voff) { return *reinterpret_cast<const bf16x8*>(ubase + voff); }
__device__ __forceinline__ void mask_tile(f32x16& p0, f32x16& p1, int dq, unsigned Wu) {
    const float NEG = -__builtin_inff();
#pragma unroll
    for (int r = 0; r < 16; ++r) {
        const int c = (r & 3) + 8 * (r >> 2);
        if ((unsigned)(dq - c) >= Wu) p0[r] = NEG;
        if ((unsigned)(dq - c - 32) >= Wu) p1[r] = NEG;
    }
}
__device__ __forceinline__ void partialSM(f32x16& p0, f32x16& p1, float& m_reg, float& mn, float& alpha) {
    float pmax = p0[0];
#pragma unroll
    for (int r = 1; r < 16; ++r) pmax = fmaxf(pmax, p0[r]);
#pragma unroll
    for (int r = 0; r < 16; ++r) pmax = fmaxf(pmax, p1[r]);
    { auto rr = __builtin_amdgcn_permlane32_swap(__float_as_uint(pmax), __float_as_uint(pmax), false, false);
      pmax = fmaxf(__uint_as_float(rr[0]), __uint_as_float(rr[1])); }
    constexpr float C2 = 1.4426950408889634f * SCALE;
    if (__builtin_expect(__all((pmax - m_reg) * SCALE <= THR), 1)) { mn = m_reg; alpha = 1.f; }
    else { mn = fmaxf(m_reg, pmax); alpha = __builtin_amdgcn_exp2f((m_reg - mn) * C2); m_reg = mn; }
    const float mnL = -mn * C2;
#pragma unroll
    for (int r = 0; r < 16; ++r) p0[r] = fmaf(p0[r], C2, mnL);
#pragma unroll
    for (int r = 0; r < 16; ++r) p1[r] = fmaf(p1[r], C2, mnL);
#pragma unroll
    for (int r = 0; r < 16; ++r) p0[r] = __builtin_amdgcn_exp2f(p0[r]);
}
__device__ __forceinline__ void finishSM(f32x16& p0, f32x16& p1, float alpha, float& l_reg, bf16x8& pa0, bf16x8& pa1, bf16x8& pa2, bf16x8& pa3) {
#pragma unroll
    for (int r = 0; r < 16; ++r) p1[r] = __builtin_amdgcn_exp2f(p1[r]);
    float ps = 0;
#pragma unroll
    for (int r = 0; r < 16; ++r) ps += p0[r];
#pragma unroll
    for (int r = 0; r < 16; ++r) ps += p1[r];
    { auto rr = __builtin_amdgcn_permlane32_swap(__float_as_uint(ps), __float_as_uint(ps), false, false);
      ps = __uint_as_float(rr[0]) + __uint_as_float(rr[1]); }
    l_reg = l_reg * alpha + ps;
#define PK4(P, B_, OUT) do { unsigned a0 = cvtpk(P[B_+0], P[B_+1]), a1 = cvtpk(P[B_+2], P[B_+3]);                          \
        unsigned b0 = cvtpk(P[B_+4], P[B_+5]), b1 = cvtpk(P[B_+6], P[B_+7]);                                             \
        auto r0 = __builtin_amdgcn_permlane32_swap(a0, b0, false, false); auto r1 = __builtin_amdgcn_permlane32_swap(a1, b1, false, false); \
        u32x4 w = {r0[0], r1[0], r0[1], r1[1]}; OUT = *reinterpret_cast<bf16x8*>(&w); } while (0)
    PK4(p0, 0, pa0); PK4(p0, 8, pa1); PK4(p1, 0, pa2); PK4(p1, 8, pa3);
#undef PK4
}
template <int KB>
__device__ __forceinline__ void qkt(f32x16& p0, f32x16& p1, const char* K_lds, int r32, int hi, const bf16x8* qr, bool act) {
    if (SK && !act) { const float NEG = -__builtin_inff();
#pragma unroll
        for (int r = 0; r < 16; ++r) { p0[r] = NEG; p1[r] = NEG; } return; }
    p0 = f32x16{}; p1 = f32x16{};
    const char* kb[4];
#pragma unroll
    for (int dd = 0; dd < 4; ++dd) kb[dd] = K_lds + KB * SHM_K + KSWZ(r32, (dd * 16 + hi * 8) * 2);
#pragma unroll
    for (int d0 = 0; d0 < 8; ++d0) { const char* a = kb[d0 & 3] + (d0 >> 2) * 128;
        bf16x8 b0 = *reinterpret_cast<const bf16x8*>(a);
        bf16x8 b1 = *reinterpret_cast<const bf16x8*>(a + 32 * 256);
        p0 = __builtin_amdgcn_mfma_f32_32x32x16_bf16(b0, qr[d0], p0, 0, 0, 0);
        p1 = __builtin_amdgcn_mfma_f32_32x32x16_bf16(b1, qr[d0], p1, 0, 0, 0); }
}
template <int VB>
__device__ __forceinline__ void pv_tile(f32x16* o, int vb0, bf16x8 pa0, bf16x8 pa1, bf16x8 pa2, bf16x8 pa3, bool act) {
    if (SK && !act) return;
#define TRRD(dst, off) asm volatile("ds_read_b64_tr_b16 %0, %1 offset:%2" : "=&v"(dst) : "v"(vb0), "i"(off) : "memory")
#define PV_D0(d0) do { s16x4 l0, l1, l2, l3, h0, h1, h2, h3; constexpr int b_ = VB * SHM_V + v_rd_off(d0, 0, 0);   \
        TRRD(l0, b_); TRRD(h0, b_ + 2048); TRRD(l1, b_ + 4096); TRRD(h1, b_ + 6144); TRRD(l2, b_ + 8192); TRRD(h2, b_ + 10240); TRRD(l3, b_ + 12288); TRRD(h3, b_ + 14336); \
        asm volatile("s_waitcnt lgkmcnt(0)" ::: "memory"); SBAR();   \
        o[d0] = __builtin_amdgcn_mfma_f32_32x32x16_bf16(pa0, (bf16x8){l0[0], l0[1], l0[2], l0[3], h0[0], h0[1], h0[2], h0[3]}, o[d0], 0, 0, 0);   \
        o[d0] = __builtin_amdgcn_mfma_f32_32x32x16_bf16(pa1, (bf16x8){l1[0], l1[1], l1[2], l1[3], h1[0], h1[1], h1[2], h1[3]}, o[d0], 0, 0, 0);   \
        o[d0] = __builtin_amdgcn_mfma_f32_32x32x16_bf16(pa2, (bf16x8){l2[0], l2[1], l2[2], l2[3], h2[0], h2[1], h2[2], h2[3]}, o[d0], 0, 0, 0);   \
        o[d0] = __builtin_amdgcn_mfma_f32_32x32x16_bf16(pa3, (bf16x8){l3[0], l3[1], l3[2], l3[3], h3[0], h3[1], h3[2], h3[3]}, o[d0], 0, 0, 0); } while (0)
    PV_D0(0); PV_D0(1); PV_D0(2); PV_D0(3);
#undef PV_D0
#undef TRRD
}

struct BlockRef { const bf16* Q; const bf16* K; const bf16* V; bf16* O; float* LSE; int P0; };
struct Seam { bf16x8 qr[8]; bf16x8 st_v0, st_v1, st_k0, st_k1; };
__device__ __forceinline__ int swa_jlo(int P0) { const int lowk = P0 - W + 1; return lowk > 0 ? lowk / KVBLK : 0; }
#define VMW() asm volatile("s_waitcnt vmcnt(0)" ::: "memory")
#define VMWN(n) asm volatile("s_waitcnt vmcnt(%0)" :: "i"(n) : "memory")
#define SLOAD_H(Kp, Vp, k0, pitch) do { const char* kb_ = (const char*)(Kp) + (size_t)(k0) * (size_t)((pitch) * 2); const char* vb_ = (const char*)(Vp) + (size_t)(k0) * (size_t)((pitch) * 2); \
        S.st_v0 = ld8g(vb_, rowoff); S.st_v1 = ld8g(vb_ + 32 * (pitch) * 2, rowoff); S.st_k0 = ld8g(kb_, rowoff); S.st_k1 = ld8g(kb_ + 32 * (pitch) * 2, rowoff); } while (0)
#define SWRITE_HK(bf) do { *(bf16x8*)(K_lds + (bf) * SHM_K + kws) = S.st_k0; *(bf16x8*)(K_lds + (bf) * SHM_K + kws + 32 * 256) = S.st_k1; } while (0)
#define SWRITE_HV(bf) do { *(bf16x8*)(V_lds + (bf) * SHM_V + vst0) = S.st_v0; *(bf16x8*)(V_lds + (bf) * SHM_V + vst1) = S.st_v1; } while (0)
#define SWRITE_H(bf) do { SWRITE_HV(bf); SWRITE_HK(bf); } while (0)
template <int DIL> __device__ __forceinline__ void swa_prime(const BlockRef& cur, char* lds, Seam& S) {
    constexpr int PITCH = DIL * 6144;
    int tid_ = threadIdx.x; asm volatile("" : "+v"(tid_));
    const int tid = tid_, wid = __builtin_amdgcn_readfirstlane(tid >> 6), lane = tid & 63, r32 = lane & 31, hi = lane >> 5;
    const int sr = tid >> 4, sc = (tid & 15) * 8, kws = KSWZ(sr, sc * 2); char* K_lds = lds + 2 * SHM_V;
    const unsigned rowoff = (unsigned)(sr * PITCH + sc) * 2u, qoff = (unsigned)((wid * QBLK + r32) * PITCH + hi * 8) * 2u;
    const int kb0 = swa_jlo(cur.P0) * KVBLK;
#pragma unroll
    for (int d0 = 0; d0 < 8; ++d0) S.qr[d0] = ld8g((const char*)cur.Q + d0 * 32, qoff);
    SLOAD_H(cur.K, cur.V, kb0, PITCH); VMW(); SWRITE_HK(0);
    __syncthreads();
}
template <int DIL> __device__ __forceinline__ void swa_block(const BlockRef& cur, const BlockRef& nxt, char* lds, Seam& S) {
    constexpr int PITCH = DIL * 6144, LPITCH = DIL * 48, SKV = 4096 / DIL;
    int tid_ = threadIdx.x; asm volatile("" : "+v"(tid_));
    const int tid = tid_, wid = __builtin_amdgcn_readfirstlane(tid >> 6), lane = tid & 63, r32 = lane & 31, hi = lane >> 5;
    const int j_lo = swa_jlo(cur.P0);
    int j_hi = (cur.P0 + QB - 1) / KVBLK + 1; if (j_hi > SKV / KVBLK) j_hi = SKV / KVBLK;
    const int NT = j_hi - j_lo;
    const int kbn = swa_jlo(nxt.P0) * KVBLK;
    const int qlo = cur.P0 + wid * QBLK, qm = qlo + r32 - 4 * hi;
    char* V_lds = lds; char* K_lds = lds + 2 * SHM_V;
    float* ws = (float*)(lds + 2 * SHM_V + 2 * SHM_K) + wid * 64; float* li_l = ws, * al_l = ws + 32;
    float m_reg = -1e30f, l_reg = 0; f32x16 o[4] = {};
    const int sr = tid >> 4, sc = (tid & 15) * 8, vst0 = v_st(sr, sc), vst1 = v_st(32 + sr, sc), kws = KSWZ(sr, sc * 2);
    const unsigned rowoff = (unsigned)(sr * PITCH + sc) * 2u, qoff = (unsigned)((wid * QBLK + r32) * PITCH + hi * 8) * 2u;
    const int vb0 = (int)(uintptr_t)V_lds + v_rd_base(lane);
    const bf16* Kh = cur.K; const bf16* Vh = cur.V; constexpr int pitch = PITCH;
#define RESC(a) do { if (__any((a) < 1.f)) { if (hi == 0) al_l[r32] = (a); asm volatile("s_waitcnt lgkmcnt(0)" ::: "memory");              \
                     for (int d_ = 0; d_ < 4; ++d_) for (int r = 0; r < 16; ++r) o[d_][r] *= al_l[crow(r, hi)]; } } while (0)
#define KBASE(t) ((j_lo + (t)) * KVBLK)
#define ACT(t) (KBASE(t) <= qlo + QBLK - 1 && KBASE(t) + KVBLK - 1 >= qlo - W + 1)
#define MASKT(P0_, P1_, t) do { const int kb_ = KBASE(t); if ((!SK || ACT(t)) && (kb_ + KVBLK - 1 > qlo || kb_ <= qlo + QBLK - 1 - W)) mask_tile(P0_, P1_, qm - kb_, (unsigned)W); } while (0)
#define SEAM_K0() do { VMWN(8); SWRITE_HK(0); SBAR(); } while (0)
    f32x16 pA0, pA1, pB0, pB1; float mnA, mnB, alA, alB; bf16x8 pa0, pa1, pa2, pa3;
    SWRITE_HV(0); SBAR();
    if (NT > 1) { SLOAD_H(Kh, Vh, KBASE(1), pitch); }
    SBAR(); qkt<0>(pA0, pA1, K_lds, r32, hi, S.qr, ACT(0));
    MASKT(pA0, pA1, 0); partialSM(pA0, pA1, m_reg, mnA, alA);
    if (NT > 1) { VMW(); SWRITE_H(1); }
    __syncthreads();
#define HALF_STEP(PX0, PX1, mnX, alX, PY0, PY1, alY, t, KB, VB, SB) do {                                                      \
        SBAR(); qkt<KB>(PX0, PX1, K_lds, r32, hi, S.qr, ACT(t));                                             \
        finishSM(PY0, PY1, alY, l_reg, pa0, pa1, pa2, pa3); SBAR();                                                           \
        if ((t) + 1 < NT) { SLOAD_H(Kh, Vh, KBASE((t) + 1), pitch); SBAR(); }                                               \
        pv_tile<VB>(o, vb0, pa0, pa1, pa2, pa3, ACT((t) - 1)); MASKT(PX0, PX1, (t)); partialSM(PX0, PX1, m_reg, mnX, alX);                                        \
        __syncthreads();                                                                                                      \
        if ((t) + 1 < NT) { VMW(); SWRITE_H(SB); }                                                                          \
        RESC(alX); __syncthreads(); } while (0)
    for (int t = 1; t + 1 < NT; t += 2) {
        HALF_STEP(pB0, pB1, mnB, alB, pA0, pA1, alA, t, 1, 0, 0);
        HALF_STEP(pA0, pA1, mnA, alA, pB0, pB1, alB, t + 1, 0, 1, 1);
    }
    const bool even = (NT & 1) == 0;
    if (even) { SBAR(); qkt<1>(pB0, pB1, K_lds, r32, hi, S.qr, ACT(NT - 1)); SBAR(); }
    SLOAD_H(nxt.K, nxt.V, kbn, PITCH); SBAR();
#pragma unroll
    for (int d0 = 0; d0 < 8; ++d0) S.qr[d0] = ld8g((const char*)nxt.Q + d0 * 32, qoff);
    SBAR();
    finishSM(pA0, pA1, alA, l_reg, pa0, pa1, pa2, pa3); SBAR();
    pv_tile<0>(o, vb0, pa0, pa1, pa2, pa3, ACT(even ? NT - 2 : NT - 1));
    if (even) { MASKT(pB0, pB1, NT - 1); partialSM(pB0, pB1, m_reg, mnB, alB); __syncthreads(); RESC(alB);
        finishSM(pB0, pB1, alB, l_reg, pa0, pa1, pa2, pa3); SBAR(); pv_tile<1>(o, vb0, pa0, pa1, pa2, pa3, ACT(NT - 1)); }
    SBAR(); SEAM_K0();
    if (hi == 0) li_l[r32] = l_reg; asm volatile("s_waitcnt lgkmcnt(0)" ::: "memory");
    float rli[16];
#pragma unroll
    for (int r = 0; r < 16; ++r) rli[r] = __builtin_amdgcn_rcpf(li_l[crow(r, hi)]);
    { char* Ob = (char*)cur.O + (size_t)(wid * QBLK) * (size_t)(PITCH * 2); const unsigned ooff = (unsigned)(4 * hi * PITCH + r32) * 2u;
#pragma unroll
      for (int r = 0; r < 16; ++r) { char* Or = Ob + (size_t)((r & 3) + 8 * (r >> 2)) * (size_t)(PITCH * 2);
#pragma unroll
        for (int d0 = 0; d0 < 4; ++d0) { const float v = o[d0][r] * rli[r];
            const float vn = __shfl_xor(v, 1);
            if ((r32 & 1) == 0) *(unsigned*)(Or + d0 * 64 + ooff) = cvtpk(v, vn); } } }
    if (hi == 0) cur.LSE[(size_t)(wid * QBLK + r32) * (size_t)LPITCH] = m_reg * SCALE + __builtin_amdgcn_logf(l_reg) * 0.6931471805599453f;
    __syncthreads();
#undef RESC
#undef KBASE
#undef ACT
#undef MASKT
#undef SEAM_K0
#undef HALF_STEP
}
#undef VMW
#undef VMWN
#undef SLOAD_H
#undef SWRITE_HK
#undef SWRITE_HV
#undef SWRITE_H
#undef KSWZ
#undef SBAR

template <int DIL> __device__ __forceinline__ BlockRef make_ref(int idx, const bf16* Q, const bf16* K, const bf16* V, bf16* O, float* LSE) {
    constexpr int GI = DIL == 1 ? 0 : (DIL == 4 ? 1 : 2), NQB = 16 / DIL, PITCH = DIL * 6144;
    const int j = idx & 15, h = (idx >> 4) & 15, b = idx >> 8, r = j / NQB, qb = j - r * NQB;
    const size_t base = (size_t)(b * 4096 + r) * 6144 + GI * 2048 + h * 128;
    BlockRef R; R.P0 = qb * QB;
    R.K = K + base; R.V = V + base; R.Q = Q + base + (size_t)R.P0 * (size_t)PITCH; R.O = O + base + (size_t)R.P0 * (size_t)PITCH;
    R.LSE = LSE + (size_t)(b * 4096 + r + R.P0 * DIL) * 48 + GI * 16 + h;
    return R;
}
template <int DIL> __device__ __forceinline__ void attn_group(char* lds, const bf16* Q, const bf16* K, const bf16* V, bf16* O, float* LSE) {
    const int total = 1024, stride = gridDim.x; int L = blockIdx.x; if (L >= total) return;
    BlockRef cur = make_ref<DIL>(L, Q, K, V, O, LSE); Seam S;
    swa_prime<DIL>(cur, lds, S);
    for (;;) {
        const int Ln = L + stride; const bool last = Ln >= total;
        const BlockRef nxt = last ? cur : make_ref<DIL>(Ln, Q, K, V, O, LSE);
        swa_block<DIL>(cur, nxt, lds, S);
        if (last) break;
        cur = nxt; L = Ln;
    }
}
__device__ __forceinline__ void attn_phase(char* lds, const bf16* Q, const bf16* K, const bf16* V, bf16* O, float* LSE) {
#ifndef ATT_ONLY
    attn_group<1>(lds, Q, K, V, O, LSE);
    attn_group<4>(lds, Q, K, V, O, LSE);
    attn_group<16>(lds, Q, K, V, O, LSE);
#else
    attn_group<ATT_ONLY>(lds, Q, K, V, O, LSE);
#endif
}
}
namespace hg {
typedef short bf16x8 __attribute__((ext_vector_type(8)));
typedef short s16x4 __attribute__((ext_vector_type(4)));
typedef float f32x16 __attribute__((ext_vector_type(16)));
typedef float f32x4 __attribute__((ext_vector_type(4)));
typedef float f32x2 __attribute__((ext_vector_type(2)));
typedef unsigned u32x4 __attribute__((ext_vector_type(4)));
#define HLAS __attribute__((address_space(3)))
constexpr int QT_OFF = 0, QT_ST = 264;
constexpr int QH_OFF = 16896, QH_ST = 272;
constexpr int KC_OFF = 34304, KC_ST = 272;
constexpr int KCT_OFF = 51712, KCT_ST = 144;
constexpr int VT_OFF = 70144, VT_ST = 144;
constexpr int GAM_OFF = 88576;
constexpr int TOT_OFF = 89088;
constexpr int OB_OFF = 93184, OB_ST = 132;
constexpr int LDS_END = OB_OFF + 64 * OB_ST * 4;
static_assert(LDS_END <= 131072, "hgrn LDS map");
typedef __bf16 bf16x2_t __attribute__((ext_vector_type(2)));
__device__ __forceinline__ unsigned cvtpk(float lo, float hi) { const f32x2 v = {lo, hi}; const bf16x2_t b = __builtin_convertvector(v, bf16x2_t); return __builtin_bit_cast(unsigned, b); }
__device__ __forceinline__ float ex(float x) { return __builtin_amdgcn_exp2f(x * 1.4426950408889634f); }
__device__ __forceinline__ float blo(unsigned w) { return __builtin_bit_cast(float, w << 16); }
__device__ __forceinline__ float bhi(unsigned w) { return __builtin_bit_cast(float, w & 0xffff0000u); }
__device__ __forceinline__ bf16x8 pack8(const f32x16& x, int o) {
    u32x4 w = {cvtpk(x[o + 0], x[o + 1]), cvtpk(x[o + 2], x[o + 3]), cvtpk(x[o + 4], x[o + 5]), cvtpk(x[o + 6], x[o + 7])}; return __builtin_bit_cast(bf16x8, w); }
__device__ __forceinline__ bf16x8 ld2x8(const HLAS unsigned char* p) {
    const s16x4 lo = *(const HLAS s16x4*)p, hi = *(const HLAS s16x4*)(p + 16); return (bf16x8){lo[0], lo[1], lo[2], lo[3], hi[0], hi[1], hi[2], hi[3]}; }

__device__ __forceinline__ void hgrn_chunked(HLAS unsigned char* lds, int bh, const unsigned short* Qb, const unsigned short* Kb, const unsigned short* Vb, unsigned short* Ob, const float* LOGF, const unsigned short* SGb, const float* ogain) {
    constexpr int SEQ_ = 4096, DM_ = 2048, HD_ = 128;
    int tid_ = threadIdx.x; asm volatile("" : "+v"(tid_));
    const int tid = tid_, wid = __builtin_amdgcn_readfirstlane(tid >> 6), lane = tid & 63, wt = wid >> 2, wv = wid & 3, c = lane & 31, hi = lane >> 5;
    const int b = bh >> 4, h = bh & 15;
    const size_t goff0 = (size_t)(b * SEQ_ + 8 * wid) * DM_ + h * HD_ + 2 * lane;
    const int t4 = tid >> 3, seg = tid & 7;
    f32x4 gn[4];
#pragma unroll
    for (int i = 0; i < 4; ++i) gn[i] = *(const f32x4*)(ogain + 16 * seg + 4 * i);
    f32x16 S[4];
#pragma unroll
    for (int kt = 0; kt < 4; ++kt)
#pragma unroll
        for (int r = 0; r < 16; ++r) S[kt][r] = 0.f;
    f32x2 lf[8]; unsigned qv[8], kv[8], vv[8];
#define HG_LOAD(t0_) do { _Pragma("unroll") for (int i = 0; i < 8; ++i) { const size_t o_ = goff0 + (size_t)((t0_) + i) * DM_; \
        lf[i] = *(const f32x2*)(LOGF + o_); qv[i] = *(const unsigned*)(Qb + o_); kv[i] = *(const unsigned*)(Kb + o_); vv[i] = *(const unsigned*)(Vb + o_); } } while (0)
#ifndef HG_NOPREFETCH
    HG_LOAD(0);
#endif
    HLAS float* TOT = (HLAS float*)(lds + TOT_OFF); HLAS float* GAM = (HLAS float*)(lds + GAM_OFF); HLAS float* OB = (HLAS float*)(lds + OB_OFF);
    for (int ch = 0; ch < SEQ_ / 64; ++ch) {
        const int t0 = ch * 64;
#ifdef HG_NOPREFETCH
        HG_LOAD(t0);
#endif
        float c0[8], c1[8];
        c0[0] = lf[0][0]; c1[0] = lf[0][1];
#pragma unroll
        for (int i = 1; i < 8; ++i) { c0[i] = c0[i - 1] + lf[i][0]; c1[i] = c1[i - 1] + lf[i][1]; }
        *(HLAS f32x2*)(TOT + wid * 128 + 2 * lane) = (f32x2){c0[7], c1[7]};
        __syncthreads();
        {
            float pre0 = 0.f, pre1 = 0.f, tot0 = 0.f, tot1 = 0.f;
#pragma unroll
            for (int w = 0; w < 8; ++w) { const f32x2 tv = *(const HLAS f32x2*)(TOT + w * 128 + 2 * lane); tot0 += tv[0]; tot1 += tv[1]; if (w < wid) { pre0 += tv[0]; pre1 += tv[1]; } }
            float kc0[8], kc1[8];
#pragma unroll
            for (int i = 0; i < 8; ++i) { const float b0 = pre0 + c0[i], b1 = pre1 + c1[i];
                const float q0 = blo(qv[i]), q1 = bhi(qv[i]), k0 = blo(kv[i]), k1 = bhi(kv[i]);
                const int t = 8 * wid + i;
                *(HLAS unsigned*)(lds + QT_OFF + t * QT_ST + lane * 4) = cvtpk(q0 * ex(b0), q1 * ex(b1));
                *(HLAS unsigned*)(lds + QH_OFF + t * QH_ST + lane * 4) = cvtpk(q0 * ex(fminf(b0 - tot0, 80.f)), q1 * ex(fminf(b1 - tot1, 80.f)));
                kc0[i] = k0 * ex(tot0 - b0); kc1[i] = k1 * ex(tot1 - b1);
                *(HLAS unsigned*)(lds + KC_OFF + t * KC_ST + lane * 4) = cvtpk(kc0[i], kc1[i]); }
            *(HLAS u32x4*)(lds + KCT_OFF + (2 * lane) * KCT_ST + wid * 16) = (u32x4){cvtpk(kc0[0], kc0[1]), cvtpk(kc0[2], kc0[3]), cvtpk(kc0[4], kc0[5]), cvtpk(kc0[6], kc0[7])};
            *(HLAS u32x4*)(lds + KCT_OFF + (2 * lane + 1) * KCT_ST + wid * 16) = (u32x4){cvtpk(kc1[0], kc1[1]), cvtpk(kc1[2], kc1[3]), cvtpk(kc1[4], kc1[5]), cvtpk(kc1[6], kc1[7])};
            *(HLAS u32x4*)(lds + VT_OFF + (2 * lane) * VT_ST + wid * 16) = (u32x4){(vv[0] & 0xffffu) | (vv[1] << 16), (vv[2] & 0xffffu) | (vv[3] << 16), (vv[4] & 0xffffu) | (vv[5] << 16), (vv[6] & 0xffffu) | (vv[7] << 16)};
            *(HLAS u32x4*)(lds + VT_OFF + (2 * lane + 1) * VT_ST + wid * 16) = (u32x4){(vv[0] >> 16) | (vv[1] & 0xffff0000u), (vv[2] >> 16) | (vv[3] & 0xffff0000u), (vv[4] >> 16) | (vv[5] & 0xffff0000u), (vv[6] >> 16) | (vv[7] & 0xffff0000u)};
            if (wid == 0) *(HLAS f32x2*)(GAM + 2 * lane) = (f32x2){ex(tot0), ex(tot1)};
        }
#ifndef HG_NOPREFETCH
        if (ch + 1 < SEQ_ / 64) HG_LOAD(t0 + 64);
#endif
        const size_t ooff = (size_t)(b * SEQ_ + t0 + t4) * DM_ + h * HD_ + 16 * seg;
        const u32x4 sg0 = *(const u32x4*)(SGb + ooff), sg1 = *(const u32x4*)(SGb + ooff + 8);
        __syncthreads();
        {
            f32x16 O, X0, X1;
#pragma unroll
            for (int r = 0; r < 16; ++r) { O[r] = 0.f; X0[r] = 0.f; X1[r] = 0.f; }
            const HLAS unsigned char* qhp = lds + QH_OFF + (32 * wt + c) * QH_ST + hi * 16;
            { const HLAS unsigned char* kp = lds + KC_OFF + c * KC_ST + hi * 16;
#pragma unroll
              for (int ks = 0; ks < 8; ++ks) X0 = __builtin_amdgcn_mfma_f32_32x32x16_bf16(*(const HLAS bf16x8*)(kp + ks * 32), *(const HLAS bf16x8*)(qhp + ks * 32), X0, 0, 0, 0); }
            if (wt == 1) { const HLAS unsigned char* kp = lds + KC_OFF + (32 + c) * KC_ST + hi * 16;
#pragma unroll
              for (int ks = 0; ks < 8; ++ks) X1 = __builtin_amdgcn_mfma_f32_32x32x16_bf16(*(const HLAS bf16x8*)(kp + ks * 32), *(const HLAS bf16x8*)(qhp + ks * 32), X1, 0, 0, 0); }
#pragma unroll
            for (int r = 0; r < 16; ++r) { const bool drop = ((r & 3) + 8 * (r >> 2) + 4 * hi) > c; if (wt == 0) { if (drop) X0[r] = 0.f; } else { if (drop) X1[r] = 0.f; } }
            const HLAS unsigned char* vrow = lds + VT_OFF + (32 * wv + c) * VT_ST;
#pragma unroll
            for (int st = 0; st < 2; ++st) O = __builtin_amdgcn_mfma_f32_32x32x16_bf16(pack8(X0, 8 * st), ld2x8(vrow + (16 * st + 4 * hi) * 2), O, 0, 0, 0);
            if (wt == 1) {
#pragma unroll
                for (int st = 0; st < 2; ++st) O = __builtin_amdgcn_mfma_f32_32x32x16_bf16(pack8(X1, 8 * st), ld2x8(vrow + (32 + 16 * st + 4 * hi) * 2), O, 0, 0, 0); }
            const HLAS unsigned char* qtp = lds + QT_OFF + (32 * wt + c) * QT_ST + 8 * hi;
#pragma unroll
            for (int kt = 0; kt < 4; ++kt)
#pragma unroll
                for (int st = 0; st < 2; ++st) O = __builtin_amdgcn_mfma_f32_32x32x16_bf16(ld2x8(qtp + (32 * kt + 16 * st) * 2), pack8(S[kt], 8 * st), O, 0, 0, 0);
            bf16x8 vb[4];
#pragma unroll
            for (int st = 0; st < 4; ++st) vb[st] = *(const HLAS bf16x8*)(vrow + (16 * st + 8 * hi) * 2);
#pragma unroll
            for (int kt = 0; kt < 4; ++kt) {
#pragma unroll
                for (int g = 0; g < 4; ++g) { const f32x4 gm = *(const HLAS f32x4*)(GAM + 32 * kt + 8 * g + 4 * hi);
#pragma unroll
                    for (int j = 0; j < 4; ++j) S[kt][4 * g + j] *= gm[j]; }
                const HLAS unsigned char* kp = lds + KCT_OFF + (32 * kt + c) * KCT_ST + hi * 16;
#pragma unroll
                for (int st = 0; st < 4; ++st) S[kt] = __builtin_amdgcn_mfma_f32_32x32x16_bf16(*(const HLAS bf16x8*)(kp + st * 32), vb[st], S[kt], 0, 0, 0);
            }
#pragma unroll
            for (int r = 0; r < 16; ++r) OB[(32 * wt + (r & 3) + 8 * (r >> 2) + 4 * hi) * OB_ST + 32 * wv + c] = O[r];
        }
        __syncthreads();
        {
            f32x4 o[4]; float s = 0.f;
#pragma unroll
            for (int i = 0; i < 4; ++i) { o[i] = *(const HLAS f32x4*)(OB + t4 * OB_ST + 16 * seg + 4 * i); s += (o[i][0] * o[i][0] + o[i][1] * o[i][1]) + (o[i][2] * o[i][2] + o[i][3] * o[i][3]); }
            s += __shfl_xor(s, 1); s += __shfl_xor(s, 2); s += __shfl_xor(s, 4);
            const float sc = __builtin_amdgcn_rsqf(s * (1.0f / HD_) + 1e-6f);
            u32x4 w0, w1;
#pragma unroll
            for (int e = 0; e < 4; ++e) { const int i = e >> 1, j = (e & 1) * 2;
                w0[e] = cvtpk(o[i][j] * sc * gn[i][j] * blo(sg0[e]), o[i][j + 1] * sc * gn[i][j + 1] * bhi(sg0[e]));
                w1[e] = cvtpk(o[2 + i][j] * sc * gn[2 + i][j] * blo(sg1[e]), o[2 + i][j + 1] * sc * gn[2 + i][j + 1] * bhi(sg1[e])); }
            *(u32x4*)(Ob + ooff) = w0; *(u32x4*)(Ob + ooff + 8) = w1;
        }
#ifdef HG_NOPREFETCH
        __syncthreads();
#endif
    }
#undef HG_LOAD
}
#undef HLAS
}
constexpr int BATCH = 4, SEQ = 4096, DM = 2048, MROWS = BATCH * SEQ, FFH = 5632, NHEAD = 16, HDIM = 128;
constexpr int NWAVES = 8;
constexpr size_t MiB = 1u << 20;
constexpr size_t WS_CTL = 0, WS_SS = 1 * MiB, CTL_ZERO_BYTES = 3 * MiB;
constexpr size_t WS_LBS = 3 * MiB, WS_ROPE = 3 * MiB + 65536;
constexpr size_t WS_W = 4 * MiB;
constexpr size_t WS_WA_IN = WS_W, WS_WA_OUT = WS_W + 64 * MiB, WS_WF_IN = WS_W + 80 * MiB, WS_WF_OUT = WS_W + 256 * MiB,
                 WS_WQKV2 = WS_W + 344 * MiB, WS_WQ3 = WS_W + 416 * MiB, WS_WB_OUT = WS_W + 440 * MiB;
constexpr size_t WS_XB = 460 * MiB;
constexpr size_t WS_R1 = 524 * MiB;
constexpr size_t WS_R2 = 908 * MiB;
constexpr size_t WS_OG = 1168 * MiB;
constexpr size_t WS_END = 1360 * MiB;
constexpr int CW_BAR = 1024;
constexpr int RING_BYTES = 131072, SCR_OFF = 131072, MISC_OFF = 131072 + 8192, LDS_BYTES = 147456;
static_assert(SCR_OFF == pg8::QKV_SCR_OFF, "LDS map");

#define GAS __attribute__((address_space(1)))
#define LAS __attribute__((address_space(3)))
typedef unsigned short bf16;
typedef unsigned v4u __attribute__((ext_vector_type(4)));
typedef unsigned v2u __attribute__((ext_vector_type(2)));
typedef float f32x4 __attribute__((ext_vector_type(4)));
#define LDS_WAIT() asm volatile("s_waitcnt lgkmcnt(0)" ::: "memory")
__device__ __forceinline__ unsigned f2bf(float f) { unsigned u = __builtin_bit_cast(unsigned, f); return (u + 0x7fffu + ((u >> 16) & 1u)) >> 16; }
__device__ __forceinline__ unsigned pk2(float lo, float hi) { return f2bf(lo) | (f2bf(hi) << 16); }
__device__ __forceinline__ float bflo(unsigned w) { return __builtin_bit_cast(float, w << 16); }
__device__ __forceinline__ float bfhi(unsigned w) { return __builtin_bit_cast(float, w & 0xffff0000u); }

#define XB_TMO      128
#define XB_XCNT(j)  (256  + 64 * (j))
#define XB_XSUB(j)  (1280 + 64 * (j))
#define XB_XGEN(j)  (2304 + 64 * (j))
#define XB_TOP      3328
#define XB_TOPGEN   3392
#define XCD_BAR_WORDS 3456
#define XB_SPIN_CAP (1u << 18)

__device__ __forceinline__ unsigned xb_ld(unsigned* p)              { return __hip_atomic_load(p, __ATOMIC_RELAXED, __HIP_MEMORY_SCOPE_AGENT); }
__device__ __forceinline__ unsigned xb_add(unsigned* p, unsigned v) { return __hip_atomic_fetch_add(p, v, __ATOMIC_RELAXED, __HIP_MEMORY_SCOPE_AGENT); }
__device__ __forceinline__ unsigned xb_xcc_id() { return (unsigned)__builtin_amdgcn_s_getreg((3 << 11) | 20) & 0xFu; }
#define XB_SPIN(cond, bar) do { unsigned _sp = 0; while (cond) { __builtin_amdgcn_s_sleep(1); \
    if ((++_sp & 255u) == 0u) { if (xb_ld(&(bar)[XB_TMO])) break; if (_sp > XB_SPIN_CAP) { atomicAdd(&(bar)[XB_TMO], 1u); break; } } } } while (0)

struct XcdBarrier {
    unsigned* bar; unsigned x;
    volatile LAS unsigned* st;
};

__device__ __forceinline__ XcdBarrier xcd_barrier_post(unsigned* bar, volatile LAS unsigned* st) {
    XcdBarrier b; b.bar = bar; b.x = xb_xcc_id(); b.st = st;
    if (threadIdx.x == 0) (void)xb_add(&bar[XB_XCNT(b.x)], 1u);
    return b;
}
__device__ __forceinline__ void xcd_barrier_complete(unsigned* bar, unsigned x, unsigned& nloc, unsigned& nx) {
    const unsigned G = gridDim.x * gridDim.y * gridDim.z;
    unsigned sum, cnt, mine, sp = 0u;
    for (;;) {
        sum = 0u; cnt = 0u; mine = 0u;
#pragma unroll
        for (unsigned j = 0; j < 16; ++j) { const unsigned c = xb_ld(&bar[XB_XCNT(j)]); sum += c; cnt += (c > 0u) ? 1u : 0u; mine = (j == x) ? c : mine; }
        if (sum == G) break;
        __builtin_amdgcn_s_sleep(1);
        if ((++sp & 255u) == 0u) { if (xb_ld(&bar[XB_TMO])) break; if (sp > XB_SPIN_CAP) { atomicAdd(&bar[XB_TMO], 1u); break; } }
    }
    nloc = mine > 0u ? mine : 1u; nx = cnt > 0u ? cnt : 1u;
}

__device__ __forceinline__ void xcd_barrier(const XcdBarrier& b) {
    asm volatile("s_waitcnt vmcnt(0)" ::: "memory");
    __syncthreads();
    if (threadIdx.x == 0) {
        unsigned* bar = b.bar;
        __builtin_amdgcn_s_waitcnt(0);
        unsigned nloc = b.st[0], nx = b.st[1];
        if (nloc == 0u) { xcd_barrier_complete(bar, b.x, nloc, nx); b.st[0] = nloc; b.st[1] = nx; }
        const unsigned old = xb_add(&bar[XB_XSUB(b.x)], 1u);
        const unsigned gen = old / nloc;
        if (old + 1u == (gen + 1u) * nloc) {
            __builtin_amdgcn_fence(__ATOMIC_RELEASE, "agent");
            asm volatile("s_waitcnt vmcnt(0)" ::: "memory");
            const unsigned og = xb_add(&bar[XB_TOP], 1u);
            const unsigned tg = og / nx;
            if (og + 1u == (tg + 1u) * nx) xb_add(&bar[XB_TOPGEN], 1u);
            else XB_SPIN(xb_ld(&bar[XB_TOPGEN]) == tg, bar);
            __builtin_amdgcn_fence(__ATOMIC_ACQUIRE, "agent");
            xb_add(&bar[XB_XGEN(b.x)], 1u);
            asm volatile("s_waitcnt vmcnt(0)" ::: "memory");
        } else {
            XB_SPIN(xb_ld(&bar[XB_XGEN(b.x)]) == gen, bar);
            __builtin_amdgcn_fence(__ATOMIC_ACQUIRE, "agent");
            asm volatile("s_waitcnt vmcnt(0)" ::: "memory");
        }
    }
    __syncthreads();
}


__device__ __forceinline__ float wave_sum(float v) {
#pragma unroll
    for (int o = 1; o < 64; o <<= 1) v += __shfl_xor(v, o);
    return v;
}
__device__ __forceinline__ void conv_item64(const float* W, int ldw, int K, const float* gain, bf16* WT, int k0, int n0, int nd0, LAS float* scr, int lane) {
    float w[64];
    const float* src = W + (size_t)k0 * ldw + n0 + lane;
#pragma unroll
    for (int kk = 0; kk < 64; ++kk) w[kk] = src[(size_t)kk * ldw];
    if (gain) {
#pragma unroll
        for (int kk = 0; kk < 64; ++kk) w[kk] *= gain[k0 + kk]; }
#pragma unroll
    for (int kk = 0; kk < 64; ++kk) scr[kk * 65 + lane] = w[kk];
    LDS_WAIT(); asm volatile("" ::: "memory");
    const int c = lane & 7;
#pragma unroll
    for (int j = 0; j < 8; ++j) { const int n = (lane >> 3) + 8 * j; const LAS float* s = scr + (8 * c) * 65 + n;
        v4u o; o.x = pk2(s[0 * 65], s[1 * 65]); o.y = pk2(s[2 * 65], s[3 * 65]); o.z = pk2(s[4 * 65], s[5 * 65]); o.w = pk2(s[6 * 65], s[7 * 65]);
        *(GAS v4u*)(WT + (size_t)(nd0 + n) * K + k0 + 8 * c) = o; }
    LDS_WAIT(); asm volatile("" ::: "memory");
}

struct Args { const float* in[16]; float* out; unsigned char* ws; };

__device__ __forceinline__ void prologue(const Args& a, LAS unsigned char* lds, int gw, int NGW, int lane, int wave) {
    unsigned char* ws = a.ws;
    { float* lbs = (float*)(ws + WS_LBS); const float* alb = a.in[5];
      for (int i = gw * 64 + lane; i < DM; i += NGW * 64) { const float a0 = alb[i], a1 = alb[DM + i]; float s1 = 1.0f / (1.0f + expf(a0 - a1)); s1 = fminf(fmaxf(s1, 0.0f), 1.0f - 1e-6f); lbs[i] = 0.0f; lbs[DM + i] = s1; } }
    { float* rope = (float*)(ws + WS_ROPE);
      for (int i = gw * 64 + lane; i < SEQ * 16; i += NGW * 64) { const int pos = i >> 4, j = i & 15; double inv = 1.0;
          for (int q = 0; q < j; ++q) inv *= 0.4403666026717805;
          const double ang = (double)pos * inv, nrev = __builtin_rint(ang * 0.15915494309189535);
          const double r = (ang - nrev * 6.283185307179586) - nrev * 2.4492935982947064e-16, r2 = r * r;
          double ts = r, sn = r, tc = 1.0, cs = 1.0;
          for (int q = 1; q <= 14; ++q) { tc *= -r2 / (double)((2 * q - 1) * (2 * q)); cs += tc; ts *= -r2 / (double)((2 * q) * (2 * q + 1)); sn += ts; }
          rope[pos * 32 + j] = (float)cs; rope[pos * 32 + 16 + j] = (float)sn; } }
    { const float* x = a.in[0]; bf16* xb = (bf16*)(ws + WS_XB); pg8::ssq_t* ss0 = (pg8::ssq_t*)(ws + WS_SS);
      for (int m = gw; m < MROWS; m += NGW) { const GAS f32x4* xr = (const GAS f32x4*)(x + (size_t)m * DM) + lane; GAS v2u* o8 = (GAS v2u*)(xb + (size_t)m * DM) + lane; float s = 0.f;
#pragma unroll
          for (int j = 0; j < 8; ++j) { const f32x4 v = xr[64 * j]; s += (v.x * v.x + v.y * v.y) + (v.z * v.z + v.w * v.w); v2u w; w.x = pk2(v.x, v.y); w.y = pk2(v.z, v.w); o8[64 * j] = w; }
          s = wave_sum(s); if (lane == 0) ss0[m] = (pg8::ssq_t)(s * 4294967296.0f); } }
    LAS float* scr = (LAS float*)(lds + wave * 16640);
    for (int job = 0; job < 17; ++job) {
        const float* W; const float* gain = nullptr; bf16* dst; int K = DM, N, mode = 0, rowoff = 0;
        if (job < 2)       { W = a.in[2] + (size_t)job * DM * 8192; N = 8192; gain = a.in[1] + job * DM; dst = (bf16*)(ws + WS_WA_IN) + (size_t)job * 8192 * DM; }
        else if (job < 4)  { const int l = job - 2; W = a.in[4] + (size_t)l * DM * DM; N = DM; dst = (bf16*)(ws + WS_WA_OUT) + (size_t)l * DM * DM; }
        else if (job < 8)  { const int l = job - 4; W = a.in[14] + (size_t)l * DM * 2 * FFH; N = 2 * FFH; gain = a.in[13] + l * DM; dst = (bf16*)(ws + WS_WF_IN) + (size_t)l * 2 * FFH * DM; mode = 1; }
        else if (job < 12) { const int l = job - 8; W = a.in[15] + (size_t)l * FFH * DM; K = FFH; N = DM; dst = (bf16*)(ws + WS_WF_OUT) + (size_t)l * DM * FFH; }
        else if (job == 12) { W = a.in[10]; N = 6144; gain = a.in[9]; dst = (bf16*)(ws + WS_WQKV2); }
        else if (job == 13) { W = a.in[7]; N = 12288; gain = a.in[6]; dst = (bf16*)(ws + WS_WQKV2); rowoff = 6144; }
        else if (job == 14) { W = a.in[10] + (size_t)DM * 6144; N = 6144; gain = a.in[9] + DM; dst = (bf16*)(ws + WS_WQ3); }
        else { const int l = job - 15; W = a.in[12] + (size_t)l * DM * DM; N = DM; dst = (bf16*)(ws + WS_WB_OUT) + (size_t)l * DM * DM; }
        const int nblk = N / 64, nitems = (K / 64) * nblk;
        for (int it = gw; it < nitems; it += NGW) { const int kb = it / nblk, nb = it - kb * nblk, n0 = 64 * nb; int nd0 = n0 + rowoff;
            if (mode == 1) { const int up = n0 >= FFH, jn = up ? n0 - FFH : n0; nd0 = 256 * (jn >> 7) + 128 * up + (jn & 127); }
            conv_item64(W, N, K, gain, dst, 64 * kb, n0, nd0, scr, lane); }
    }
}

__device__ __forceinline__ void hgrn_naive(LAS unsigned char* lds, int bh, const bf16* Qb, const bf16* Kb, bf16* Vb, const float* LOGF, const bf16* SGb, const float* ogain) {
    int tid_ = threadIdx.x; asm volatile("" : "+v"(tid_));
    const int tid = tid_, b = bh >> 4, h = bh & 15, v = tid & 127, kg = tid >> 7;
    LAS float* Lf = (LAS float*)lds; LAS float* Lk = Lf + 2048; LAS float* Lq = Lk + 2048; LAS float* Lv = Lq + 2048; LAS float* Lp = Lv + 2048;
    float S[32];
#pragma unroll
    for (int j = 0; j < 32; ++j) S[j] = 0.f;
    const int stok = tid >> 5, sch = (tid & 31) * 4;
    for (int t0 = 0; t0 < SEQ; t0 += 16) {
        { const size_t off = (size_t)(b * SEQ + t0 + stok) * DM + h * HDIM + sch;
          const f32x4 lf = *(const f32x4*)(LOGF + off); const v2u kq = *(const v2u*)(Kb + off), qq = *(const v2u*)(Qb + off), vq = *(const v2u*)(Vb + off);
          *(LAS f32x4*)(Lf + stok * 128 + sch) = (f32x4){__expf(lf.x), __expf(lf.y), __expf(lf.z), __expf(lf.w)};
          *(LAS f32x4*)(Lk + stok * 128 + sch) = (f32x4){bflo(kq.x), bfhi(kq.x), bflo(kq.y), bfhi(kq.y)};
          *(LAS f32x4*)(Lq + stok * 128 + sch) = (f32x4){bflo(qq.x), bfhi(qq.x), bflo(qq.y), bfhi(qq.y)};
          *(LAS f32x4*)(Lv + stok * 128 + sch) = (f32x4){bflo(vq.x), bfhi(vq.x), bflo(vq.y), bfhi(vq.y)}; }
        __syncthreads();
        for (int tok = 0; tok < 16; ++tok) { const float vv = Lv[tok * 128 + v]; float acc = 0.f;
#pragma unroll
            for (int j4 = 0; j4 < 8; ++j4) { const f32x4 f = *(const LAS f32x4*)(Lf + tok * 128 + kg * 32 + 4 * j4), kk = *(const LAS f32x4*)(Lk + tok * 128 + kg * 32 + 4 * j4), qq = *(const LAS f32x4*)(Lq + tok * 128 + kg * 32 + 4 * j4);
#pragma unroll
                for (int e = 0; e < 4; ++e) { S[4 * j4 + e] = f[e] * S[4 * j4 + e] + kk[e] * vv; acc += qq[e] * S[4 * j4 + e]; } }
            Lp[(tok * 4 + kg) * 128 + v] = acc; }
        __syncthreads();
        { f32x4 o = *(const LAS f32x4*)(Lp + (stok * 4 + 0) * 128 + sch);
#pragma unroll
          for (int g = 1; g < 4; ++g) o += *(const LAS f32x4*)(Lp + (stok * 4 + g) * 128 + sch);
          float s = (o.x * o.x + o.y * o.y) + (o.z * o.z + o.w * o.w);
#pragma unroll
          for (int d = 1; d < 32; d <<= 1) s += __shfl_xor(s, d);
          const float sc = 1.0f / sqrtf(s * (1.0f / HDIM) + 1e-6f);
          const size_t off = (size_t)(b * SEQ + t0 + stok) * DM + h * HDIM + sch;
          const f32x4 gn = *(const f32x4*)(ogain + sch); const v2u sg = *(const v2u*)(SGb + off);
          v2u w; w.x = pk2(o.x * sc * gn.x * bflo(sg.x), o.y * sc * gn.y * bfhi(sg.x)); w.y = pk2(o.z * sc * gn.z * bflo(sg.y), o.w * sc * gn.w * bfhi(sg.y));
          *(v2u*)(Vb + off) = w; }
        __syncthreads();
    }
}

__device__ __forceinline__ void combine_phase(const bf16* OG, const float* LSE, bf16* OC) {
    const size_t nitem = (size_t)MROWS * (DM / 8), stride = (size_t)gridDim.x * blockDim.x;
    for (size_t i = (size_t)blockIdx.x * blockDim.x + threadIdx.x; i < nitem; i += stride) {
        const size_t tok = i >> 8; const int c = (int)(i & 255) * 8, h = c >> 7;
        const float l0 = LSE[tok * 48 + h], l1 = LSE[tok * 48 + 16 + h], l2 = LSE[tok * 48 + 32 + h];
        const float mx = fmaxf(l0, fmaxf(l1, l2)); float w0 = __expf(l0 - mx), w1 = __expf(l1 - mx), w2 = __expf(l2 - mx); const float inv = 1.0f / (w0 + w1 + w2); w0 *= inv; w1 *= inv; w2 *= inv;
        const v4u a = *(const v4u*)(OG + tok * 6144 + c), bb = *(const v4u*)(OG + tok * 6144 + 2048 + c), cc = *(const v4u*)(OG + tok * 6144 + 4096 + c);
        v4u o;
#pragma unroll
        for (int e = 0; e < 4; ++e) o[e] = pk2(w0 * bflo(a[e]) + w1 * bflo(bb[e]) + w2 * bflo(cc[e]), w0 * bfhi(a[e]) + w1 * bfhi(bb[e]) + w2 * bfhi(cc[e]));
        *(v4u*)(OC + tok * DM + c) = o;
    }
}

#define GRID_BAR() xcd_barrier(bar)
template <int LAYER>
__device__ __forceinline__ void layer_phases(const Args& args, LAS unsigned char* lds, unsigned char* lds_raw, const XcdBarrier& bar) {
    unsigned char* ws = args.ws; const int G = gridDim.x;
    bf16* XB = (bf16*)(ws + WS_XB); pg8::ssq_t* SS = (pg8::ssq_t*)(ws + WS_SS); float* out = args.out;
    constexpr int ssi = 2 * LAYER;
    if constexpr (LAYER < 2) {
#ifdef HG_SEPARATE_O
        bf16* HGO = (bf16*)(ws + WS_OG);
#else
        bf16* HGO = (bf16*)(ws + WS_R1) + 2 * (size_t)MROWS * DM;
#endif
        bf16* Aq = (bf16*)(ws + WS_R1); bf16* Ak = Aq + (size_t)MROWS * DM; bf16* Av = Ak + (size_t)MROWS * DM; bf16* Asg = Av + (size_t)MROWS * DM; float* Alogf = (float*)(ws + WS_R1 + 256 * MiB);
#ifndef DIS_G1
        {
            pg8::Gemm g{XB, (const bf16*)(ws + WS_WA_IN) + (size_t)LAYER * 8192 * DM, MROWS, 8192, DM}; pg8::StaticOrder S; S.init(MROWS, 8192, G, (int)blockIdx.x);
            pg8::EpiHgrnIn E{Aq, Alogf, SS + (size_t)ssi * MROWS, (const float*)(ws + WS_LBS) + LAYER * DM};
            pg8::gemm_phase<pg8::EpiHgrnIn, pg8::StaticOrder, true, true>(lds, g, S, E);
#ifdef PROBE_REP_GEMM
            pg8::gemm_phase<pg8::EpiHgrnIn, pg8::StaticOrder, true, true>(lds, g, S, E);
#endif
        }
#endif
        GRID_BAR();
#ifndef DIS_HGRN
#ifdef HGRN_BOTH
        for (int bh = blockIdx.x; bh < BATCH * NHEAD; bh += G) hg::hgrn_chunked(lds, bh, Aq, Ak, Av, (bf16*)(ws + WS_OG), Alogf, Asg, args.in[3] + LAYER * HDIM);
        __syncthreads();
        for (int bh = blockIdx.x; bh < BATCH * NHEAD; bh += G) hg::hgrn_chunked(lds, bh, Aq, Ak, Av, (bf16*)(ws + WS_OG + 64 * MiB), Alogf, Asg, args.in[3] + LAYER * HDIM);
        __syncthreads();
        for (int bh = blockIdx.x; bh < BATCH * NHEAD; bh += G) hgrn_naive(lds, bh, Aq, Ak, Av, Alogf, Asg, args.in[3] + LAYER * HDIM);
        GRID_BAR();
        {
            const unsigned* A = (const unsigned*)(ws + WS_OG); const unsigned* B = (const unsigned*)(ws + WS_OG + 64 * MiB); const unsigned* R = (const unsigned*)Av;
            unsigned nbit = 0, ntol = 0;
            for (size_t i = (size_t)blockIdx.x * blockDim.x + threadIdx.x; i < (size_t)MROWS * DM / 2; i += (size_t)gridDim.x * blockDim.x) {
                const unsigned a = A[i], b2 = B[i], r = R[i]; if (a != b2) ++nbit;
                if (fabsf(bflo(a) - bflo(r)) > 0.25f || fabsf(bfhi(a) - bfhi(r)) > 0.25f) ++ntol; }
            if (nbit) atomicAdd((unsigned*)(ws + WS_CTL) + 512, nbit);
            if (ntol) atomicAdd((unsigned*)(ws + WS_CTL) + 513, ntol);
        }
#elif defined(HGRN_NAIVE)
        for (int bh = blockIdx.x; bh < BATCH * NHEAD; bh += G) hgrn_naive(lds, bh, Aq, Ak, Av, Alogf, Asg, args.in[3] + LAYER * HDIM);
#else
        for (int bh = blockIdx.x; bh < BATCH * NHEAD; bh += G) hg::hgrn_chunked(lds, bh, Aq, Ak, Av, HGO, Alogf, Asg, args.in[3] + LAYER * HDIM);
#endif
#endif
        GRID_BAR();
#ifndef DIS_G3
        {
            pg8::Gemm g{HGO, (const bf16*)(ws + WS_WA_OUT) + (size_t)LAYER * DM * DM, MROWS, DM, DM}; pg8::StaticOrder S; S.init(MROWS, DM, G, (int)blockIdx.x);
            pg8::EpiRes E{LAYER == 0 ? args.in[0] : (const float*)out, out, XB, SS + (size_t)(ssi + 1) * MROWS};
            pg8::gemm_phase<pg8::EpiRes, pg8::StaticOrder, true, true>(lds, g, S, E);
        }
#endif
    } else {
        bf16* KB = (bf16*)(ws + WS_R1); bf16* VB = (bf16*)(ws + WS_R1 + 192 * MiB);
        bf16* QO = (bf16*)(ws + WS_R2); bf16* OG = (bf16*)(ws + WS_OG); bf16* OC = (bf16*)(ws + WS_R2 + 192 * MiB); float* LSE = (float*)(ws + WS_R2 + 256 * MiB);
#ifndef DIS_G2
        {
            constexpr int N = LAYER == 2 ? 18432 : 6144;
            pg8::Gemm g{XB, LAYER == 2 ? (const bf16*)(ws + WS_WQKV2) : (const bf16*)(ws + WS_WQ3), MROWS, N, DM}; pg8::StaticOrder S; S.init(MROWS, N, G, (int)blockIdx.x);
            pg8::EpiQkv E{QO, KB, VB, SS + (size_t)ssi * MROWS, args.in[11] + (LAYER - 2) * 3 * HDIM, args.in[8], (const float*)(ws + WS_ROPE)};
            pg8::gemm_phase<pg8::EpiQkv, pg8::StaticOrder, true, true>(lds, g, S, E);
#ifdef PROBE_REP_GEMM
            pg8::gemm_phase<pg8::EpiQkv, pg8::StaticOrder, true, true>(lds, g, S, E);
#endif
        }
#endif
        GRID_BAR();
#ifndef DIS_ATTN
        att::attn_phase((char*)lds_raw, QO, KB, VB, OG, LSE);
#ifdef PROBE_REP_ATTN
        att::attn_phase((char*)lds_raw, QO, KB, VB, OG, LSE);
#endif
#endif
        GRID_BAR();
#ifndef DIS_COMB
        combine_phase(OG, LSE, OC);
#endif
        GRID_BAR();
#ifndef DIS_G3
        {
            pg8::Gemm g{OC, (const bf16*)(ws + WS_WB_OUT) + (size_t)(LAYER - 2) * DM * DM, MROWS, DM, DM}; pg8::StaticOrder S; S.init(MROWS, DM, G, (int)blockIdx.x);
            pg8::EpiRes E{out, out, XB, SS + (size_t)(ssi + 1) * MROWS};
            pg8::gemm_phase<pg8::EpiRes, pg8::StaticOrder, true, true>(lds, g, S, E);
        }
#endif
    }
    GRID_BAR();
    bf16* HB = (bf16*)(ws + WS_R2);
#ifndef DIS_G4
    {
        pg8::Gemm g{XB, (const bf16*)(ws + WS_WF_IN) + (size_t)LAYER * 2 * FFH * DM, MROWS, 2 * FFH, DM}; pg8::StaticOrder S; S.init(MROWS, 2 * FFH, G, (int)blockIdx.x);
        pg8::EpiFfn1 E{HB, FFH, SS + (size_t)(ssi + 1) * MROWS};
        pg8::gemm_phase<pg8::EpiFfn1, pg8::StaticOrder, true, true>(lds, g, S, E);
#ifdef PROBE_REP_GEMM
            pg8::gemm_phase<pg8::EpiFfn1, pg8::StaticOrder, true, true>(lds, g, S, E);
#endif
#ifdef PROBE_G4_L2RES
        { pg8::ProbeOrder00 S0; S0.init(MROWS, 2 * FFH, G, (int)blockIdx.x); pg8::gemm_phase<pg8::EpiFfn1, pg8::ProbeOrder00, true, true>(lds, g, S0, E); }
#endif
    }
#endif
    GRID_BAR();
#ifndef DIS_G5
    {
        pg8::Gemm g{HB, (const bf16*)(ws + WS_WF_OUT) + (size_t)LAYER * DM * FFH, MROWS, DM, FFH}; pg8::StaticOrder S; S.init(MROWS, DM, G, (int)blockIdx.x);
        pg8::EpiRes E{out, out, XB, SS + (size_t)(ssi + 2) * MROWS};
        pg8::gemm_phase<pg8::EpiRes, pg8::StaticOrder, true, true>(lds, g, S, E);
    }
#endif
    if constexpr (LAYER < 3) GRID_BAR();
}

__global__ void __launch_bounds__(NWAVES * 64, 2) yoco_fwd(Args args) {
    extern __shared__ __attribute__((aligned(16))) unsigned char lds_raw[];
    LAS unsigned char* lds = (LAS unsigned char*)lds_raw;
    const int tid = threadIdx.x;
    volatile LAS unsigned* MISC = (volatile LAS unsigned*)(lds + MISC_OFF);
    if (tid < 64) MISC[tid] = 0u;
    __syncthreads();
    XcdBarrier bar = xcd_barrier_post((unsigned*)(args.ws + WS_CTL) + CW_BAR, MISC + 8);
#ifndef DIS_PRO
    { const int lane = tid & 63, wave = __builtin_amdgcn_readfirstlane(tid >> 6), G = gridDim.x;
      const int vcu = (G % 8 == 0) ? ((int)blockIdx.x % 8) * (G / 8) + (int)blockIdx.x / 8 : (int)blockIdx.x;
      prologue(args, lds, vcu * NWAVES + wave, G * NWAVES, lane, wave);
#ifdef PROBE_REP_PRO
      prologue(args, lds, vcu * NWAVES + wave, G * NWAVES, lane, wave);
#endif
    }
#endif
    GRID_BAR();
#ifndef ONLY_LAYER
    layer_phases<0>(args, lds, lds_raw, bar);
    layer_phases<1>(args, lds, lds_raw, bar);
    layer_phases<2>(args, lds, lds_raw, bar);
    layer_phases<3>(args, lds, lds_raw, bar);
#else
    layer_phases<ONLY_LAYER>(args, lds, lds_raw, bar);
#endif
#ifdef HGRN_BOTH
    GRID_BAR();
    { const unsigned nbit = __hip_atomic_load((unsigned*)(args.ws + WS_CTL) + 512, __ATOMIC_RELAXED, __HIP_MEMORY_SCOPE_AGENT), ntol = __hip_atomic_load((unsigned*)(args.ws + WS_CTL) + 513, __ATOMIC_RELAXED, __HIP_MEMORY_SCOPE_AGENT);
      if (nbit > 0 && blockIdx.x == 0 && threadIdx.x < 64) args.out[threadIdx.x] = __builtin_nanf("");
      if (ntol > 1000) { for (size_t i = (size_t)blockIdx.x * blockDim.x + threadIdx.x; i < (size_t)MROWS * DM; i += (size_t)gridDim.x * blockDim.x) args.out[i] *= 2.0f; } }
#endif
}

extern "C" void kernel_launch(void* const* d_in, const int* in_sizes, int n_in, void* d_out, int out_size, void* d_ws, size_t ws_size, hipStream_t stream) {
    static int grid = 0;
    if (grid == 0) {
        if (n_in != 16 || out_size != MROWS * DM || ws_size < WS_END) { fprintf(stderr, "kernel_launch: unexpected shapes (n_in %d out %d ws %zu)\n", n_in, out_size, ws_size); grid = -1; return; }
        int dev = 0, cus = 0, per_cu = 0;
        if (hipGetDevice(&dev) != hipSuccess || hipDeviceGetAttribute(&cus, hipDeviceAttributeMultiprocessorCount, dev) != hipSuccess) { grid = -1; return; }
        if (hipFuncSetAttribute((const void*)yoco_fwd, hipFuncAttributeMaxDynamicSharedMemorySize, LDS_BYTES) != hipSuccess) { fprintf(stderr, "kernel_launch: hipFuncSetAttribute failed\n"); grid = -1; return; }
        if (hipOccupancyMaxActiveBlocksPerMultiprocessor(&per_cu, (const void*)yoco_fwd, NWAVES * 64, LDS_BYTES) != hipSuccess || per_cu < 1) { fprintf(stderr, "kernel_launch: occupancy query says %d\n", per_cu); }
        (void)hipGetLastError();
        grid = cus;
    }
    if (grid < 0) return;
    (void)hipMemsetAsync((char*)d_ws + WS_CTL, 0, CTL_ZERO_BYTES, stream);
    Args a{};
    for (int i = 0; i < 16; ++i) a.in[i] = (const float*)d_in[i];
    a.out = (float*)d_out; a.ws = (unsigned char*)d_ws;
    hipLaunchKernelGGL(yoco_fwd, dim3(grid), dim3(NWAVES * 64), LDS_BYTES, stream, a);
}
```

```cpp
#define CONV_ALL_IN_PROLOGUE 1
#include <hip/hip_runtime.h>
#include <cstdio>
#include <cstdint>
namespace pg8 {
#define PG8_LAS __attribute__((address_space(3)))
typedef unsigned short bf16_t;
typedef short bf16x8 __attribute__((ext_vector_type(8)));
typedef float f32x4 __attribute__((ext_vector_type(4)));
typedef unsigned u32x4 __attribute__((ext_vector_type(4)));
typedef int i32x4 __attribute__((ext_vector_type(4)));
typedef int i32x8 __attribute__((ext_vector_type(8)));
constexpr int BM = 256, BK = 64, HALF = 128, HTB = HALF * BK * 2  , STAGE_BYTES = 8 * HTB, NXCD = 8, WGM = 8;

__host__ __device__ __forceinline__ int lds_byte(int r, int c) { const int st = (r >> 4) * 2 + (c >> 5), rr = r & 15, cc = c & 31, ob = rr * 64 + cc * 2; return st * 1024 + (ob ^ (((ob >> 9) & 1) << 5)); }
__host__ __device__ __forceinline__ void stage_rc(int b, int& R, int& C) { const int st = b / 1024, sb = b % 1024, swz = sb ^ (((sb >> 9) & 1) << 5); R = (st >> 1) * 16 + swz / 64; C = (st & 1) * 32 + (swz % 64) / 2; }
__host__ __device__ __forceinline__ int perm32(int rho) { const int n = rho >> 4, i = rho & 15; return 8 * (i >> 2) + 4 * n + (i & 3); }

struct Unit { int pm, pn; };
struct Gemm { const bf16_t* A; const bf16_t* Bt; int M, N, K; };

struct StaticOrder {
    int nM, nN, nwg, G, c;
    __host__ __device__ void init(int M, int N, int G_, int c_) { nM = M / BM; nN = N / BM; nwg = nM * nN; G = G_; c = c_; }
    __host__ __device__ bool next(int i, Unit& u) const {
        const long L = (long)i * G + c; if (L >= nwg) return false;
        int wgid = (int)L; { const int q = nwg / NXCD, r = nwg % NXCD, xcd = wgid % NXCD, off = wgid / NXCD; wgid = (xcd < r ? xcd * (q + 1) : r * (q + 1) + (xcd - r) * q) + off; }
        const int nig = WGM * nN, gid = wgid / nig, fm = gid * WGM, gsz = (nM - fm) < WGM ? (nM - fm) : WGM;
        u.pm = fm + ((wgid % nig) % gsz); u.pn = (wgid % nig) / gsz; return true;
    }
    __device__ __forceinline__ void a_ready(const Unit&) const {}
    __device__ __forceinline__ void done(const Unit&) const {}
};
struct ProbeOrder00 : StaticOrder {
    __host__ __device__ bool next(int i, Unit& u) const { const long L = (long)i * G + c; if (L >= nwg) return false; u.pm = 0; u.pn = 0; return true; }
};
__device__ __forceinline__ i32x8 cat8(const bf16x8 a, const bf16x8 b) { const i32x4 x = __builtin_bit_cast(i32x4, a), y = __builtin_bit_cast(i32x4, b); return __builtin_shufflevector(x, y, 0, 1, 2, 3, 4, 5, 6, 7); }
constexpr float F8_HSCALE = 8.0f, F8_XSCALE = 16.0f, F8_WSCALE = 512.0f, F8_MAX = 448.0f;
__device__ __forceinline__ unsigned cvt4_fp8(float a, float b, float c, float d, float s) {
    int w = 0;
    w = __builtin_amdgcn_cvt_pk_fp8_f32(__builtin_amdgcn_fmed3f(a * s, -F8_MAX, F8_MAX), __builtin_amdgcn_fmed3f(b * s, -F8_MAX, F8_MAX), w, false);
    w = __builtin_amdgcn_cvt_pk_fp8_f32(__builtin_amdgcn_fmed3f(c * s, -F8_MAX, F8_MAX), __builtin_amdgcn_fmed3f(d * s, -F8_MAX, F8_MAX), w, true);
    return (unsigned)w; }
__device__ __forceinline__ unsigned cvt_pk_bf16(float lo, float hi) { unsigned r; asm volatile("v_cvt_pk_bf16_f32 %0, %1, %2" : "=v"(r) : "v"(lo), "v"(hi)); return r; }
template <class Epi, class Sched, bool ALIGN_EPI = false, bool SP2 = false, int QM = 0>
__device__ __forceinline__ void gemm_phase(PG8_LAS unsigned char* lds, const Gemm g, const Sched& S, const Epi& E) {
    int tid_ = threadIdx.x; asm volatile("" : "+v"(tid_));
    const int tid = tid_, wid = __builtin_amdgcn_readfirstlane(tid >> 6), lane = tid & 63, wr = wid >> 2, wc = wid & 3, fr = lane & 15, fq = lane >> 4;
    const int K = g.K, nt = K / BK;
    unsigned voffA[2], voffB[2];
#pragma unroll
    for (int i = 0; i < 2; ++i) { int R, C; stage_rc(tid * 16 + i * 8192, R, C); const int Rb = Epi::PERM ? ((R & ~31) + perm32(R & 31)) : R;
        voffA[i] = (unsigned)(R * K + C) * 2u; voffB[i] = (unsigned)(Rb * K + C) * 2u; }
    const size_t kstep = (size_t)(BK * 2);
    const size_t hstep = (size_t)HALF * K * 2;
    const size_t tstep = 2 * hstep;
    const unsigned ldsw = (unsigned)wid * 1024u;
    const int aoff = lds_byte(wr * 64 + fr, fq * 8), boff = lds_byte(wc * 32 + fr, fq * 8);
#define PG8_SA(b, h) (((b) * 2 + (h)) * HTB)
#define PG8_SB(b, h) ((4 + (b) * 2 + (h)) * HTB)
#define PG8_STAGE(bufoff, gbase, voff) do { _Pragma("unroll") for (int _i = 0; _i < 2; ++_i) \
        __builtin_amdgcn_global_load_lds((const unsigned*)((const char*)(gbase) + (voff)[_i]), (PG8_LAS unsigned*)(lds + (bufoff) + ldsw + _i * 8192), 16, 0, 0); } while (0)
#define PG8_LDA(dst, b, h) do { _Pragma("unroll") for (int m = 0; m < 4; ++m) _Pragma("unroll") for (int k = 0; k < 2; ++k) dst[m][k] = *(const PG8_LAS bf16x8*)(lds + PG8_SA(b, h) + aoff + m * 2048 + k * 1024); } while (0)
#define PG8_LDB(dst, b, h) do { _Pragma("unroll") for (int n = 0; n < 2; ++n) _Pragma("unroll") for (int k = 0; k < 2; ++k) dst[n][k] = *(const PG8_LAS bf16x8*)(lds + PG8_SB(b, h) + boff + n * 2048 + k * 1024); } while (0)
#define PG8_MMA(ai, bj, At, Bt) do { __builtin_amdgcn_s_setprio(1); _Pragma("unroll") for (int m = 0; m < 4; ++m) _Pragma("unroll") for (int n = 0; n < 2; ++n) { \
        if constexpr (QM == 1) { const i32x8 b8_ = cat8(Bt[n][0], Bt[n][1]), a8_ = cat8(At[m][0], At[m][1]); asm volatile("v_mfma_f32_16x16x128_f8f6f4 %0, %1, %2, %0" : "+v"(acc[ai][bj][m][n]) : "v"(b8_), "v"(a8_)); } \
        else if constexpr (QM == 2) { _Pragma("unroll") for (int k = 0; k < 2; ++k) acc[ai][bj][m][n] = __builtin_bit_cast(f32x4, __builtin_amdgcn_mfma_i32_16x16x64_i8(__builtin_bit_cast(i32x4, Bt[n][k]), __builtin_bit_cast(i32x4, At[m][k]), __builtin_bit_cast(i32x4, acc[ai][bj][m][n]), 0, 0, 0)); } \
        else { _Pragma("unroll") for (int k = 0; k < 2; ++k) acc[ai][bj][m][n] = __builtin_amdgcn_mfma_f32_16x16x32_bf16(Bt[n][k], At[m][k], acc[ai][bj][m][n], 0, 0, 0); } } __builtin_amdgcn_s_setprio(0); } while (0)
#define PG8_WAIT_V(n) asm volatile("s_waitcnt vmcnt(" #n ")" ::: "memory")
#define PG8_WAIT_L(n) asm volatile("s_waitcnt lgkmcnt(" #n ")" ::: "memory")
#define PG8_BAR __builtin_amdgcn_s_barrier()
#define PG8_SCHED __builtin_amdgcn_sched_barrier(0)
    Unit cur, nxt; int ui = 0;
    if (!S.next(0, cur)) return;
    f32x4 acc[2][2][4][2];
    unsigned pre[8];
#pragma unroll
    for (int a = 0; a < 2; ++a)
#pragma unroll
        for (int b = 0; b < 2; ++b)
#pragma unroll
            for (int m = 0; m < 4; ++m)
#pragma unroll
                for (int n = 0; n < 2; ++n) acc[a][b][m][n] = (f32x4){0.f, 0.f, 0.f, 0.f};
    bf16x8 At[4][2], B0[2][2], B1[2][2];
    const char* cA = (const char*)g.A + (size_t)cur.pm * tstep; const char* cB = (const char*)g.Bt + (size_t)cur.pn * tstep;
    S.a_ready(cur);
    if constexpr (SP2) {
        PG8_STAGE(PG8_SB(0, 0), cB, voffB); PG8_STAGE(PG8_SB(0, 1), cB + hstep, voffB); PG8_STAGE(PG8_SA(0, 0), cA, voffA); PG8_STAGE(PG8_SA(0, 1), cA + hstep, voffA);
        if (wr == 1) PG8_BAR;
        PG8_WAIT_V(2); PG8_BAR;
        PG8_STAGE(PG8_SB(1, 0), cB + kstep, voffB); PG8_STAGE(PG8_SA(1, 0), cA + kstep, voffA); PG8_STAGE(PG8_SB(1, 1), cB + hstep + kstep, voffB);
        PG8_WAIT_V(6); PG8_BAR;
    } else {
        PG8_STAGE(PG8_SB(0, 0), cB, voffB); PG8_STAGE(PG8_SA(0, 0), cA, voffA); PG8_STAGE(PG8_SB(0, 1), cB + hstep, voffB); PG8_STAGE(PG8_SA(0, 1), cA + hstep, voffA);
        if (wr == 1) PG8_BAR;
        PG8_WAIT_V(4); PG8_BAR;
        PG8_STAGE(PG8_SB(1, 0), cB + kstep, voffB); PG8_STAGE(PG8_SA(1, 0), cA + kstep, voffA); PG8_STAGE(PG8_SB(1, 1), cB + hstep + kstep, voffB);
        PG8_WAIT_V(6); PG8_BAR;
    }
    for (;;) {
        const bool has_next = S.next(ui + 1, nxt);
        const char* nA = has_next ? (const char*)g.A + (size_t)nxt.pm * tstep : cA; const char* nB = has_next ? (const char*)g.Bt + (size_t)nxt.pn * tstep : cB;
        for (int t = 0; t < nt; t += 2) {
            const bool last = (t == nt - 2);
            const char* a1 = cA + (size_t)(t + 1) * kstep;
            const char* a2 = last ? nA : cA + (size_t)(t + 2) * kstep; const char* b2 = last ? nB : cB + (size_t)(t + 2) * kstep;
            const char* a3 = a2 + kstep; const char* b3 = b2 + kstep;
            if (last && has_next) S.a_ready(nxt);
            if (last) E.prefetch(cur, wr, fr, pre);
            if constexpr (SP2) {
            PG8_LDB(B0, 0, 0); PG8_LDB(B1, 0, 1); PG8_SCHED; PG8_LDA(At, 0, 0); PG8_STAGE(PG8_SA(1, 1), a1 + hstep, voffA);
            PG8_WAIT_V(8); PG8_WAIT_L(0); PG8_BAR; PG8_MMA(0, 0, At, B0); PG8_MMA(0, 1, At, B1); PG8_BAR; PG8_SCHED;
            PG8_LDA(At, 0, 1); PG8_STAGE(PG8_SB(0, 0), b2, voffB); PG8_STAGE(PG8_SB(0, 1), b2 + hstep, voffB); PG8_STAGE(PG8_SA(0, 0), a2, voffA);
            PG8_WAIT_V(8); PG8_WAIT_L(0); PG8_BAR; PG8_MMA(1, 0, At, B0); PG8_MMA(1, 1, At, B1); PG8_BAR; PG8_SCHED;
            PG8_LDB(B0, 1, 0); PG8_LDB(B1, 1, 1); PG8_SCHED; PG8_LDA(At, 1, 0); PG8_STAGE(PG8_SA(0, 1), a2 + hstep, voffA);
            PG8_WAIT_V(8); PG8_WAIT_L(0); PG8_BAR; PG8_MMA(0, 0, At, B0); PG8_MMA(0, 1, At, B1); PG8_BAR; PG8_SCHED;
            PG8_LDA(At, 1, 1); PG8_STAGE(PG8_SB(1, 0), b3, voffB); PG8_STAGE(PG8_SB(1, 1), b3 + hstep, voffB); PG8_STAGE(PG8_SA(1, 0), a3, voffA);
            PG8_WAIT_V(8); PG8_WAIT_L(0); PG8_BAR; PG8_MMA(1, 0, At, B0); PG8_MMA(1, 1, At, B1); PG8_BAR; PG8_SCHED;
            } else {
            PG8_LDB(B0, 0, 0); PG8_SCHED; PG8_LDA(At, 0, 0); PG8_STAGE(PG8_SA(1, 1), a1 + hstep, voffA);
            PG8_WAIT_L(8); PG8_BAR; PG8_WAIT_L(0); PG8_MMA(0, 0, At, B0); PG8_BAR; PG8_SCHED;
            PG8_LDB(B1, 0, 1); PG8_STAGE(PG8_SB(0, 0), b2, voffB);
            PG8_BAR; PG8_WAIT_L(0); PG8_MMA(0, 1, At, B1); PG8_BAR;
            PG8_LDA(At, 0, 1); PG8_STAGE(PG8_SA(0, 0), a2, voffA);
            PG8_BAR; PG8_WAIT_L(0); PG8_MMA(1, 0, At, B0); PG8_BAR; PG8_SCHED;
            PG8_STAGE(PG8_SB(0, 1), b2 + hstep, voffB);
            PG8_WAIT_V(6); PG8_BAR; PG8_MMA(1, 1, At, B1); PG8_BAR;
            PG8_LDB(B0, 1, 0); PG8_SCHED; PG8_LDA(At, 1, 0); PG8_STAGE(PG8_SA(0, 1), a2 + hstep, voffA);
            PG8_WAIT_L(8); PG8_BAR; PG8_WAIT_L(0); PG8_MMA(0, 0, At, B0); PG8_BAR; PG8_SCHED;
            PG8_LDB(B1, 1, 1); PG8_STAGE(PG8_SB(1, 0), b3, voffB);
            PG8_BAR; PG8_WAIT_L(0); PG8_MMA(0, 1, At, B1); PG8_BAR;
            PG8_LDA(At, 1, 1); PG8_STAGE(PG8_SA(1, 0), a3, voffA);
            PG8_BAR; PG8_WAIT_L(0); PG8_MMA(1, 0, At, B0); PG8_BAR; PG8_SCHED;
            PG8_STAGE(PG8_SB(1, 1), b3 + hstep, voffB);
            PG8_WAIT_V(6); PG8_BAR; PG8_MMA(1, 1, At, B1); PG8_BAR;
            }
        }
        if constexpr (QM == 1) asm volatile("s_nop 15\n\ts_nop 15\n\ts_nop 7" ::: "memory");
        if constexpr (ALIGN_EPI) { if (wr == 0) PG8_BAR; }
        E(acc, cur, wr, wc, fr, fq, lds, pre, ui);
        if (!has_next) break;
#pragma unroll
        for (int a = 0; a < 2; ++a)
#pragma unroll
            for (int b = 0; b < 2; ++b)
#pragma unroll
                for (int m = 0; m < 4; ++m)
#pragma unroll
                    for (int n = 0; n < 2; ++n) acc[a][b][m][n] = (f32x4){0.f, 0.f, 0.f, 0.f};
        cur = nxt; cA = nA; cB = nB; ++ui;
        if constexpr (ALIGN_EPI) { if (wr == 1) PG8_BAR; }
    }
    PG8_WAIT_V(0);
    if constexpr (!ALIGN_EPI) { if (wr == 0) PG8_BAR; }
    PG8_BAR;
#undef PG8_SA
#undef PG8_SB
#undef PG8_STAGE
#undef PG8_LDA
#undef PG8_LDB
#undef PG8_MMA
#undef PG8_WAIT_V
#undef PG8_WAIT_L
#undef PG8_BAR
#undef PG8_SCHED
}
}
namespace pg8 {
constexpr int DMODEL = 2048;
constexpr float RMS_EPS = 1e-6f;
__device__ __forceinline__ float fast_exp(float x) { return __builtin_amdgcn_exp2f(x * 1.4426950408889634f); }
__device__ __forceinline__ float fast_log(float x) { return __builtin_amdgcn_logf(x) * 0.6931471805599453f; }
__device__ __forceinline__ float fast_rcp(float x) { return __builtin_amdgcn_rcpf(x); }
__device__ __forceinline__ float silu_f(float v) { return v * fast_rcp(1.0f + fast_exp(-v)); }
__device__ __forceinline__ u32x4 pack8_bf16(const f32x4 a, const f32x4 b) { u32x4 w; w.x = cvt_pk_bf16(a[0], a[1]); w.y = cvt_pk_bf16(a[2], a[3]); w.z = cvt_pk_bf16(b[0], b[1]); w.w = cvt_pk_bf16(b[2], b[3]); return w; }
typedef unsigned ssq_t;
constexpr float SS_SCALE = 1024.0f;
__device__ __forceinline__ float ss_to_rs(ssq_t v) { return __builtin_amdgcn_rsqf((float)v * (1.0f / (SS_SCALE * DMODEL)) + RMS_EPS); }
__device__ __forceinline__ void ss_prefetch(unsigned (&pre)[8], const ssq_t* ss, int row0) {
#pragma unroll
    for (int i = 0; i < 8; ++i) pre[i] = ss[row0 + (i >> 2) * HALF + (i & 3) * 16];
}
__device__ __forceinline__ void row_scales(float (&rs)[2][4], const unsigned (&pre)[8]) {
#pragma unroll
    for (int ai = 0; ai < 2; ++ai)
#pragma unroll
        for (int m = 0; m < 4; ++m) rs[ai][m] = ss_to_rs(pre[ai * 4 + m]);
}

typedef _Float16 f16x2_t __attribute__((ext_vector_type(2)));
typedef float f32x2e __attribute__((ext_vector_type(2)));
__device__ __forceinline__ unsigned pk_f16(float lo, float hi) { const f32x2e v = {lo, hi}; const f16x2_t h = __builtin_convertvector(v, f16x2_t); return __builtin_bit_cast(unsigned, h); }
__device__ __forceinline__ void fz_one(float z, float l, float& k, float& logf) {
    const float e = fast_exp(-__builtin_fabsf(z)), inv = fast_rcp(1.0f + e), sm = e * inv;
    const float sig = z >= 0.f ? inv : sm, nsig = z >= 0.f ? sm : inv;
    k = (1.0f - l) * nsig; logf = fast_log(l + (1.0f - l) * sig);
}

struct EpiHgrnIn {
    static constexpr bool PERM = true, AFTER_DRAIN = false;
    __device__ __forceinline__ void prefetch(const Unit& u, int wr, int fr, unsigned (&pre)[8]) const { ss_prefetch(pre, ss, u.pm * BM + wr * 64 + fr); }
    bf16_t* QKVG; float* LOGF; const ssq_t* ss; const float* lb;
    static constexpr size_t TSTRIDE = (size_t)16384 * DMODEL;
    __device__ __forceinline__ void operator()(const f32x4 (&acc)[2][2][4][2], const Unit& u, int wr, int wc, int fr, int fq, PG8_LAS unsigned char*, const unsigned (&pre)[8], int ui) const {
        const int row0 = u.pm * BM + wr * 64 + fr, type = u.pn >> 3, col0 = (u.pn & 7) * BM + wc * 32 + 8 * fq, hd0 = (u.pn & 7) * 2, dcol = wc * 32 + 8 * fq;
        float rsv[2][4]; row_scales(rsv, pre);
        if (type == 1) {
#pragma unroll
            for (int bj = 0; bj < 2; ++bj) { const f32x4 lb0 = *(const f32x4*)(lb + col0 + bj * HALF), lb1 = *(const f32x4*)(lb + col0 + bj * HALF + 4);
#pragma unroll
                for (int ai = 0; ai < 2; ++ai)
#pragma unroll
                    for (int m = 0; m < 4; ++m) { const int row = row0 + ai * HALF + m * 16; const size_t off = ((size_t)((row >> 12) * 16 + hd0 + bj) * 4096 + (row & 4095)) * 128 + dcol;
                        const float rs = rsv[ai][m]; f32x4 lf0, lf1, kk0, kk1;
#pragma unroll
                        for (int j = 0; j < 4; ++j) { float ka, la, kb, lb_; fz_one(acc[ai][bj][m][0][j] * rs, lb0[j], ka, la); fz_one(acc[ai][bj][m][1][j] * rs, lb1[j], kb, lb_); lf0[j] = la; lf1[j] = lb_; kk0[j] = ka; kk1[j] = kb; }
#ifdef HG_STORE_K
                        *(u32x4*)(QKVG + TSTRIDE + off) = pack8_bf16(kk0, kk1);
#endif
                        *(f32x4*)(LOGF + off) = lf0; *(f32x4*)(LOGF + off + 4) = lf1;
                        asm volatile("" ::: "memory"); } }
        } else {
            bf16_t* dst = QKVG + (size_t)(type == 0 ? 0 : type) * TSTRIDE;
#pragma unroll
            for (int ai = 0; ai < 2; ++ai)
#pragma unroll
                for (int m = 0; m < 4; ++m) { const int row = row0 + ai * HALF + m * 16; const size_t off = ((size_t)((row >> 12) * 16 + hd0) * 4096 + (row & 4095)) * 128 + dcol;
                    const float rs = rsv[ai][m];
#pragma unroll
                    for (int bj = 0; bj < 2; ++bj) { f32x4 v0 = acc[ai][bj][m][0] * rs, v1 = acc[ai][bj][m][1] * rs;
                        if (type == 3) {
#pragma unroll
                            for (int j = 0; j < 4; ++j) { v0[j] = silu_f(v0[j]); v1[j] = silu_f(v1[j]); } }
                        *(u32x4*)(dst + off + (size_t)bj * (4096 * 128)) = pack8_bf16(v0, v1); }
                    asm volatile("" ::: "memory"); }
        }
    }
};

struct EpiRes {
    static constexpr bool PERM = true, AFTER_DRAIN = false;
    bf16_t* xb; float* out; ssq_t* ssn; float ascale; unsigned char* x8;
    __device__ __forceinline__ void prefetch(const Unit&, int, int, unsigned (&)[8]) const {}
    __device__ __forceinline__ void operator()(const f32x4 (&acc)[2][2][4][2], const Unit& u, int wr, int wc, int fr, int fq, PG8_LAS unsigned char*, const unsigned (&pre)[8], int ui) const {
        const int row0 = u.pm * BM + wr * 64 + fr, col0 = u.pn * BM + wc * 32 + 8 * fq;
#pragma unroll
        for (int ai = 0; ai < 2; ++ai) {
            u32x4 rv[4][2];
#pragma unroll
            for (int m = 0; m < 4; ++m) { const size_t off = (size_t)(row0 + ai * HALF + m * 16) * DMODEL + col0;
#pragma unroll
                for (int bj = 0; bj < 2; ++bj) rv[m][bj] = *(const u32x4*)(xb + off + bj * HALF); }
            asm volatile("" ::: "memory");
#pragma unroll
            for (int m = 0; m < 4; ++m) { const int row = row0 + ai * HALF + m * 16; const size_t off = (size_t)row * DMODEL + col0; float s = 0.f;
#pragma unroll
                for (int bj = 0; bj < 2; ++bj) { const u32x4 r = rv[m][bj];
                    const f32x4 r0 = {__uint_as_float(r.x << 16), __uint_as_float(r.x & 0xffff0000u), __uint_as_float(r.y << 16), __uint_as_float(r.y & 0xffff0000u)};
                    const f32x4 r1 = {__uint_as_float(r.z << 16), __uint_as_float(r.z & 0xffff0000u), __uint_as_float(r.w << 16), __uint_as_float(r.w & 0xffff0000u)};
                    const f32x4 x0 = acc[ai][bj][m][0] * ascale + r0, x1 = acc[ai][bj][m][1] * ascale + r1;
                    if (out) { *(f32x4*)(out + off + bj * HALF) = x0; *(f32x4*)(out + off + bj * HALF + 4) = x1; }
                    else { *(u32x4*)(xb + off + bj * HALF) = pack8_bf16(x0, x1);
                        if (x8) { typedef unsigned u32x2_ __attribute__((ext_vector_type(2))); *(u32x2_*)(x8 + off + bj * HALF) = (u32x2_){cvt4_fp8(x0[0], x0[1], x0[2], x0[3], F8_XSCALE), cvt4_fp8(x1[0], x1[1], x1[2], x1[3], F8_XSCALE)}; }
                        s += (x0[0] * x0[0] + x0[1] * x0[1]) + (x0[2] * x0[2] + x0[3] * x0[3]) + (x1[0] * x1[0] + x1[1] * x1[1]) + (x1[2] * x1[2] + x1[3] * x1[3]); } }
                if (!out) { s += __shfl_xor(s, 16); s += __shfl_xor(s, 32);
                    if (fq == 0) atomicAdd(ssn + row, (ssq_t)(s * SS_SCALE + 0.5f)); } }
            asm volatile("" ::: "memory");
        }
    }
};

struct EpiResI8 {
    static constexpr bool PERM = true, AFTER_DRAIN = false;
    bf16_t* xb; float* out; ssq_t* ssn; float ascale; unsigned char* x8; const float* asc; const float* wsc;
    __device__ __forceinline__ void prefetch(const Unit& u, int wr, int fr, unsigned (&pre)[8]) const {
        if (asc) { const int row0 = u.pm * BM + wr * 64 + fr;
#pragma unroll
            for (int i = 0; i < 8; ++i) pre[i] = __builtin_bit_cast(unsigned, asc[row0 + (i >> 2) * HALF + (i & 3) * 16]); } }
    __device__ __forceinline__ void operator()(const f32x4 (&acc)[2][2][4][2], const Unit& u, int wr, int wc, int fr, int fq, PG8_LAS unsigned char*, const unsigned (&pre)[8], int ui) const {
        const int row0 = u.pm * BM + wr * 64 + fr, col0 = u.pn * BM + wc * 32 + 8 * fq;
#pragma unroll
        for (int ai = 0; ai < 2; ++ai) {
            f32x4 cs[2][2] = {{{0.f, 0.f, 0.f, 0.f}, {0.f, 0.f, 0.f, 0.f}}, {{0.f, 0.f, 0.f, 0.f}, {0.f, 0.f, 0.f, 0.f}}};
            if (asc) {
#pragma unroll
                for (int bj = 0; bj < 2; ++bj) { cs[bj][0] = *(const f32x4*)(wsc + col0 + bj * HALF); cs[bj][1] = *(const f32x4*)(wsc + col0 + bj * HALF + 4); } }
            u32x4 rv[4][2];
#pragma unroll
            for (int m = 0; m < 4; ++m) { const size_t off = (size_t)(row0 + ai * HALF + m * 16) * DMODEL + col0;
#pragma unroll
                for (int bj = 0; bj < 2; ++bj) rv[m][bj] = *(const u32x4*)(xb + off + bj * HALF); }
            asm volatile("" ::: "memory");
#pragma unroll
            for (int m = 0; m < 4; ++m) { const int row = row0 + ai * HALF + m * 16; const size_t off = (size_t)row * DMODEL + col0; float s = 0.f;
#pragma unroll
                for (int bj = 0; bj < 2; ++bj) { const u32x4 r = rv[m][bj];
                    const f32x4 r0 = {__uint_as_float(r.x << 16), __uint_as_float(r.x & 0xffff0000u), __uint_as_float(r.y << 16), __uint_as_float(r.y & 0xffff0000u)};
                    const f32x4 r1 = {__uint_as_float(r.z << 16), __uint_as_float(r.z & 0xffff0000u), __uint_as_float(r.w << 16), __uint_as_float(r.w & 0xffff0000u)};
                    f32x4 a0 = acc[ai][bj][m][0], a1 = acc[ai][bj][m][1];
                    if (asc) { const float ra = __builtin_bit_cast(float, pre[ai * 4 + m]);
                        a0 = __builtin_convertvector(__builtin_bit_cast(i32x4, a0), f32x4) * (cs[bj][0] * ra); a1 = __builtin_convertvector(__builtin_bit_cast(i32x4, a1), f32x4) * (cs[bj][1] * ra); }
                    else { a0 = a0 * ascale; a1 = a1 * ascale; }
                    const f32x4 x0 = a0 + r0, x1 = a1 + r1;
                    if (out) { *(f32x4*)(out + off + bj * HALF) = x0; *(f32x4*)(out + off + bj * HALF + 4) = x1; }
                    else { *(u32x4*)(xb + off + bj * HALF) = pack8_bf16(x0, x1);
                        if (x8) { typedef unsigned u32x2_ __attribute__((ext_vector_type(2))); *(u32x2_*)(x8 + off + bj * HALF) = (u32x2_){cvt4_fp8(x0[0], x0[1], x0[2], x0[3], F8_XSCALE), cvt4_fp8(x1[0], x1[1], x1[2], x1[3], F8_XSCALE)}; }
                        s += (x0[0] * x0[0] + x0[1] * x0[1]) + (x0[2] * x0[2] + x0[3] * x0[3]) + (x1[0] * x1[0] + x1[1] * x1[1]) + (x1[2] * x1[2] + x1[3] * x1[3]); } }
                if (!out) { s += __shfl_xor(s, 16); s += __shfl_xor(s, 32);
                    if (fq == 0) atomicAdd(ssn + row, (ssq_t)(s * SS_SCALE + 0.5f)); } }
            asm volatile("" ::: "memory");
        }
    }
};

struct ConvJob { const float* W; const float* gain; unsigned short* dst; int K, N, mode, rowoff; };
__device__ __forceinline__ void conv_item_reg(const ConvJob& J, int item, int lane) {
    const int nblk = J.N >> 6, kb = item / nblk, nb = item - kb * nblk, k0 = 64 * kb, n0 = 64 * nb; int nd0 = n0 + J.rowoff;
    if (J.mode == 1) { const int up = n0 >= 5632, jn = up ? n0 - 5632 : n0; nd0 = 256 * (jn >> 7) + 128 * up + (jn & 127); }
    const float* src = J.W + (size_t)k0 * J.N + n0 + lane; float w[64];
#pragma unroll
    for (int kk = 0; kk < 64; ++kk) w[kk] = __builtin_nontemporal_load(src + (size_t)kk * J.N);
    if (J.gain) {
#pragma unroll
        for (int kk = 0; kk < 64; ++kk) w[kk] *= J.gain[k0 + kk]; }
    unsigned short* drow = J.dst + (size_t)(nd0 + lane) * J.K + k0;
#pragma unroll
    for (int j = 0; j < 8; ++j) { u32x4 o; o.x = cvt_pk_bf16(w[8 * j], w[8 * j + 1]); o.y = cvt_pk_bf16(w[8 * j + 2], w[8 * j + 3]); o.z = cvt_pk_bf16(w[8 * j + 4], w[8 * j + 5]); o.w = cvt_pk_bf16(w[8 * j + 6], w[8 * j + 7]);
        *(u32x4*)(drow + 8 * j) = o; }
}
__host__ __device__ constexpr int conv_items(int job) { return job < 2 ? 4096 : job < 4 ? 1024 : job < 8 ? 5632 : job < 12 ? 2816 : job == 12 ? 3072 : job == 13 ? 6144 : job == 14 ? 3072 : 1024; }
__device__ __forceinline__ bool conv_slot(int phase, int s, int& job, int& item) {
    if (phase == 0) { constexpr int j0 = 1, j1 = 3, j2 = 5, j3 = 9; constexpr int c1 = conv_items(j0), c2 = c1 + conv_items(j1), c3 = c2 + conv_items(j2), c4 = c3 + conv_items(j3);
        if (s < c1) { job = j0; item = s; } else if (s < c2) { job = j1; item = s - c1; } else if (s < c3) { job = j2; item = s - c2; } else if (s < c4) { job = j3; item = s - c3; } else return false; return true; }
    if (phase == 1) { constexpr int j0 = 12, j1 = 13, j2 = 15, j3 = 6, j4 = 10; constexpr int c1 = conv_items(j0), c2 = c1 + conv_items(j1), c3 = c2 + conv_items(j2), c4 = c3 + conv_items(j3), c5 = c4 + conv_items(j4);
        if (s < c1) { job = j0; item = s; } else if (s < c2) { job = j1; item = s - c1; } else if (s < c3) { job = j2; item = s - c2; } else if (s < c4) { job = j3; item = s - c3; } else if (s < c5) { job = j4; item = s - c4; } else return false; return true; }
    if (phase == 2) { constexpr int j0 = 14, j1 = 16, j2 = 7, j3 = 11; constexpr int c1 = conv_items(j0), c2 = c1 + conv_items(j1), c3 = c2 + conv_items(j2), c4 = c3 + conv_items(j3);
        if (s < c1) { job = j0; item = s; } else if (s < c2) { job = j1; item = s - c1; } else if (s < c3) { job = j2; item = s - c2; } else if (s < c4) { job = j3; item = s - c3; } else return false; return true; }
    return false;
}

struct EpiFfn1 {
    static constexpr bool PERM = true, AFTER_DRAIN = false;
    bf16_t* H; int ldh; const ssq_t* ss; const ConvJob* jobs; int phase; int f8; float ascale;
    const float* asc; const float* wsc;
    __device__ __forceinline__ void prefetch(const Unit& u, int wr, int fr, unsigned (&pre)[8]) const {
        const int row0 = u.pm * BM + wr * 64 + fr;
        if (asc) {
#pragma unroll
            for (int i = 0; i < 8; ++i) pre[i] = __builtin_bit_cast(unsigned, asc[row0 + (i >> 2) * HALF + (i & 3) * 16]); }
        else ss_prefetch(pre, ss, row0); }
    __device__ __forceinline__ void operator()(const f32x4 (&acc)[2][2][4][2], const Unit& u, int wr, int wc, int fr, int fq, PG8_LAS unsigned char*, const unsigned (&pre)[8], int ui) const {
        const int row0 = u.pm * BM + wr * 64 + fr, col0 = u.pn * HALF + wc * 32 + 8 * fq;
        float rs[2][4]; f32x4 wg[2], wu[2];
        if (asc) {
#pragma unroll
            for (int i = 0; i < 8; ++i) rs[i >> 2][i & 3] = __builtin_bit_cast(float, pre[i]);
            const float* wp = wsc + u.pn * BM + wc * 32 + 8 * fq;
            wg[0] = *(const f32x4*)wp; wg[1] = *(const f32x4*)(wp + 4); wu[0] = *(const f32x4*)(wp + HALF); wu[1] = *(const f32x4*)(wp + HALF + 4); }
        else { row_scales(rs, pre);
#pragma unroll
            for (int i = 0; i < 8; ++i) rs[i >> 2][i & 3] *= ascale;
            wg[0] = wg[1] = wu[0] = wu[1] = (f32x4){1.f, 1.f, 1.f, 1.f}; }
#pragma unroll
        for (int ai = 0; ai < 2; ++ai)
#pragma unroll
            for (int m = 0; m < 4; ++m) { f32x4 h[2];
#pragma unroll
                for (int n = 0; n < 2; ++n)
#pragma unroll
                    for (int j = 0; j < 4; ++j) { float ag = acc[ai][0][m][n][j], au = acc[ai][1][m][n][j];
                        if (asc) { ag = (float)__builtin_bit_cast(int, ag); au = (float)__builtin_bit_cast(int, au); }
                        const float g = ag * (rs[ai][m] * wg[n][j]), up = au * (rs[ai][m] * wu[n][j]); h[n][j] = silu_f(g) * up; }
                if (f8) { typedef unsigned u32x2_ __attribute__((ext_vector_type(2)));
                    *(u32x2_*)((unsigned char*)H + (size_t)(row0 + ai * HALF + m * 16) * ldh + col0) = (u32x2_){cvt4_fp8(h[0][0], h[0][1], h[0][2], h[0][3], F8_HSCALE), cvt4_fp8(h[1][0], h[1][1], h[1][2], h[1][3], F8_HSCALE)}; }
                else *(u32x4*)(H + (size_t)(row0 + ai * HALF + m * 16) * ldh + col0) = pack8_bf16(h[0], h[1]); }
        if (phase < 3) {
            asm volatile("" ::: "memory");
            const int slot = (ui * (int)gridDim.x + (int)blockIdx.x) * 8 + wr * 4 + wc; int job, item;
            if (conv_slot(phase, slot, job, item)) { const ConvJob J = jobs[job]; conv_item_reg(J, item, fq * 16 + fr); }
        }
    }
};

__host__ __device__ __forceinline__ size_t attn_row(int b, int g, int h, int t) { return (size_t)((b * 3 + g) * 16 + h) * 4096 + (size_t)((t & ((1 << (2 * g)) - 1)) << (12 - 2 * g)) + (size_t)(t >> (2 * g)); }
constexpr int QKV_SCR_OFF = 131072;
constexpr int QKV_ROPE_OFF = QKV_SCR_OFF + 8192;
constexpr int QKV_EPS_OFF = QKV_ROPE_OFF + 16384;
typedef _Float16 f16x8_t __attribute__((ext_vector_type(8)));
typedef float f32x8_t __attribute__((ext_vector_type(8)));
struct EpiQkv {
    static constexpr bool PERM = true, AFTER_DRAIN = false;
    __device__ __forceinline__ void prefetch(const Unit&, int, int, unsigned (&)[8]) const {}
    bf16_t *Qo, *Ko, *Vo; const ssq_t* ss; const float* qgain; const float* kgain; const _Float16* rope; float ascale;
    __device__ __forceinline__ void operator()(const f32x4 (&acc)[2][2][4][2], const Unit& u, int wr, int wc, int fr, int fq, PG8_LAS unsigned char* lds, const unsigned (&pre)[8], int ui) const {
        const int kind = u.pn / 24, pt = u.pn - kind * 24, grp = pt >> 3;
        const int row0 = u.pm * BM + wr * 64 + fr, hd0 = (pt & 7) * 2, dcol = wc * 32 + 8 * fq;
        if (kind == 2) {
            unsigned loc[8]; ss_prefetch(loc, ss, row0);
            float rs[2][4]; row_scales(rs, loc);
#pragma unroll
            for (int i = 0; i < 8; ++i) rs[i >> 2][i & 3] *= ascale;
#pragma unroll
            for (int ai = 0; ai < 2; ++ai)
#pragma unroll
                for (int m = 0; m < 4; ++m) { const int row = row0 + ai * HALF + m * 16; const size_t off = attn_row(row >> 12, grp, hd0, row & 4095) * 128 + dcol;
#pragma unroll
                    for (int bj = 0; bj < 2; ++bj) { const f32x4 a_ = acc[ai][bj][m][0] * rs[ai][m], b_ = acc[ai][bj][m][1] * rs[ai][m];
                        typedef unsigned u32x2_ __attribute__((ext_vector_type(2))); *(u32x2_*)((unsigned char*)Vo + off + (size_t)bj * (4096 * 128)) = (u32x2_){cvt4_fp8(a_[0], a_[1], a_[2], a_[3], F8_XSCALE), cvt4_fp8(b_[0], b_[1], b_[2], b_[3], F8_XSCALE)}; } }
            return;
        }
        int lr = wr * 64 + fr; asm volatile("" : "+v"(lr));
        { const char* src = (const char*)(rope + (size_t)((u.pm * BM) & 4095) * 32) + ((wr * 4 + wc) * 64 + fq * 16 + fr) * 16;
#pragma unroll
          for (int i = 0; i < 2; ++i) __builtin_amdgcn_global_load_lds((const unsigned*)(src + i * 8192), (PG8_LAS unsigned*)(lds + QKV_ROPE_OFF + (wr * 4 + wc) * 1024 + i * 8192), 16, 0, 0); }
        unsigned loc[8];
        if (wc == 0) ss_prefetch(loc, ss, row0);
        const float* gain = (kind == 0 ? qgain : kgain) + grp * 128 + wc * 32 + 8 * fq;
        const f32x4 g0 = *(const f32x4*)gain, g1 = *(const f32x4*)(gain + 4);
        PG8_LAS float* scr = (PG8_LAS float*)(lds + QKV_SCR_OFF);
#pragma unroll
        for (int ai = 0; ai < 2; ++ai)
#pragma unroll
            for (int m = 0; m < 4; ++m)
#pragma unroll
                for (int bj = 0; bj < 2; ++bj) { const f32x4 a = acc[ai][bj][m][0], b = acc[ai][bj][m][1];
                    float s = (a[0] * a[0] + a[1] * a[1]) + (a[2] * a[2] + a[3] * a[3]) + (b[0] * b[0] + b[1] * b[1]) + (b[2] * b[2] + b[3] * b[3]);
                    s += __shfl_xor(s, 16); s += __shfl_xor(s, 32);
                    if (fq == 0) scr[((ai * HALF + m * 16 + lr) * 2 + bj) * 4 + wc] = s; }
        PG8_LAS float* epsl = (PG8_LAS float*)(lds + QKV_EPS_OFF);
        if (wc == 0 && fq == 0) {
#pragma unroll
            for (int am = 0; am < 8; ++am) epsl[(am >> 2) * HALF + (am & 3) * 16 + lr] = RMS_EPS * ((float)loc[am] * (1.0f / (SS_SCALE * DMODEL)) + RMS_EPS) * (1.0f / (ascale * ascale)); }
        asm volatile("s_waitcnt vmcnt(0) lgkmcnt(0)" ::: "memory"); __builtin_amdgcn_s_barrier(); asm volatile("" ::: "memory");
        bf16_t* dst = kind == 0 ? Qo : Ko;
#pragma unroll
        for (int am = 0; am < 8; ++am) { const int ai = am >> 2, m = am & 3; const int row = row0 + ai * HALF + m * 16; const size_t off = attn_row(row >> 12, grp, hd0, row & 4095) * 128 + dcol;
            const int lrow = ai * HALF + m * 16 + lr;
            const float epsr = epsl[lrow];
            f32x4 c0 = {1.f, 1.f, 1.f, 1.f}, c1 = c0, s0 = {0.f, 0.f, 0.f, 0.f}, s1 = s0;
            if (wc == 0) { const PG8_LAS f16x8_t* rp = (const PG8_LAS f16x8_t*)(lds + QKV_ROPE_OFF + lrow * 64 + (fq & 1) * 16);
                const f32x8_t cf = __builtin_convertvector(rp[0], f32x8_t), sf = __builtin_convertvector(rp[2], f32x8_t);
                const float sg = fq < 2 ? -1.0f : 1.0f;
#pragma unroll
                for (int j = 0; j < 4; ++j) { c0[j] = cf[j]; c1[j] = cf[4 + j]; s0[j] = sf[j] * sg; s1[j] = sf[4 + j] * sg; } }
#pragma unroll
            for (int bj = 0; bj < 2; ++bj) { const f32x4 p = *(const PG8_LAS f32x4*)(scr + (lrow * 2 + bj) * 4);
                const float sc = __builtin_amdgcn_rsqf(((p[0] + p[1]) + (p[2] + p[3])) * (1.0f / 128.0f) + epsr);
                f32x4 v0 = acc[ai][bj][m][0] * sc * g0, v1 = acc[ai][bj][m][1] * sc * g1;
                if (wc == 0) { f32x4 p0, p1;
#pragma unroll
                    for (int j = 0; j < 4; ++j) { p0[j] = __shfl_xor(v0[j], 32); p1[j] = __shfl_xor(v1[j], 32); }
                    v0 = v0 * c0 + p0 * s0; v1 = v1 * c1 + p1 * s1; }
                { typedef unsigned u32x2_ __attribute__((ext_vector_type(2))); *(u32x2_*)((unsigned char*)dst + off + (size_t)bj * (4096 * 128)) = (u32x2_){cvt4_fp8(v0[0], v0[1], v0[2], v0[3], F8_XSCALE), cvt4_fp8(v1[0], v1[1], v1[2], v1[3], F8_XSCALE)}; } }
            asm volatile("" ::: "memory");
        }
    }
};
}
namespace att {
typedef unsigned short bf16;
typedef short bf16x8 __attribute__((ext_vector_type(8)));
typedef short s16x4 __attribute__((ext_vector_type(4)));
typedef float f32x16 __attribute__((ext_vector_type(16)));
typedef float f32x4 __attribute__((ext_vector_type(4)));
typedef unsigned u32x4 __attribute__((ext_vector_type(4)));
constexpr int D = 128, NW = 8, QBLK = 32, KVBLK = 64, QB = NW * QBLK;
constexpr int SHM_V = KVBLK * D * 2, SHM_K = KVBLK * D * 2;
constexpr int LDS_BYTES = 2 * SHM_V + 2 * SHM_K + NW * 64 * 4;
constexpr float SCALE = 0.08838834764831845f;
constexpr float THR = 8.f;
constexpr int W = 129;
constexpr bool SK = true;

#define KSWZ(row, colB) ((row) * 256 + ((colB) ^ (((row) & 7) << 4)))
#define SBAR() __builtin_amdgcn_sched_barrier(0)
__device__ __forceinline__ int v_st(int k, int c) { const int kk = (k & ~0xC) | ((k & 4) << 1) | ((k & 8) >> 1); return ((kk >> 3) * 4 + (c >> 5)) * 512 + ((kk & 7) * 32 + (c & 31)) * 2; }
__device__ __forceinline__ int v_rd_base(int lane) { return ((lane & 3) << 3) | (((lane >> 2) & 3) << 6) | (((lane >> 4) & 1) << 5) | (((lane >> 5) & 1) << 8); }
constexpr int v_rd_off(int d0, int ks, int half) { return d0 * 512 + ks * 4096 + half * 2048; }
__device__ __forceinline__ int crow(int r, int hi) { return (r & 3) + 8 * (r >> 2) + 4 * hi; }
__device__ __forceinline__ unsigned cvtpk(float lo, float hi) { unsigned r; asm volatile("v_cvt_pk_bf16_f32 %0, %1, %2" : "=v"(r) : "v"(lo), "v"(hi)); return r; }
__device__ __forceinline__ bf16x8 ld8(const bf16* p) { return *reinterpret_cast<const bf16x8*>(p); }
__device__ __forceinline__ bf16x8 ld8g(const char* ubase, unsigned voff) { return *reinterpret_cast<const bf16x8*>(ubase + voff); }
__device__ __forceinline__ void mask_tile(f32x16& p0, f32x16& p1, int dq, unsigned Wu) {
    const float NEG = -__builtin_inff();
#pragma unroll
    for (int r = 0; r < 16; ++r) {
        const int c = (r & 3) + 8 * (r >> 2);
        if ((unsigned)(dq - c) >= Wu) p0[r] = NEG;
        if ((unsigned)(dq - c - 32) >= Wu) p1[r] = NEG;
    }
}
__device__ __forceinline__ void partialSM(f32x16& p0, f32x16& p1, float& m_reg, float& mn, float& alpha) {
    float pmax = p0[0];
#pragma unroll
    for (int r = 1; r < 16; ++r) pmax = fmaxf(pmax, p0[r]);
#pragma unroll
    for (int r = 0; r < 16; ++r) pmax = fmaxf(pmax, p1[r]);
    { auto rr = __builtin_amdgcn_permlane32_swap(__float_as_uint(pmax), __float_as_uint(pmax), false, false);
      pmax = fmaxf(__uint_as_float(rr[0]), __uint_as_float(rr[1])); }
    constexpr float C2 = 1.4426950408889634f * SCALE;
    if (__builtin_expect(__all((pmax - m_reg) * SCALE <= THR), 1)) { mn = m_reg; alpha = 1.f; }
    else { mn = fmaxf(m_reg, pmax); alpha = __builtin_amdgcn_exp2f((m_reg - mn) * C2); m_reg = mn; }
    const float mnL = -mn * C2;
#pragma unroll
    for (int r = 0; r < 16; ++r) p0[r] = fmaf(p0[r], C2, mnL);
#pragma unroll
    for (int r = 0; r < 16; ++r) p1[r] = fmaf(p1[r], C2, mnL);
#pragma unroll
    for (int r = 0; r < 16; ++r) p0[r] = __builtin_amdgcn_exp2f(p0[r]);
}
__device__ __forceinline__ void finishSM(f32x16& p0, f32x16& p1, float alpha, float& l_reg, bf16x8& pa0, bf16x8& pa1, bf16x8& pa2, bf16x8& pa3) {
#pragma unroll
    for (int r = 0; r < 16; ++r) p1[r] = __builtin_amdgcn_exp2f(p1[r]);
    float ps = 0;
#pragma unroll
    for (int r = 0; r < 16; ++r) ps += p0[r];
#pragma unroll
    for (int r = 0; r < 16; ++r) ps += p1[r];
    { auto rr = __builtin_amdgcn_permlane32_swap(__float_as_uint(ps), __float_as_uint(ps), false, false);
      ps = __uint_as_float(rr[0]) + __uint_as_float(rr[1]); }
    l_reg = l_reg * alpha + ps;
#define PK4(P, B_, OUT) do { unsigned a0 = cvtpk(P[B_+0], P[B_+1]), a1 = cvtpk(P[B_+2], P[B_+3]);                          \
        unsigned b0 = cvtpk(P[B_+4], P[B_+5]), b1 = cvtpk(P[B_+6], P[B_+7]);                                             \
        auto r0 = __builtin_amdgcn_permlane32_swap(a0, b0, false, false); auto r1 = __builtin_amdgcn_permlane32_swap(a1, b1, false, false); \
        u32x4 w = {r0[0], r1[0], r0[1], r1[1]}; OUT = *reinterpret_cast<bf16x8*>(&w); } while (0)
    PK4(p0, 0, pa0); PK4(p0, 8, pa1); PK4(p1, 0, pa2); PK4(p1, 8, pa3);
#undef PK4
}
template <int KB>
__device__ __forceinline__ void qkt(f32x16& p0, f32x16& p1, const char* K_lds, int r32, int hi, const bf16x8* qr, bool act) {
    if (SK && !act) { const float NEG = -__builtin_inff();
#pragma unroll
        for (int r = 0; r < 16; ++r) { p0[r] = NEG; p1[r] = NEG; } return; }
    p0 = f32x16{}; p1 = f32x16{};
    const char* kb[4];
#pragma unroll
    for (int dd = 0; dd < 4; ++dd) kb[dd] = K_lds + KB * SHM_K + KSWZ(r32, (dd * 16 + hi * 8) * 2);
#pragma unroll
    for (int d0 = 0; d0 < 8; ++d0) { const char* a = kb[d0 & 3] + (d0 >> 2) * 128;
        bf16x8 b0 = *reinterpret_cast<const bf16x8*>(a);
        bf16x8 b1 = *reinterpret_cast<const bf16x8*>(a + 32 * 256);
        p0 = __builtin_amdgcn_mfma_f32_32x32x16_bf16(b0, qr[d0], p0, 0, 0, 0);
        p1 = __builtin_amdgcn_mfma_f32_32x32x16_bf16(b1, qr[d0], p1, 0, 0, 0); }
}
template <int VB>
__device__ __forceinline__ void pv_tile(f32x16* o, int vb0, bf16x8 pa0, bf16x8 pa1, bf16x8 pa2, bf16x8 pa3, bool act) {
    if (SK && !act) return;
#define TRRD(dst, off) asm volatile("ds_read_b64_tr_b16 %0, %1 offset:%2" : "=&v"(dst) : "v"(vb0), "i"(off) : "memory")
#define PV_D0(d0) do { s16x4 l0, l1, l2, l3, h0, h1, h2, h3; constexpr int b_ = VB * SHM_V + v_rd_off(d0, 0, 0);   \
        TRRD(l0, b_); TRRD(h0, b_ + 2048); TRRD(l1, b_ + 4096); TRRD(h1, b_ + 6144); TRRD(l2, b_ + 8192); TRRD(h2, b_ + 10240); TRRD(l3, b_ + 12288); TRRD(h3, b_ + 14336); \
        asm volatile("s_waitcnt lgkmcnt(0)" ::: "memory"); SBAR();   \
        o[d0] = __builtin_amdgcn_mfma_f32_32x32x16_bf16(pa0, (bf16x8){l0[0], l0[1], l0[2], l0[3], h0[0], h0[1], h0[2], h0[3]}, o[d0], 0, 0, 0);   \
        o[d0] = __builtin_amdgcn_mfma_f32_32x32x16_bf16(pa1, (bf16x8){l1[0], l1[1], l1[2], l1[3], h1[0], h1[1], h1[2], h1[3]}, o[d0], 0, 0, 0);   \
        o[d0] = __builtin_amdgcn_mfma_f32_32x32x16_bf16(pa2, (bf16x8){l2[0], l2[1], l2[2], l2[3], h2[0], h2[1], h2[2], h2[3]}, o[d0], 0, 0, 0);   \
        o[d0] = __builtin_amdgcn_mfma_f32_32x32x16_bf16(pa3, (bf16x8){l3[0], l3[1], l3[2], l3[3], h3[0], h3[1], h3[2], h3[3]}, o[d0], 0, 0, 0); } while (0)
    PV_D0(0); PV_D0(1); PV_D0(2); PV_D0(3);
#undef PV_D0
#undef TRRD
}

struct BlockRef { const bf16* Q; const bf16* K; const bf16* V; bf16* O; float* LSE; int P0; };
struct Seam { bf16x8 qr[8]; bf16x8 st_v0, st_v1, st_k0, st_k1; };
__device__ __forceinline__ int swa_jlo(int P0) { const int lowk = P0 - W + 1; return lowk > 0 ? lowk / KVBLK : 0; }
#define VMW() asm volatile("s_waitcnt vmcnt(0)" ::: "memory")
#define VMWN(n) asm volatile("s_waitcnt vmcnt(%0)" :: "i"(n) : "memory")
#define SLOAD_H(Kp, Vp, k0, pitch) do { const char* kb_ = (const char*)(Kp) + (size_t)(k0) * (size_t)((pitch) * 2); const char* vb_ = (const char*)(Vp) + (size_t)(k0) * (size_t)((pitch) * 2); \
        S.st_v0 = ld8g(vb_, rowoff); S.st_v1 = ld8g(vb_ + 32 * (pitch) * 2, rowoff); S.st_k0 = ld8g(kb_, rowoff); S.st_k1 = ld8g(kb_ + 32 * (pitch) * 2, rowoff); } while (0)
#define SWRITE_HK(bf) do { *(bf16x8*)(K_lds + (bf) * SHM_K + kws) = S.st_k0; *(bf16x8*)(K_lds + (bf) * SHM_K + kws + 32 * 256) = S.st_k1; } while (0)
#define SWRITE_HV(bf) do { *(bf16x8*)(V_lds + (bf) * SHM_V + vst0) = S.st_v0; *(bf16x8*)(V_lds + (bf) * SHM_V + vst1) = S.st_v1; } while (0)
#define SWRITE_H(bf) do { SWRITE_HV(bf); SWRITE_HK(bf); } while (0)
template <int DIL> __device__ __forceinline__ void swa_prime(const BlockRef& cur, char* lds, Seam& S) {
    constexpr int PITCH = 128;
    int tid_ = threadIdx.x; asm volatile("" : "+v"(tid_));
    const int tid = tid_, wid = __builtin_amdgcn_readfirstlane(tid >> 6), lane = tid & 63, r32 = lane & 31, hi = lane >> 5;
    const int sr = tid >> 4, sc = (tid & 15) * 8, kws = KSWZ(sr, sc * 2); char* K_lds = lds + 2 * SHM_V;
    const unsigned rowoff = (unsigned)(sr * PITCH + sc) * 2u, qoff = (unsigned)((wid * QBLK + r32) * PITCH + hi * 8) * 2u;
    const int kb0 = swa_jlo(cur.P0) * KVBLK;
#pragma unroll
    for (int d0 = 0; d0 < 8; ++d0) S.qr[d0] = ld8g((const char*)cur.Q + d0 * 32, qoff);
    SLOAD_H(cur.K, cur.V, kb0, PITCH); VMW(); SWRITE_HK(0);
    __syncthreads();
}
template <int DIL> __device__ __forceinline__ void swa_block(const BlockRef& cur, const BlockRef& nxt, char* lds, Seam& S) {
    constexpr int PITCH = 128, LPITCH = DIL * 48, SKV = 4096 / DIL;
    int tid_ = threadIdx.x; asm volatile("" : "+v"(tid_));
    const int tid = tid_, wid = __builtin_amdgcn_readfirstlane(tid >> 6), lane = tid & 63, r32 = lane & 31, hi = lane >> 5;
    const int j_lo = swa_jlo(cur.P0);
    int j_hi = (cur.P0 + QB - 1) / KVBLK + 1; if (j_hi > SKV / KVBLK) j_hi = SKV / KVBLK;
    const int NT = j_hi - j_lo;
    const int kbn = swa_jlo(nxt.P0) * KVBLK;
    const int qlo = cur.P0 + wid * QBLK, qm = qlo + r32 - 4 * hi;
    char* V_lds = lds; char* K_lds = lds + 2 * SHM_V;
    float* ws = (float*)(lds + 2 * SHM_V + 2 * SHM_K) + wid * 64; float* li_l = ws, * al_l = ws + 32;
    float m_reg = -1e30f, l_reg = 0; f32x16 o[4] = {};
    const int sr = tid >> 4, sc = (tid & 15) * 8, vst0 = v_st(sr, sc), vst1 = v_st(32 + sr, sc), kws = KSWZ(sr, sc * 2);
    const unsigned rowoff = (unsigned)(sr * PITCH + sc) * 2u, qoff = (unsigned)((wid * QBLK + r32) * PITCH + hi * 8) * 2u;
    const int vb0 = (int)(uintptr_t)V_lds + v_rd_base(lane);
    const bf16* Kh = cur.K; const bf16* Vh = cur.V; constexpr int pitch = PITCH;
#define RESC(a) do { if (__any((a) < 1.f)) { if (hi == 0) al_l[r32] = (a); asm volatile("s_waitcnt lgkmcnt(0)" ::: "memory");              \
                     for (int d_ = 0; d_ < 4; ++d_) for (int r = 0; r < 16; ++r) o[d_][r] *= al_l[crow(r, hi)]; } } while (0)
#define KBASE(t) ((j_lo + (t)) * KVBLK)
#define ACT(t) (KBASE(t) <= qlo + QBLK - 1 && KBASE(t) + KVBLK - 1 >= qlo - W + 1)
#define MASKT(P0_, P1_, t) do { const int kb_ = KBASE(t); if ((!SK || ACT(t)) && (kb_ + KVBLK - 1 > qlo || kb_ <= qlo + QBLK - 1 - W)) mask_tile(P0_, P1_, qm - kb_, (unsigned)W); } while (0)
#define SEAM_K0() do { VMWN(8); SWRITE_HK(0); SBAR(); } while (0)
    f32x16 pA0, pA1, pB0, pB1; float mnA, mnB, alA, alB; bf16x8 pa0, pa1, pa2, pa3;
    SWRITE_HV(0); SBAR();
    if (NT > 1) { SLOAD_H(Kh, Vh, KBASE(1), pitch); }
    SBAR(); qkt<0>(pA0, pA1, K_lds, r32, hi, S.qr, ACT(0));
    MASKT(pA0, pA1, 0); partialSM(pA0, pA1, m_reg, mnA, alA);
    if (NT > 1) { VMW(); SWRITE_H(1); }
    __syncthreads();
#define HALF_STEP(PX0, PX1, mnX, alX, PY0, PY1, alY, t, KB, VB, SB) do {                                                      \
        SBAR(); qkt<KB>(PX0, PX1, K_lds, r32, hi, S.qr, ACT(t));                                             \
        finishSM(PY0, PY1, alY, l_reg, pa0, pa1, pa2, pa3); SBAR();                                                           \
        if ((t) + 1 < NT) { SLOAD_H(Kh, Vh, KBASE((t) + 1), pitch); SBAR(); }                                               \
        pv_tile<VB>(o, vb0, pa0, pa1, pa2, pa3, ACT((t) - 1)); MASKT(PX0, PX1, (t)); partialSM(PX0, PX1, m_reg, mnX, alX);                                        \
        __syncthreads();                                                                                                      \
        if ((t) + 1 < NT) { VMW(); SWRITE_H(SB); }                                                                          \
        RESC(alX); __syncthreads(); } while (0)
    for (int t = 1; t + 1 < NT; t += 2) {
        HALF_STEP(pB0, pB1, mnB, alB, pA0, pA1, alA, t, 1, 0, 0);
        HALF_STEP(pA0, pA1, mnA, alA, pB0, pB1, alB, t + 1, 0, 1, 1);
    }
    const bool even = (NT & 1) == 0;
    if (even) { SBAR(); qkt<1>(pB0, pB1, K_lds, r32, hi, S.qr, ACT(NT - 1)); SBAR(); }
    SLOAD_H(nxt.K, nxt.V, kbn, PITCH); SBAR();
#pragma unroll
    for (int d0 = 0; d0 < 8; ++d0) S.qr[d0] = ld8g((const char*)nxt.Q + d0 * 32, qoff);
    SBAR();
    finishSM(pA0, pA1, alA, l_reg, pa0, pa1, pa2, pa3); SBAR();
    pv_tile<0>(o, vb0, pa0, pa1, pa2, pa3, ACT(even ? NT - 2 : NT - 1));
    if (even) { MASKT(pB0, pB1, NT - 1); partialSM(pB0, pB1, m_reg, mnB, alB); __syncthreads(); RESC(alB);
        finishSM(pB0, pB1, alB, l_reg, pa0, pa1, pa2, pa3); SBAR(); pv_tile<1>(o, vb0, pa0, pa1, pa2, pa3, ACT(NT - 1)); }
    SBAR(); SEAM_K0();
    if (hi == 0) li_l[r32] = l_reg; asm volatile("s_waitcnt lgkmcnt(0)" ::: "memory");
    float rli[16];
#pragma unroll
    for (int r = 0; r < 16; ++r) rli[r] = __builtin_amdgcn_rcpf(li_l[crow(r, hi)]);
    { char* Ob = (char*)cur.O + (size_t)(wid * QBLK) * (size_t)(PITCH * 2); const unsigned ooff = (unsigned)(4 * hi * PITCH + r32) * 2u;
#pragma unroll
      for (int r = 0; r < 16; ++r) { char* Or = Ob + (size_t)((r & 3) + 8 * (r >> 2)) * (size_t)(PITCH * 2);
#pragma unroll
        for (int d0 = 0; d0 < 4; ++d0) { const float v = o[d0][r] * rli[r];
            const float vn = __shfl_xor(v, 1);
            if ((r32 & 1) == 0) *(unsigned*)(Or + d0 * 64 + ooff) = cvtpk(v, vn); } } }
    if (hi == 0) cur.LSE[(size_t)(wid * QBLK + r32) * (size_t)LPITCH] = m_reg * SCALE + __builtin_amdgcn_logf(l_reg) * 0.6931471805599453f;
    __syncthreads();
#undef RESC
#undef KBASE
#undef ACT
#undef MASKT
#undef SEAM_K0
#undef HALF_STEP
}
#undef VMW
#undef VMWN
#undef SLOAD_H
#undef SWRITE_HK
#undef SWRITE_HV
#undef SWRITE_H
#undef KSWZ
#undef SBAR

template <int DIL> __device__ __forceinline__ BlockRef make_ref(int idx, const bf16* Q, const bf16* K, const bf16* V, bf16* O, float* LSE) {
    constexpr int GI = DIL == 1 ? 0 : (DIL == 4 ? 1 : 2), NQB = 16 / DIL, PITCH = 128;
    const int j = idx & 15, h = (idx >> 4) & 15, b = idx >> 8, r = j / NQB, qb = j - r * NQB;
    const size_t base = ((size_t)((b * 3 + GI) * 16 + h) * 4096 + (size_t)r * (4096 / DIL)) * 128;
    BlockRef R; R.P0 = qb * QB;
    R.K = K + base; R.V = V + base; R.Q = Q + base + (size_t)R.P0 * (size_t)PITCH; R.O = O + base + (size_t)R.P0 * (size_t)PITCH;
    R.LSE = LSE + (size_t)(b * 4096 + r + R.P0 * DIL) * 48 + GI * 16 + h;
    return R;
}
template <int DIL> __device__ __forceinline__ void attn_group(char* lds, const bf16* Q, const bf16* K, const bf16* V, bf16* O, float* LSE) {
    const int total = 1024, stride = gridDim.x; int L = blockIdx.x; if (L >= total) return;
    BlockRef cur = make_ref<DIL>(L, Q, K, V, O, LSE); Seam S;
    swa_prime<DIL>(cur, lds, S);
    for (;;) {
        const int Ln = L + stride; const bool last = Ln >= total;
        const BlockRef nxt = last ? cur : make_ref<DIL>(Ln, Q, K, V, O, LSE);
        swa_block<DIL>(cur, nxt, lds, S);
        if (last) break;
        cur = nxt; L = Ln;
    }
}
__device__ __forceinline__ void attn_phase(char* lds, const bf16* Q, const bf16* K, const bf16* V, bf16* O, float* LSE) {
#ifndef ATT_ONLY
    attn_group<1>(lds, Q, K, V, O, LSE);
    attn_group<4>(lds, Q, K, V, O, LSE);
    attn_group<16>(lds, Q, K, V, O, LSE);
#else
    attn_group<ATT_ONLY>(lds, Q, K, V, O, LSE);
#endif
}
}
namespace att2 {
typedef unsigned short bf16;
typedef short bf16x8 __attribute__((ext_vector_type(8)));
typedef short v4i16_t __attribute__((ext_vector_type(4)));
typedef float f32x4 __attribute__((ext_vector_type(4)));
typedef float f32x2 __attribute__((ext_vector_type(2)));
typedef unsigned u32x4 __attribute__((ext_vector_type(4)));
typedef unsigned u32x2 __attribute__((ext_vector_type(2)));
typedef __bf16 bf16x2_t __attribute__((ext_vector_type(2)));
#define ALAS __attribute__((address_space(3)))
constexpr int KST = 272, VST = 288, GRAN_K = 128 * KST, GRAN = GRAN_K + 128 * VST;
constexpr int LDS_NEED = 2 * GRAN;
constexpr float F8S = 16.0f;
constexpr float SCALE = 0.08838834764831845f / (F8S * F8S), C2 = 1.4426950408889634f * SCALE;
__device__ __forceinline__ u32x2 f8x4_to_bf16(unsigned w) { const f32x2 lo = __builtin_amdgcn_cvt_pk_f32_fp8((int)w, false), hi = __builtin_amdgcn_cvt_pk_f32_fp8((int)w, true);
    const bf16x2_t a = __builtin_convertvector(lo, bf16x2_t), b = __builtin_convertvector(hi, bf16x2_t); return (u32x2){__builtin_bit_cast(unsigned, a), __builtin_bit_cast(unsigned, b)}; }
__device__ __forceinline__ u32x4 f8x8_to_bf16(unsigned w0, unsigned w1) { const u32x2 a = f8x4_to_bf16(w0), b = f8x4_to_bf16(w1); return (u32x4){a.x, a.y, b.x, b.y}; }
__device__ __forceinline__ unsigned cvtpk(float lo, float hi) { const f32x2 v = {lo, hi}; const bf16x2_t b = __builtin_convertvector(v, bf16x2_t); return __builtin_bit_cast(unsigned, b); }
__device__ __forceinline__ v4i16_t vtr(const ALAS unsigned char* p) { return __builtin_amdgcn_ds_read_tr16_b64_v4i16((ALAS v4i16_t*)p); }

__device__ __forceinline__ void a2_compute(ALAS unsigned char* lds, int G, bool has_prev, int wid, int q16, int g4, const bf16x8 (&qf)[4], bf16* Oq, float* LSE, int b, int GI, int h, int DIL, int NBM, int NBS) {
        const ALAS unsigned char* slotP = lds + ((G - 1) & 1) * GRAN; const ALAS unsigned char* slotC = lds + (G & 1) * GRAN;
        f32x4 sc[9];
        const int nprev = 8 - wid;
#pragma unroll
        for (int kt = 0; kt < 9; ++kt) { sc[kt] = (f32x4){0.f, 0.f, 0.f, 0.f};
            const int kb = 16 * wid + 16 * kt; const bool inprev = kt < nprev;
            if (!inprev || has_prev) { const ALAS unsigned char* kp = (inprev ? slotP + kb * KST : slotC + (kb - 128) * KST) + q16 * KST + g4 * 16;
#pragma unroll
                for (int s = 0; s < 4; ++s) sc[kt] = __builtin_amdgcn_mfma_f32_16x16x32_bf16(*(const ALAS bf16x8*)(kp + s * 64), qf[s], sc[kt], 0, 0, 0); } }
        const float NEG = -__builtin_inff();
#pragma unroll
        for (int r = 0; r < 4; ++r) { if (4 * g4 + r < q16) sc[0][r] = NEG; if (4 * g4 + r > q16) sc[8][r] = NEG; }
        if (!has_prev) {
#pragma unroll
            for (int kt = 0; kt < 8; ++kt) if (kt < nprev) sc[kt] = (f32x4){NEG, NEG, NEG, NEG}; }
        float mx = NEG;
#pragma unroll
        for (int kt = 0; kt < 9; ++kt) mx = fmaxf(mx, fmaxf(fmaxf(sc[kt][0], sc[kt][1]), fmaxf(sc[kt][2], sc[kt][3])));
        mx = fmaxf(mx, __shfl_xor(mx, 16)); mx = fmaxf(mx, __shfl_xor(mx, 32));
        const float mL = -mx * C2; float ls = 0.f;
#pragma unroll
        for (int kt = 0; kt < 9; ++kt)
#pragma unroll
            for (int r = 0; r < 4; ++r) { const float p = __builtin_amdgcn_exp2f(fmaf(sc[kt][r], C2, mL)); sc[kt][r] = p; ls += p; }
        ls += __shfl_xor(ls, 16); ls += __shfl_xor(ls, 32);
        f32x4 o[8];
#pragma unroll
        for (int dt = 0; dt < 8; ++dt) o[dt] = (f32x4){0.f, 0.f, 0.f, 0.f};
#pragma unroll
        for (int p = 0; p < 5; ++p) { const int t0 = 2 * p, t1 = 2 * p + 1;
            const bool v0 = !(t0 < nprev) || has_prev, v1 = (t1 < 9) && (!(t1 < nprev) || has_prev);
            if (v0 || v1) {
                u32x4 pw; pw.x = cvtpk(sc[t0][0], sc[t0][1]); pw.y = cvtpk(sc[t0][2], sc[t0][3]);
                if (t1 < 9) { pw.z = cvtpk(sc[t1 < 9 ? t1 : 8][0], sc[t1 < 9 ? t1 : 8][1]); pw.w = cvtpk(sc[t1 < 9 ? t1 : 8][2], sc[t1 < 9 ? t1 : 8][3]); } else { pw.z = 0u; pw.w = 0u; }
                const bf16x8 pf = __builtin_bit_cast(bf16x8, pw);
                const int kb0 = 16 * wid + 16 * t0, kb1 = 16 * wid + 16 * t1;
                const ALAS unsigned char* vb0 = (t0 < nprev) ? slotP + GRAN_K + kb0 * VST : slotC + GRAN_K + (kb0 - 128) * VST;
                const ALAS unsigned char* vb1 = (t1 < 9) ? ((t1 < nprev) ? slotP + GRAN_K + kb1 * VST : slotC + GRAN_K + (kb1 - 128) * VST) : vb0;
                if (!v0) vb0 = vb1;
                if (!v1) vb1 = vb0;
                const ALAS unsigned char* a0 = vb0 + (4 * g4 + (q16 >> 2)) * VST + (q16 & 3) * 8; const ALAS unsigned char* a1 = vb1 + (4 * g4 + (q16 >> 2)) * VST + (q16 & 3) * 8;
#pragma unroll
                for (int dt = 0; dt < 8; ++dt) { const v4i16_t lo = vtr(a0 + dt * 32), hi = vtr(a1 + dt * 32);
                    o[dt] = __builtin_amdgcn_mfma_f32_16x16x32_bf16((bf16x8){lo[0], lo[1], lo[2], lo[3], hi[0], hi[1], hi[2], hi[3]}, pf, o[dt], 0, 0, 0); } } }
        { const float inv = __builtin_amdgcn_rcpf(ls); unsigned char* orow = (unsigned char*)Oq + 4 * g4;
#pragma unroll
          for (int dt = 0; dt < 8; ++dt) *(unsigned*)(orow + 16 * dt) = pg8::cvt4_fp8(o[dt][0] * inv, o[dt][1] * inv, o[dt][2] * inv, o[dt][3] * inv, 1.0f);
          if (g4 == 0) { const int blk = G & NBM, r = G >> NBS, t = (128 * blk + 16 * wid + q16) * DIL + r;
              LSE[((size_t)b * 4096 + t) * 48 + GI * 16 + h] = mx * SCALE + __builtin_amdgcn_logf(ls) * 0.6931471805599453f; } }
}

__device__ __forceinline__ void attn_item(ALAS unsigned char* lds, int b, int GI, int h, int G0, const bf16* Q, const bf16* K, const bf16* V, bf16* O, float* LSE) {
    const int DIL = 1 << (2 * GI), NBM = (32 >> (2 * GI)) - 1, NBS = 5 - 2 * GI;
    int tid_ = threadIdx.x; asm volatile("" : "+v"(tid_));
    const int tid = tid_, wid = __builtin_amdgcn_readfirstlane(tid >> 6), lane = tid & 63, q16 = lane & 15, g4 = lane >> 4;
    const size_t hb = (size_t)((b * 3 + GI) * 16 + h) * 4096;
    const char* Kh = (const char*)K + hb * 128; const char* Vh = (const char*)V + hb * 128;
    u32x4 skA[2], svA[2], skB[2], svB[2];
#define A2_GLOAD(G_, sk, sv) do { _Pragma("unroll") for (int i = 0; i < 2; ++i) { const unsigned o_ = (unsigned)((G_) * 128 * 128) + (unsigned)(tid + 512 * i) * 16u; \
        sk[i] = *(const u32x4*)(Kh + o_); sv[i] = *(const u32x4*)(Vh + o_); } } while (0)
#define A2_WIDEN(dstp_, src_) do { *(ALAS u32x4*)(dstp_) = f8x8_to_bf16(src_.x, src_.y); *(ALAS u32x4*)((dstp_) + 16) = f8x8_to_bf16(src_.z, src_.w); } while (0)
#define A2_GWRITE(G_, sk, sv) do { ALAS unsigned char* sl_ = lds + ((G_) & 1) * GRAN; _Pragma("unroll") for (int i = 0; i < 2; ++i) { const int id_ = tid + 512 * i, r_ = id_ >> 3, c_ = id_ & 7; \
        A2_WIDEN(sl_ + r_ * KST + c_ * 32, sk[i]); A2_WIDEN(sl_ + GRAN_K + r_ * VST + c_ * 32, sv[i]); } } while (0)
#define A2_QLOAD(G_, qf_) do { const size_t qr_ = hb + (size_t)(G_) * 128 + 16 * wid + q16; _Pragma("unroll") for (int s = 0; s < 4; ++s) { const u32x2 w_ = *(const u32x2*)((const unsigned char*)Q + qr_ * 128 + 32 * s + 8 * g4); \
        qf_[s] = __builtin_bit_cast(bf16x8, f8x8_to_bf16(w_.x, w_.y)); } } while (0)
    bf16x8 qfA[4], qfB[4];
    __syncthreads();
    if ((G0 & NBM) != 0) { A2_GLOAD(G0 - 1, skA, svA); A2_GWRITE(G0 - 1, skA, svA); }
    A2_GLOAD(G0, skB, svB); A2_QLOAD(G0, qfA); A2_GLOAD(G0 + 1, skA, svA); A2_GWRITE(G0, skB, svB);
    __syncthreads();
#define A2_BLOCK(n, skC, svC, skN, svN, qf, qn) do { \
        const int G = G0 + (n); const bool has_prev = (G & NBM) != 0; \
        if ((n) < 6) A2_GLOAD(G + 2, skN, svN); \
        if ((n) < 7) A2_QLOAD(G + 1, qn); \
        const size_t qrow = hb + (size_t)G * 128 + 16 * wid + q16; \
        a2_compute(lds, G, has_prev, wid, q16, g4, qf, O + qrow * 64, LSE, b, GI, h, DIL, NBM, NBS);   \
        __syncthreads(); \
        if ((n) < 7) A2_GWRITE(G + 1, skC, svC); \
        __syncthreads(); } while (0)
    A2_BLOCK(0, skA, svA, skB, svB, qfA, qfB); A2_BLOCK(1, skB, svB, skA, svA, qfB, qfA);
    A2_BLOCK(2, skA, svA, skB, svB, qfA, qfB); A2_BLOCK(3, skB, svB, skA, svA, qfB, qfA);
    A2_BLOCK(4, skA, svA, skB, svB, qfA, qfB); A2_BLOCK(5, skB, svB, skA, svA, qfB, qfA);
    A2_BLOCK(6, skA, svA, skB, svB, qfA, qfB); A2_BLOCK(7, skB, svB, skA, svA, qfB, qfA);
#undef A2_BLOCK
#undef A2_GLOAD
#undef A2_GWRITE
#undef A2_WIDEN
#undef A2_QLOAD
}

__device__ __forceinline__ void attn_phase(ALAS unsigned char* lds, const bf16* Q, const bf16* K, const bf16* V, bf16* O, float* LSE) {
    const int G_ = gridDim.x, vcu = (G_ % 8 == 0) ? ((int)blockIdx.x % 8) * (G_ / 8) + (int)blockIdx.x / 8 : (int)blockIdx.x;
    for (int it = vcu; it < 768; it += G_) { const int i4 = it & 3, h = (it >> 2) & 15, bg = it >> 6, b = bg / 3, g = bg - 3 * b;
        attn_item(lds, b, g, h, 8 * i4, Q, K, V, O, LSE); }
}
#undef ALAS
}
namespace hg {
typedef short bf16x8 __attribute__((ext_vector_type(8)));
typedef short s16x4 __attribute__((ext_vector_type(4)));
typedef float f32x16 __attribute__((ext_vector_type(16)));
typedef float f32x4 __attribute__((ext_vector_type(4)));
typedef float f32x2 __attribute__((ext_vector_type(2)));
typedef unsigned u32x4 __attribute__((ext_vector_type(4)));
typedef _Float16 f16x2_t __attribute__((ext_vector_type(2)));
#define HLAS __attribute__((address_space(3)))
constexpr int QT_OFF = 0, QT_ST = 264;
constexpr int QH_OFF = 16896, QH_ST = 272;
constexpr int KC_OFF = 34304, KC_ST = 272;
constexpr int KCT_OFF = 51712, KCT_ST = 144;
constexpr int VT_OFF = 70144, VT_ST = 144;
constexpr int GAM_OFF = 88576;
constexpr int TOT_OFF = 89088;
constexpr int OB_OFF = 93184, OB_ST = 132;
constexpr int LDS_END = OB_OFF + 64 * OB_ST * 4;
static_assert(LDS_END <= 131072, "hgrn LDS map");
typedef __bf16 bf16x2_t __attribute__((ext_vector_type(2)));
__device__ __forceinline__ unsigned cvtpk(float lo, float hi) { const f32x2 v = {lo, hi}; const bf16x2_t b = __builtin_convertvector(v, bf16x2_t); return __builtin_bit_cast(unsigned, b); }
__device__ __forceinline__ float ex(float x) { return __builtin_amdgcn_exp2f(x * 1.4426950408889634f); }
__device__ __forceinline__ float blo(unsigned w) { return __builtin_bit_cast(float, w << 16); }
__device__ __forceinline__ float bhi(unsigned w) { return __builtin_bit_cast(float, w & 0xffff0000u); }
__device__ __forceinline__ bf16x8 pack8(const f32x16& x, int o) {
    u32x4 w = {cvtpk(x[o + 0], x[o + 1]), cvtpk(x[o + 2], x[o + 3]), cvtpk(x[o + 4], x[o + 5]), cvtpk(x[o + 6], x[o + 7])}; return __builtin_bit_cast(bf16x8, w); }
__device__ __forceinline__ bf16x8 ld2x8(const HLAS unsigned char* p) {
    const s16x4 lo = *(const HLAS s16x4*)p, hi = *(const HLAS s16x4*)(p + 16); return (bf16x8){lo[0], lo[1], lo[2], lo[3], hi[0], hi[1], hi[2], hi[3]}; }

template <bool STATE_ONLY>
__device__ __forceinline__ void hgrn_chunked(HLAS unsigned char* lds, int bh, int seg_i, int ch0, int nch, const unsigned short* Qb, const unsigned short* Kb, const unsigned short* Vb, unsigned short* Ob,
                                             const float* LOGF, const unsigned short* SGb, const float* ogain, float* Sbase, float* Gbase) {
    constexpr int SEQ_ = 4096, DM_ = 2048, HD_ = 128;
    int tid_ = threadIdx.x; asm volatile("" : "+v"(tid_));
    const int tid = tid_, wid = __builtin_amdgcn_readfirstlane(tid >> 6), lane = tid & 63, wt = wid >> 2, wv = wid & 3, c = lane & 31, hi = lane >> 5;
    const int b = bh >> 4, h = bh & 15;
    const size_t goff0 = ((size_t)bh * SEQ_ + 8 * wid) * HD_ + 2 * lane;
    const int t4 = tid >> 3, seg = tid & 7;
    f32x4 gn[4];
    if constexpr (!STATE_ONLY) {
#pragma unroll
        for (int i = 0; i < 4; ++i) gn[i] = *(const f32x4*)(ogain + 16 * seg + 4 * i); }
    f32x16 S[4];
#pragma unroll
    for (int kt = 0; kt < 4; ++kt)
#pragma unroll
        for (int r = 0; r < 16; ++r) S[kt][r] = 0.f;
    if constexpr (!STATE_ONLY) {
        for (int j = 0; j < seg_i; ++j) { const float* Sj = Sbase + (size_t)j * HD_ * HD_ + 32 * wv + c; const float* Gj = Gbase + j * HD_;
#pragma unroll
            for (int kt = 0; kt < 4; ++kt)
#pragma unroll
                for (int r = 0; r < 16; ++r) { const int k = 32 * kt + (r & 3) + 8 * (r >> 2) + 4 * hi; S[kt][r] = ex(Gj[k]) * S[kt][r] + Sj[(size_t)k * HD_]; } } }
    float gs0 = 0.f, gs1 = 0.f;
#ifdef HG_STORE_K
    unsigned kv[8];
#endif
    f32x2 lfh[8]; unsigned qv[8], vv[8];
#ifdef HG_STORE_K
#define HG_KLOAD(i, o_) kv[i] = *(const unsigned*)(Kb + o_)
#define HG_K(i) const float k0 = blo(kv[i]), k1 = bhi(kv[i])
#else
#define HG_KLOAD(i, o_)
#define HG_K(i) const float k0 = 1.0f - ex(l0[i]), k1 = 1.0f - ex(l1[i])
#endif
#define HG_LOAD(t0_) do { _Pragma("unroll") for (int i = 0; i < 8; ++i) { const size_t o_ = goff0 + (size_t)((t0_) + i) * HD_; \
        lfh[i] = *(const f32x2*)(LOGF + o_); HG_KLOAD(i, o_); vv[i] = *(const unsigned*)(Vb + o_); if constexpr (!STATE_ONLY) qv[i] = *(const unsigned*)(Qb + o_); } } while (0)
    HG_LOAD(ch0 * 64);
    HLAS float* TOT = (HLAS float*)(lds + TOT_OFF); HLAS float* GAM = (HLAS float*)(lds + GAM_OFF); HLAS float* OB = (HLAS float*)(lds + OB_OFF);
    for (int ch = ch0; ch < ch0 + nch; ++ch) {
        const int t0 = ch * 64;
        float f0[8], f1[8], cs0 = 0.f, cs1 = 0.f;
#pragma unroll
        for (int i = 0; i < 8; ++i) { const float a0 = lfh[i][0], a1 = lfh[i][1]; cs0 += a0; cs1 += a1; f0[i] = ex(a0); f1[i] = ex(a1); }
        *(HLAS f32x2*)(TOT + wid * 128 + 2 * lane) = (f32x2){cs0, cs1};
        __syncthreads();
        {
            float pre0 = 0.f, pre1 = 0.f, tot0 = 0.f, tot1 = 0.f;
#pragma unroll
            for (int w = 0; w < 8; ++w) { const f32x2 tv = *(const HLAS f32x2*)(TOT + w * 128 + 2 * lane); tot0 += tv[0]; tot1 += tv[1]; if (w < wid) { pre0 += tv[0]; pre1 += tv[1]; } }
            gs0 += tot0; gs1 += tot1;
            const float rg0 = ex(fminf(-tot0, 80.f)), rg1 = ex(fminf(-tot1, 80.f));
            float kc0[8], kc1[8];
            { float r0 = ex(tot0 - pre0 - cs0), r1 = ex(tot1 - pre1 - cs1);
#pragma unroll
              for (int i = 7; i >= 0; --i) { kc0[i] = (1.0f - f0[i]) * r0; kc1[i] = (1.0f - f1[i]) * r1; r0 *= f0[i]; r1 *= f1[i]; } }
            if constexpr (!STATE_ONLY) { float e0 = ex(pre0), e1 = ex(pre1);
#pragma unroll
                for (int i = 0; i < 8; ++i) { const int t = 8 * wid + i; e0 *= f0[i]; e1 *= f1[i];
                    const float qt0 = blo(qv[i]) * e0, qt1 = bhi(qv[i]) * e1;
                    *(HLAS unsigned*)(lds + QT_OFF + t * QT_ST + lane * 4) = cvtpk(qt0, qt1);
                    *(HLAS unsigned*)(lds + QH_OFF + t * QH_ST + lane * 4) = cvtpk(qt0 * rg0, qt1 * rg1);
                    *(HLAS unsigned*)(lds + KC_OFF + t * KC_ST + lane * 4) = cvtpk(kc0[i], kc1[i]); } }
            *(HLAS u32x4*)(lds + KCT_OFF + (2 * lane) * KCT_ST + wid * 16) = (u32x4){cvtpk(kc0[0], kc0[1]), cvtpk(kc0[2], kc0[3]), cvtpk(kc0[4], kc0[5]), cvtpk(kc0[6], kc0[7])};
            *(HLAS u32x4*)(lds + KCT_OFF + (2 * lane + 1) * KCT_ST + wid * 16) = (u32x4){cvtpk(kc1[0], kc1[1]), cvtpk(kc1[2], kc1[3]), cvtpk(kc1[4], kc1[5]), cvtpk(kc1[6], kc1[7])};
            *(HLAS u32x4*)(lds + VT_OFF + (2 * lane) * VT_ST + wid * 16) = (u32x4){(vv[0] & 0xffffu) | (vv[1] << 16), (vv[2] & 0xffffu) | (vv[3] << 16), (vv[4] & 0xffffu) | (vv[5] << 16), (vv[6] & 0xffffu) | (vv[7] << 16)};
            *(HLAS u32x4*)(lds + VT_OFF + (2 * lane + 1) * VT_ST + wid * 16) = (u32x4){(vv[0] >> 16) | (vv[1] & 0xffff0000u), (vv[2] >> 16) | (vv[3] & 0xffff0000u), (vv[4] >> 16) | (vv[5] & 0xffff0000u), (vv[6] >> 16) | (vv[7] & 0xffff0000u)};
            if (wid == 0) *(HLAS f32x2*)(GAM + 2 * lane) = (f32x2){ex(tot0), ex(tot1)};
        }
        if (ch + 1 < ch0 + nch) HG_LOAD(t0 + 64);
        const size_t ooff = (size_t)(b * SEQ_ + t0 + t4) * DM_ + h * HD_ + 16 * seg;
        u32x4 sg0, sg1;
        if constexpr (!STATE_ONLY) { const size_t so_ = ((size_t)bh * SEQ_ + t0 + t4) * HD_ + 16 * seg; sg0 = *(const u32x4*)(SGb + so_); sg1 = *(const u32x4*)(SGb + so_ + 8); }
        __syncthreads();
        {
            const HLAS unsigned char* vrow = lds + VT_OFF + (32 * wv + c) * VT_ST;
            f32x16 O;
            if constexpr (!STATE_ONLY) {
            f32x16 X0, X1;
#pragma unroll
            for (int r = 0; r < 16; ++r) { O[r] = 0.f; X0[r] = 0.f; X1[r] = 0.f; }
            const HLAS unsigned char* qhp = lds + QH_OFF + (32 * wt + c) * QH_ST + hi * 16;
            { const HLAS unsigned char* kp = lds + KC_OFF + c * KC_ST + hi * 16;
#pragma unroll
              for (int ks = 0; ks < 8; ++ks) X0 = __builtin_amdgcn_mfma_f32_32x32x16_bf16(*(const HLAS bf16x8*)(kp + ks * 32), *(const HLAS bf16x8*)(qhp + ks * 32), X0, 0, 0, 0); }
            if (wt == 1) { const HLAS unsigned char* kp = lds + KC_OFF + (32 + c) * KC_ST + hi * 16;
#pragma unroll
              for (int ks = 0; ks < 8; ++ks) X1 = __builtin_amdgcn_mfma_f32_32x32x16_bf16(*(const HLAS bf16x8*)(kp + ks * 32), *(const HLAS bf16x8*)(qhp + ks * 32), X1, 0, 0, 0); }
#pragma unroll
            for (int r = 0; r < 16; ++r) { const bool drop = ((r & 3) + 8 * (r >> 2) + 4 * hi) > c; if (wt == 0) { if (drop) X0[r] = 0.f; } else { if (drop) X1[r] = 0.f; } }
#pragma unroll
            for (int st = 0; st < 2; ++st) O = __builtin_amdgcn_mfma_f32_32x32x16_bf16(pack8(X0, 8 * st), ld2x8(vrow + (16 * st + 4 * hi) * 2), O, 0, 0, 0);
            if (wt == 1) {
#pragma unroll
                for (int st = 0; st < 2; ++st) O = __builtin_amdgcn_mfma_f32_32x32x16_bf16(pack8(X1, 8 * st), ld2x8(vrow + (32 + 16 * st + 4 * hi) * 2), O, 0, 0, 0); }
            const HLAS unsigned char* qtp = lds + QT_OFF + (32 * wt + c) * QT_ST + 8 * hi;
#pragma unroll
            for (int kt = 0; kt < 4; ++kt)
#pragma unroll
                for (int st = 0; st < 2; ++st) O = __builtin_amdgcn_mfma_f32_32x32x16_bf16(ld2x8(qtp + (32 * kt + 16 * st) * 2), pack8(S[kt], 8 * st), O, 0, 0, 0);
            }
            bf16x8 vb[4];
#pragma unroll
            for (int st = 0; st < 4; ++st) vb[st] = *(const HLAS bf16x8*)(vrow + (16 * st + 8 * hi) * 2);
#pragma unroll
            for (int kt = 0; kt < 4; ++kt) {
#pragma unroll
                for (int g = 0; g < 4; ++g) { const f32x4 gm = *(const HLAS f32x4*)(GAM + 32 * kt + 8 * g + 4 * hi);
#pragma unroll
                    for (int j = 0; j < 4; ++j) S[kt][4 * g + j] *= gm[j]; }
                const HLAS unsigned char* kp = lds + KCT_OFF + (32 * kt + c) * KCT_ST + hi * 16;
#pragma unroll
                for (int st = 0; st < 4; ++st) S[kt] = __builtin_amdgcn_mfma_f32_32x32x16_bf16(*(const HLAS bf16x8*)(kp + st * 32), vb[st], S[kt], 0, 0, 0);
            }
            if constexpr (!STATE_ONLY) {
#pragma unroll
            for (int r = 0; r < 16; ++r) OB[(32 * wt + (r & 3) + 8 * (r >> 2) + 4 * hi) * OB_ST + 32 * wv + c] = O[r]; }
        }
        if constexpr (!STATE_ONLY) {
        __syncthreads();
        {
            f32x4 o[4]; float s = 0.f;
#pragma unroll
            for (int i = 0; i < 4; ++i) { o[i] = *(const HLAS f32x4*)(OB + t4 * OB_ST + 16 * seg + 4 * i); s += (o[i][0] * o[i][0] + o[i][1] * o[i][1]) + (o[i][2] * o[i][2] + o[i][3] * o[i][3]); }
            s += __shfl_xor(s, 1); s += __shfl_xor(s, 2); s += __shfl_xor(s, 4);
            const float sc = __builtin_amdgcn_rsqf(s * (1.0f / HD_) + 1e-6f);
            u32x4 w0, w1;
#pragma unroll
            for (int e = 0; e < 4; ++e) { const int i = e >> 1, j = (e & 1) * 2;
                w0[e] = cvtpk(o[i][j] * sc * gn[i][j] * blo(sg0[e]), o[i][j + 1] * sc * gn[i][j + 1] * bhi(sg0[e]));
                w1[e] = cvtpk(o[2 + i][j] * sc * gn[2 + i][j] * blo(sg1[e]), o[2 + i][j + 1] * sc * gn[2 + i][j + 1] * bhi(sg1[e])); }
            *(u32x4*)(Ob + ooff) = w0; *(u32x4*)(Ob + ooff + 8) = w1;
        }
        }
    }
    if constexpr (STATE_ONLY) {
        if (wt == 0) { float* Sj = Sbase + (size_t)seg_i * HD_ * HD_ + 32 * wv + c;
#pragma unroll
            for (int kt = 0; kt < 4; ++kt)
#pragma unroll
                for (int r = 0; r < 16; ++r) Sj[(size_t)(32 * kt + (r & 3) + 8 * (r >> 2) + 4 * hi) * HD_] = S[kt][r]; }
        if (wid == 0) *(f32x2*)(Gbase + seg_i * HD_ + 2 * lane) = (f32x2){gs0, gs1};
    }
#undef HG_LOAD
}
#undef HLAS
}
constexpr int BATCH = 4, SEQ = 4096, DM = 2048, MROWS = BATCH * SEQ, FFH = 5632, NHEAD = 16, HDIM = 128;
constexpr int NWAVES = 8;
constexpr int F8_FIRST_LAYER = 4, F8_FFN1_LAYER = 4;
constexpr size_t MiB = 1u << 20;
constexpr size_t WS_CTL = 0, WS_SS = 1 * MiB, CTL_ZERO_BYTES = 3 * MiB;
constexpr size_t WS_LBS = 3 * MiB, WS_JOBS = 3 * MiB + 32768, WS_ROPE = 3 * MiB + 65536;
constexpr size_t WS_WMAX = 2 * MiB;
constexpr size_t WS_ASC = 3 * MiB + 640 * 1024, WS_WSC = 3 * MiB + 704 * 1024;
constexpr size_t WS_WMAX2 = WS_WMAX + 256 * 1024, WS_ASC2 = 3 * MiB + 576 * 1024, WS_WSC2 = 3 * MiB + 896 * 1024;
#define I8_FFN2(L_) ((L_) == 2)
constexpr int I8_FFN1_LAYER = 0;
constexpr size_t WS_W = 4 * MiB;
constexpr size_t WS_WA_IN = WS_W, WS_WA_OUT = WS_W + 64 * MiB, WS_WF_IN = WS_W + 80 * MiB, WS_WF_OUT = WS_W + 256 * MiB,
                 WS_WQKV2 = WS_W + 344 * MiB, WS_WQ3 = WS_W + 416 * MiB, WS_WB_OUT = WS_W + 440 * MiB;
constexpr size_t WS_XB = 460 * MiB;
constexpr size_t WS_R1 = 524 * MiB;
constexpr size_t WS_R2 = 908 * MiB;
constexpr size_t WS_OG = 1168 * MiB;
constexpr size_t WS_X8 = 1360 * MiB;
constexpr size_t WS_END = 1392 * MiB;
constexpr int CW_BAR = 1024;
constexpr int RING_BYTES = 131072, SCR_OFF = 131072, LDS_BYTES = 163840, MISC_OFF = LDS_BYTES - 512;
static_assert(SCR_OFF == pg8::QKV_SCR_OFF && att2::LDS_NEED <= MISC_OFF && pg8::QKV_EPS_OFF + 1024 <= MISC_OFF, "LDS map");

#define GAS __attribute__((address_space(1)))
#define LAS __attribute__((address_space(3)))
typedef unsigned short bf16;
typedef unsigned v4u __attribute__((ext_vector_type(4)));
typedef unsigned v2u __attribute__((ext_vector_type(2)));
typedef float f32x4 __attribute__((ext_vector_type(4)));
#define LDS_WAIT() asm volatile("s_waitcnt lgkmcnt(0)" ::: "memory")
__device__ __forceinline__ unsigned f2bf(float f) { unsigned u = __builtin_bit_cast(unsigned, f); return (u + 0x7fffu + ((u >> 16) & 1u)) >> 16; }
__device__ __forceinline__ unsigned pk2(float lo, float hi) { return f2bf(lo) | (f2bf(hi) << 16); }
__device__ __forceinline__ float bflo(unsigned w) { return __builtin_bit_cast(float, w << 16); }
__device__ __forceinline__ float bfhi(unsigned w) { return __builtin_bit_cast(float, w & 0xffff0000u); }

#define XB_TMO      128
#define XB_XCNT(j)  (256  + 64 * (j))
#define XB_XSUB(j)  (1280 + 64 * (j))
#define XB_XGEN(j)  (2304 + 64 * (j))
#define XB_TOP      3328
#define XB_TOPGEN   3392
#define XCD_BAR_WORDS 3456
#define XB_SPIN_CAP (1u << 18)

__device__ __forceinline__ unsigned xb_ld(unsigned* p)              { return __hip_atomic_load(p, __ATOMIC_RELAXED, __HIP_MEMORY_SCOPE_AGENT); }
__device__ __forceinline__ unsigned xb_add(unsigned* p, unsigned v) { return __hip_atomic_fetch_add(p, v, __ATOMIC_RELAXED, __HIP_MEMORY_SCOPE_AGENT); }
__device__ __forceinline__ unsigned xb_xcc_id() { return (unsigned)__builtin_amdgcn_s_getreg((3 << 11) | 20) & 0xFu; }
#define XB_SPIN(cond, bar) do { unsigned _sp = 0; while (cond) { __builtin_amdgcn_s_sleep(1); \
    if ((++_sp & 255u) == 0u) { if (xb_ld(&(bar)[XB_TMO])) break; if (_sp > XB_SPIN_CAP) { atomicAdd(&(bar)[XB_TMO], 1u); break; } } } } while (0)

struct XcdBarrier {
    unsigned* bar; unsigned x;
    volatile LAS unsigned* st;
};

__device__ __forceinline__ XcdBarrier xcd_barrier_post(unsigned* bar, volatile LAS unsigned* st) {
    XcdBarrier b; b.bar = bar; b.x = xb_xcc_id(); b.st = st;
    if (threadIdx.x == 0) (void)xb_add(&bar[XB_XCNT(b.x)], 1u);
    return b;
}
__device__ __forceinline__ void xcd_barrier_complete(unsigned* bar, unsigned x, unsigned& nloc, unsigned& nx) {
    const unsigned G = gridDim.x * gridDim.y * gridDim.z;
    unsigned sum, cnt, mine, sp = 0u;
    for (;;) {
        sum = 0u; cnt = 0u; mine = 0u;
#pragma unroll
        for (unsigned j = 0; j < 16; ++j) { const unsigned c = xb_ld(&bar[XB_XCNT(j)]); sum += c; cnt += (c > 0u) ? 1u : 0u; mine = (j == x) ? c : mine; }
        if (sum == G) break;
        __builtin_amdgcn_s_sleep(1);
        if ((++sp & 255u) == 0u) { if (xb_ld(&bar[XB_TMO])) break; if (sp > XB_SPIN_CAP) { atomicAdd(&bar[XB_TMO], 1u); break; } }
    }
    nloc = mine > 0u ? mine : 1u; nx = cnt > 0u ? cnt : 1u;
}

__device__ __forceinline__ void xcd_barrier(const XcdBarrier& b) {
    asm volatile("s_waitcnt vmcnt(0)" ::: "memory");
    __syncthreads();
    if (threadIdx.x == 0) {
        unsigned* bar = b.bar;
        __builtin_amdgcn_s_waitcnt(0);
        unsigned nloc = b.st[0], nx = b.st[1];
        if (nloc == 0u) { xcd_barrier_complete(bar, b.x, nloc, nx); b.st[0] = nloc; b.st[1] = nx; }
        const unsigned old = xb_add(&bar[XB_XSUB(b.x)], 1u);
        const unsigned gen = old / nloc;
        if (old + 1u == (gen + 1u) * nloc) {
            __builtin_amdgcn_fence(__ATOMIC_RELEASE, "agent");
            asm volatile("s_waitcnt vmcnt(0)" ::: "memory");
            const unsigned og = xb_add(&bar[XB_TOP], 1u);
            const unsigned tg = og / nx;
            if (og + 1u == (tg + 1u) * nx) xb_add(&bar[XB_TOPGEN], 1u);
            else XB_SPIN(xb_ld(&bar[XB_TOPGEN]) == tg, bar);
            __builtin_amdgcn_fence(__ATOMIC_ACQUIRE, "agent");
            asm volatile("s_waitcnt vmcnt(0)" ::: "memory");
        } else {
            XB_SPIN(xb_ld(&bar[XB_TOPGEN]) == gen, bar);
            __builtin_amdgcn_fence(__ATOMIC_ACQUIRE, "agent");
            asm volatile("s_waitcnt vmcnt(0)" ::: "memory");
        }
    }
    __syncthreads();
}


__device__ __forceinline__ float wave_sum(float v) {
#pragma unroll
    for (int o = 1; o < 64; o <<= 1) v += __shfl_xor(v, o);
    return v;
}
__device__ __forceinline__ void conv_load64(float (&w)[64], const float* W, int ldw, int k0, int n0, int lane) {
    const float* src = W + (size_t)k0 * ldw + n0 + lane;
#pragma unroll
    for (int kk = 0; kk < 64; ++kk) w[kk] = __builtin_nontemporal_load(src + (size_t)kk * ldw);
}
__device__ __forceinline__ unsigned pack4_i8(float a, float b, float c, float d, float s) {
    const int q0 = (int)__builtin_rintf(__builtin_amdgcn_fmed3f(a * s, -127.f, 127.f)), q1 = (int)__builtin_rintf(__builtin_amdgcn_fmed3f(b * s, -127.f, 127.f)), q2 = (int)__builtin_rintf(__builtin_amdgcn_fmed3f(c * s, -127.f, 127.f)), q3 = (int)__builtin_rintf(__builtin_amdgcn_fmed3f(d * s, -127.f, 127.f));
    return (unsigned)(q0 & 255) | ((unsigned)(q1 & 255) << 8) | ((unsigned)(q2 & 255) << 16) | ((unsigned)(q3 & 255) << 24); }
__device__ __forceinline__ void conv_store64(const float (&w)[64], int K, const float* gain, bf16* WT, int k0, int nd0, LAS float* scr, int lane, bool f8 = false, const unsigned* wmax = nullptr, float* wsc = nullptr, int n0 = 0) {
    if (gain) {
#pragma unroll
        for (int kk = 0; kk < 64; ++kk) scr[kk * 65 + lane] = w[kk] * gain[k0 + kk]; }
    else {
#pragma unroll
        for (int kk = 0; kk < 64; ++kk) scr[kk * 65 + lane] = w[kk]; }
    LDS_WAIT(); asm volatile("" ::: "memory");
    const int c = lane & 7;
#pragma unroll
    for (int j = 0; j < 8; ++j) { const int n = (lane >> 3) + 8 * j; const LAS float* s = scr + (8 * c) * 65 + n;
        if (wmax) { const float am = fmaxf(__builtin_bit_cast(float, wmax[n0 + n]), 1e-30f), sc = 127.0f / am;
            v2u o; o.x = pack4_i8(s[0 * 65], s[1 * 65], s[2 * 65], s[3 * 65], sc); o.y = pack4_i8(s[4 * 65], s[5 * 65], s[6 * 65], s[7 * 65], sc);
            __builtin_nontemporal_store(o, (GAS v2u*)((unsigned char*)WT + (size_t)(nd0 + n) * K + k0 + 8 * c));
            if (k0 == 0 && c == 0) wsc[nd0 + n] = am * (1.0f / 127.0f); }
        else if (f8) { v2u o; o.x = pg8::cvt4_fp8(s[0 * 65], s[1 * 65], s[2 * 65], s[3 * 65], pg8::F8_WSCALE); o.y = pg8::cvt4_fp8(s[4 * 65], s[5 * 65], s[6 * 65], s[7 * 65], pg8::F8_WSCALE);
            __builtin_nontemporal_store(o, (GAS v2u*)((unsigned char*)WT + (size_t)(nd0 + n) * K + k0 + 8 * c)); }
        else { v4u o; o.x = pk2(s[0 * 65], s[1 * 65]); o.y = pk2(s[2 * 65], s[3 * 65]); o.z = pk2(s[4 * 65], s[5 * 65]); o.w = pk2(s[6 * 65], s[7 * 65]);
            __builtin_nontemporal_store(o, (GAS v4u*)(WT + (size_t)(nd0 + n) * K + k0 + 8 * c)); } }
    LDS_WAIT(); asm volatile("" ::: "memory");
}

struct Args { const float* in[16]; float* out; unsigned char* ws; };


__device__ __forceinline__ void wmax_tensor(const float* W, const float* gain, int K, int N, unsigned* wm, int gw, int NGW, int lane) {
    const int nblk = N / 64, nkb = K / 64, nitems = nkb * nblk;
    for (int it = gw; it < nitems; it += NGW) { const int k0 = 64 * (it % nkb), n0 = 64 * (it / nkb); const float* src = W + (size_t)k0 * N + n0 + lane; float m = 0.f;
#pragma unroll 16
        for (int kk = 0; kk < 64; ++kk) m = fmaxf(m, __builtin_fabsf(src[(size_t)kk * N] * (gain ? gain[k0 + kk] : 1.0f)));
        atomicMax(wm + n0 + lane, __builtin_bit_cast(unsigned, m)); }
}
__device__ __forceinline__ void wmax_pass(const Args& a, int gw, int NGW, int lane) {
    for (int l = I8_FFN1_LAYER; l < 4; ++l) wmax_tensor(a.in[14] + (size_t)l * DM * 2 * FFH, a.in[13] + l * DM, DM, 2 * FFH, (unsigned*)(a.ws + WS_WMAX) + l * 2 * FFH, gw, NGW, lane);
    for (int l = 0; l < 4; ++l) if (I8_FFN2(l)) wmax_tensor(a.in[15] + (size_t)l * FFH * DM, nullptr, FFH, DM, (unsigned*)(a.ws + WS_WMAX2) + l * DM, gw, NGW, lane);
}
template <int NP = 4>
__device__ __forceinline__ void quant_rows(const bf16* xb, const pg8::ssq_t* ss, unsigned char* xq, float* asc, int gw, int NGW, int lane) {
    constexpr int DM = NP * 512;
    for (int r = gw; r < MROWS; r += NGW) { const float rs = ss ? pg8::ss_to_rs(ss[r]) : 1.0f; const GAS v4u* src = (const GAS v4u*)(xb + (size_t)r * DM) + lane; v4u w[NP]; float m = 0.f;
#pragma unroll
        for (int j = 0; j < NP; ++j) { w[j] = src[64 * j];
#pragma unroll
            for (int q = 0; q < 4; ++q) m = fmaxf(m, fmaxf(__builtin_fabsf(bflo(w[j][q])), __builtin_fabsf(bfhi(w[j][q])))); }
#pragma unroll
        for (int o = 1; o < 64; o <<= 1) m = fmaxf(m, __shfl_xor(m, o));
        const float am = fmaxf(m * rs, 1e-30f), sc = rs * (127.0f / am);
#pragma unroll
        for (int j = 0; j < NP; ++j) { v2u o; o.x = pack4_i8(bflo(w[j][0]), bfhi(w[j][0]), bflo(w[j][1]), bfhi(w[j][1]), sc); o.y = pack4_i8(bflo(w[j][2]), bfhi(w[j][2]), bflo(w[j][3]), bfhi(w[j][3]), sc);
            *((GAS v2u*)(xq + (size_t)r * DM) + lane + 64 * j) = o; }
        if (lane == 0) asc[r] = am * (1.0f / 127.0f); }
}
__device__ __forceinline__ void prologue(const Args& a, LAS unsigned char* lds, int gw, int NGW, int lane, int wave) {
    unsigned char* ws = a.ws;
    { float* lbs = (float*)(ws + WS_LBS); const float* alb = a.in[5];
      for (int i = gw * 64 + lane; i < DM; i += NGW * 64) { const float a0 = alb[i], a1 = alb[DM + i]; float s1 = 1.0f / (1.0f + expf(a0 - a1)); s1 = fminf(fmaxf(s1, 0.0f), 1.0f - 1e-6f); lbs[i] = 0.0f; lbs[DM + i] = s1; } }
    { _Float16* rope = (_Float16*)(ws + WS_ROPE);
      for (int i = gw * 64 + lane; i < SEQ * 16; i += NGW * 64) { const int pos = i >> 4, j = i & 15; double inv = 1.0;
          for (int q = 0; q < j; ++q) inv *= 0.4403666026717805;
          const double ang = (double)pos * inv, nrev = __builtin_rint(ang * 0.15915494309189535);
          const double r = (ang - nrev * 6.283185307179586) - nrev * 2.4492935982947064e-16, r2 = r * r;
          double ts = r, sn = r, tc = 1.0, cs = 1.0;
          for (int q = 1; q <= 14; ++q) { tc *= -r2 / (double)((2 * q - 1) * (2 * q)); cs += tc; ts *= -r2 / (double)((2 * q) * (2 * q + 1)); sn += ts; }
          rope[pos * 32 + j] = (_Float16)(float)cs; rope[pos * 32 + 16 + j] = (_Float16)(float)sn; } }
    { const float* x = a.in[0]; bf16* xb = (bf16*)(ws + WS_XB); pg8::ssq_t* ss0 = (pg8::ssq_t*)(ws + WS_SS);
      for (int m = gw; m < MROWS; m += NGW) { const GAS f32x4* xr = (const GAS f32x4*)(x + (size_t)m * DM) + lane; GAS v2u* o8 = (GAS v2u*)(xb + (size_t)m * DM) + lane; float s = 0.f;
#pragma unroll
          for (int j = 0; j < 8; ++j) { const f32x4 v = xr[64 * j]; s += (v.x * v.x + v.y * v.y) + (v.z * v.z + v.w * v.w); v2u w; w.x = pk2(v.x, v.y); w.y = pk2(v.z, v.w); o8[64 * j] = w; }
          s = wave_sum(s); if (lane == 0) ss0[m] = (pg8::ssq_t)(s * pg8::SS_SCALE + 0.5f); } }
    pg8::ConvJob* jobs = (pg8::ConvJob*)(ws + WS_JOBS);
    LAS float* scr = (LAS float*)(lds + wave * 16640);
    for (int job = 0; job < 17; ++job) {
        const float* W; const float* gain = nullptr; bf16* dst; int K = DM, N, mode = 0, rowoff = 0;
        if (job < 2)       { W = a.in[2] + (size_t)job * DM * 8192; N = 8192; gain = a.in[1] + job * DM; dst = (bf16*)(ws + WS_WA_IN) + (size_t)job * 8192 * DM; }
        else if (job < 4)  { const int l = job - 2; W = a.in[4] + (size_t)l * DM * DM; N = DM; dst = (bf16*)(ws + WS_WA_OUT) + (size_t)l * DM * DM; }
        else if (job < 8)  { const int l = job - 4; W = a.in[14] + (size_t)l * DM * 2 * FFH; N = 2 * FFH; gain = a.in[13] + l * DM; dst = (bf16*)(ws + WS_WF_IN) + (size_t)l * 2 * FFH * DM; mode = 1; }
        else if (job < 12) { const int l = job - 8; W = a.in[15] + (size_t)l * FFH * DM; K = FFH; N = DM; dst = (bf16*)(ws + WS_WF_OUT) + (size_t)l * DM * FFH; }
        else if (job == 12) { W = a.in[10]; N = 6144; gain = a.in[9]; dst = (bf16*)(ws + WS_WQKV2); }
        else if (job == 13) { W = a.in[7]; N = 12288; gain = a.in[6]; dst = (bf16*)(ws + WS_WQKV2); rowoff = 6144; }
        else if (job == 14) { W = a.in[10] + (size_t)DM * 6144; N = 6144; gain = a.in[9] + DM; dst = (bf16*)(ws + WS_WQ3); }
        else { const int l = job - 15; W = a.in[12] + (size_t)l * DM * DM; N = DM; dst = (bf16*)(ws + WS_WB_OUT) + (size_t)l * DM * DM; }
        if (gw == 0 && lane == 0) { pg8::ConvJob J; J.W = W; J.gain = gain; J.dst = dst; J.K = K; J.N = N; J.mode = mode; J.rowoff = rowoff; jobs[job] = J; }
#ifndef CONV_ALL_IN_PROLOGUE
        if (!(job == 0 || job == 2 || job == 4 || job == 8)) continue;
#endif
        const bool i8job = job >= 4 + I8_FFN1_LAYER && job < 8;
        const bool i8ojob = job >= 8 && job < 12 && I8_FFN2(job - 8);
        const int nblk = N / 64, nkb = K / 64, nitems = nkb * nblk;
        float wa[64], wb[64];
#define CONV_KB 2
#define CONV_DEC(it_, k0_, n0_, nd0_) const int sg_##k0_ = (it_) >> 3, w_##k0_ = (it_) & 7, nkg_##k0_ = nkb / CONV_KB; \
        const int k0_ = 64 * (CONV_KB * (sg_##k0_ % nkg_##k0_) + (w_##k0_ % CONV_KB)), n0_ = 64 * ((8 / CONV_KB) * (sg_##k0_ / nkg_##k0_) + (w_##k0_ / CONV_KB)); int nd0_ = n0_ + rowoff; \
        if (mode == 1) { const int up_ = n0_ >= FFH, jn_ = up_ ? n0_ - FFH : n0_; nd0_ = 256 * (jn_ >> 7) + 128 * up_ + (jn_ & 127); }
        if (gw < nitems) { { CONV_DEC(gw, k0, n0, nd0); (void)nd0; conv_load64(wa, W, N, k0, n0, lane); }
            for (int it = gw; it < nitems; it += 2 * NGW) {
                const bool h1 = it + NGW < nitems, h2 = it + 2 * NGW < nitems;
                if (h1) { CONV_DEC(it + NGW, k0, n0, nd0); (void)nd0; conv_load64(wb, W, N, k0, n0, lane); }
                { CONV_DEC(it, k0, n0, nd0); conv_store64(wa, K, gain, dst, k0, nd0, scr, lane, (job >= 8 + F8_FIRST_LAYER && job < 12) || job >= 12 || (job >= 4 + F8_FFN1_LAYER && job < 8), i8job ? (const unsigned*)(ws + WS_WMAX) + (job - 4) * 2 * FFH : i8ojob ? (const unsigned*)(ws + WS_WMAX2) + (job - 8) * DM : nullptr, i8ojob ? (float*)(ws + WS_WSC2) + (job - 8) * DM : (float*)(ws + WS_WSC) + (job - 4) * 2 * FFH, n0); }
                if (h2) { CONV_DEC(it + 2 * NGW, k0, n0, nd0); (void)nd0; conv_load64(wa, W, N, k0, n0, lane); }
                if (h1) { CONV_DEC(it + NGW, k0, n0, nd0); conv_store64(wb, K, gain, dst, k0, nd0, scr, lane, (job >= 8 + F8_FIRST_LAYER && job < 12) || job >= 12 || (job >= 4 + F8_FFN1_LAYER && job < 8), i8job ? (const unsigned*)(ws + WS_WMAX) + (job - 4) * 2 * FFH : i8ojob ? (const unsigned*)(ws + WS_WMAX2) + (job - 8) * DM : nullptr, i8ojob ? (float*)(ws + WS_WSC2) + (job - 8) * DM : (float*)(ws + WS_WSC) + (job - 4) * 2 * FFH, n0); }
            } }
#undef CONV_DEC
    }
}

__device__ __forceinline__ void hgrn_naive(LAS unsigned char* lds, int bh, const bf16* Qb, const bf16* Kb, bf16* Vb, const float* LOGF, const bf16* SGb, const float* ogain) {
    int tid_ = threadIdx.x; asm volatile("" : "+v"(tid_));
    const int tid = tid_, b = bh >> 4, h = bh & 15, v = tid & 127, kg = tid >> 7;
    LAS float* Lf = (LAS float*)lds; LAS float* Lk = Lf + 2048; LAS float* Lq = Lk + 2048; LAS float* Lv = Lq + 2048; LAS float* Lp = Lv + 2048;
    float S[32];
#pragma unroll
    for (int j = 0; j < 32; ++j) S[j] = 0.f;
    const int stok = tid >> 5, sch = (tid & 31) * 4;
    for (int t0 = 0; t0 < SEQ; t0 += 16) {
        { const size_t off = (size_t)(b * SEQ + t0 + stok) * DM + h * HDIM + sch;
          const f32x4 lf = *(const f32x4*)(LOGF + off); const v2u kq = *(const v2u*)(Kb + off), qq = *(const v2u*)(Qb + off), vq = *(const v2u*)(Vb + off);
          *(LAS f32x4*)(Lf + stok * 128 + sch) = (f32x4){__expf(lf.x), __expf(lf.y), __expf(lf.z), __expf(lf.w)};
          *(LAS f32x4*)(Lk + stok * 128 + sch) = (f32x4){bflo(kq.x), bfhi(kq.x), bflo(kq.y), bfhi(kq.y)};
          *(LAS f32x4*)(Lq + stok * 128 + sch) = (f32x4){bflo(qq.x), bfhi(qq.x), bflo(qq.y), bfhi(qq.y)};
          *(LAS f32x4*)(Lv + stok * 128 + sch) = (f32x4){bflo(vq.x), bfhi(vq.x), bflo(vq.y), bfhi(vq.y)}; }
        __syncthreads();
        for (int tok = 0; tok < 16; ++tok) { const float vv = Lv[tok * 128 + v]; float acc = 0.f;
#pragma unroll
            for (int j4 = 0; j4 < 8; ++j4) { const f32x4 f = *(const LAS f32x4*)(Lf + tok * 128 + kg * 32 + 4 * j4), kk = *(const LAS f32x4*)(Lk + tok * 128 + kg * 32 + 4 * j4), qq = *(const LAS f32x4*)(Lq + tok * 128 + kg * 32 + 4 * j4);
#pragma unroll
                for (int e = 0; e < 4; ++e) { S[4 * j4 + e] = f[e] * S[4 * j4 + e] + kk[e] * vv; acc += qq[e] * S[4 * j4 + e]; } }
            Lp[(tok * 4 + kg) * 128 + v] = acc; }
        __syncthreads();
        { f32x4 o = *(const LAS f32x4*)(Lp + (stok * 4 + 0) * 128 + sch);
#pragma unroll
          for (int g = 1; g < 4; ++g) o += *(const LAS f32x4*)(Lp + (stok * 4 + g) * 128 + sch);
          float s = (o.x * o.x + o.y * o.y) + (o.z * o.z + o.w * o.w);
#pragma unroll
          for (int d = 1; d < 32; d <<= 1) s += __shfl_xor(s, d);
          const float sc = 1.0f / sqrtf(s * (1.0f / HDIM) + 1e-6f);
          const size_t off = (size_t)(b * SEQ + t0 + stok) * DM + h * HDIM + sch;
          const f32x4 gn = *(const f32x4*)(ogain + sch); const v2u sg = *(const v2u*)(SGb + off);
          v2u w; w.x = pk2(o.x * sc * gn.x * bflo(sg.x), o.y * sc * gn.y * bfhi(sg.x)); w.y = pk2(o.z * sc * gn.z * bflo(sg.y), o.w * sc * gn.w * bfhi(sg.y));
          *(v2u*)(Vb + off) = w; }
        __syncthreads();
    }
}

__device__ __forceinline__ void combine_phase(const bf16* OG, const float* LSE, bf16* OC) {
    typedef float f32x2c __attribute__((ext_vector_type(2)));
    const unsigned char* OG8 = (const unsigned char*)OG;
    const size_t nitem = (size_t)MROWS * (DM / 8), stride = (size_t)gridDim.x * blockDim.x;
    for (size_t i0 = (size_t)blockIdx.x * blockDim.x + threadIdx.x; i0 < nitem; i0 += 4 * stride) {
        v2u a[4], bb[4], cc[4]; float l0[4], l1[4], l2[4];
#pragma unroll
        for (int u = 0; u < 4; ++u) { const size_t i = i0 + u * stride; const size_t tok = i >> 8; const int c = (int)(i & 255) * 8, h = c >> 7, bb_ = (int)(tok >> 12), t_ = (int)(tok & 4095), d_ = c & 127;
            l0[u] = LSE[tok * 48 + h]; l1[u] = LSE[tok * 48 + 16 + h]; l2[u] = LSE[tok * 48 + 32 + h];
            a[u] = *(const v2u*)(OG8 + pg8::attn_row(bb_, 0, h, t_) * 128 + d_); bb[u] = *(const v2u*)(OG8 + pg8::attn_row(bb_, 1, h, t_) * 128 + d_); cc[u] = *(const v2u*)(OG8 + pg8::attn_row(bb_, 2, h, t_) * 128 + d_); }
#pragma unroll
        for (int u = 0; u < 4; ++u) { const size_t i = i0 + u * stride; const size_t tok = i >> 8; const int c = (int)(i & 255) * 8;
            const float mx = fmaxf(l0[u], fmaxf(l1[u], l2[u])); float w0 = __expf(l0[u] - mx), w1 = __expf(l1[u] - mx), w2 = __expf(l2[u] - mx); const float inv = 1.0f / (w0 + w1 + w2); w0 *= inv; w1 *= inv; w2 *= inv;
            float r[8];
#pragma unroll
            for (int e = 0; e < 2; ++e) {
                const f32x2c a0 = __builtin_amdgcn_cvt_pk_f32_fp8((int)a[u][e], false), a1 = __builtin_amdgcn_cvt_pk_f32_fp8((int)a[u][e], true);
                const f32x2c b0 = __builtin_amdgcn_cvt_pk_f32_fp8((int)bb[u][e], false), b1 = __builtin_amdgcn_cvt_pk_f32_fp8((int)bb[u][e], true);
                const f32x2c c0 = __builtin_amdgcn_cvt_pk_f32_fp8((int)cc[u][e], false), c1 = __builtin_amdgcn_cvt_pk_f32_fp8((int)cc[u][e], true);
                r[4 * e + 0] = w0 * a0[0] + w1 * b0[0] + w2 * c0[0]; r[4 * e + 1] = w0 * a0[1] + w1 * b0[1] + w2 * c0[1];
                r[4 * e + 2] = w0 * a1[0] + w1 * b1[0] + w2 * c1[0]; r[4 * e + 3] = w0 * a1[1] + w1 * b1[1] + w2 * c1[1]; }
            v2u o; o.x = pg8::cvt4_fp8(r[0], r[1], r[2], r[3], 1.0f); o.y = pg8::cvt4_fp8(r[4], r[5], r[6], r[7], 1.0f);
            *(v2u*)((unsigned char*)OC + tok * DM + c) = o; }
    }
}

#define GRID_BAR() xcd_barrier(bar)
template <int LAYER>
__device__ __forceinline__ void layer_phases(const Args& args, LAS unsigned char* lds, unsigned char* lds_raw, const XcdBarrier& bar) {
    unsigned char* ws = args.ws; const int G = gridDim.x;
    bf16* XB = (bf16*)(ws + WS_XB); pg8::ssq_t* SS = (pg8::ssq_t*)(ws + WS_SS); float* out = args.out;
    constexpr int ssi = 2 * LAYER;
    if constexpr (LAYER < 2) {
        bf16* HGO = (bf16*)(ws + WS_OG);
        bf16* Aq = (bf16*)(ws + WS_R1); bf16* Ak = Aq + (size_t)MROWS * DM; bf16* Av = Ak + (size_t)MROWS * DM; bf16* Asg = Av + (size_t)MROWS * DM; float* Alogf = (float*)(ws + WS_R1 + 256 * MiB);
#ifndef DIS_G1
        {
            pg8::Gemm g{XB, (const bf16*)(ws + WS_WA_IN) + (size_t)LAYER * 8192 * DM, MROWS, 8192, DM}; pg8::StaticOrder S; S.init(MROWS, 8192, G, (int)blockIdx.x);
            pg8::EpiHgrnIn E{Aq, Alogf, SS + (size_t)ssi * MROWS, (const float*)(ws + WS_LBS) + LAYER * DM};
            pg8::gemm_phase<pg8::EpiHgrnIn, pg8::StaticOrder, true, true>(lds, g, S, E);
#ifdef PROBE_REP_GEMM
            pg8::gemm_phase<pg8::EpiHgrnIn, pg8::StaticOrder, true, true>(lds, g, S, E);
#endif
        }
#endif
        GRID_BAR();
#ifndef DIS_HGRN
        {
            float* HS = (float*)(ws + WS_R2); float* HGm = (float*)(ws + WS_R2 + 16 * MiB);
            for (int u = blockIdx.x; u < BATCH * NHEAD * 3; u += G) { const int bh = u & 63, sg_ = u >> 6;
                hg::hgrn_chunked<true>(lds, bh, sg_, 16 * sg_, 16, Aq, Ak, Av, HGO, Alogf, Asg, args.in[3] + LAYER * HDIM, HS + (size_t)bh * 3 * HDIM * HDIM, HGm + bh * 3 * HDIM); }
#ifdef PROBE_REP_HG1
            __syncthreads();
            for (int u = blockIdx.x; u < BATCH * NHEAD * 3; u += G) { const int bh = u & 63, sg_ = u >> 6;
                hg::hgrn_chunked<true>(lds, bh, sg_, 16 * sg_, 16, Aq, Ak, Av, HGO, Alogf, Asg, args.in[3] + LAYER * HDIM, HS + (size_t)bh * 3 * HDIM * HDIM, HGm + bh * 3 * HDIM); }
#endif
            GRID_BAR();
            for (int u = blockIdx.x; u < BATCH * NHEAD * 4; u += G) { const int bh = u & 63, sg_ = u >> 6;
                hg::hgrn_chunked<false>(lds, bh, sg_, 16 * sg_, 16, Aq, Ak, Av, HGO, Alogf, Asg, args.in[3] + LAYER * HDIM, HS + (size_t)bh * 3 * HDIM * HDIM, HGm + bh * 3 * HDIM); }
#ifdef PROBE_REP_HG2
            __syncthreads();
            for (int u = blockIdx.x; u < BATCH * NHEAD * 4; u += G) { const int bh = u & 63, sg_ = u >> 6;
                hg::hgrn_chunked<false>(lds, bh, sg_, 16 * sg_, 16, Aq, Ak, Av, HGO, Alogf, Asg, args.in[3] + LAYER * HDIM, HS + (size_t)bh * 3 * HDIM * HDIM, HGm + bh * 3 * HDIM); }
#endif
        }
#endif
        GRID_BAR();
#ifndef DIS_G3
        {
            pg8::Gemm g{HGO, (const bf16*)(ws + WS_WA_OUT) + (size_t)LAYER * DM * DM, MROWS, DM, DM}; pg8::StaticOrder S; S.init(MROWS, DM, G, (int)blockIdx.x);
            pg8::EpiRes E{XB, nullptr, SS + (size_t)(ssi + 1) * MROWS, 1.0f, nullptr};
            pg8::gemm_phase<pg8::EpiRes, pg8::StaticOrder, true, true>(lds, g, S, E);
        }
#endif
    } else {
        bf16* KB = (bf16*)(ws + WS_R1); bf16* VB = (bf16*)(ws + WS_R1 + 192 * MiB);
        bf16* QO = (bf16*)(ws + WS_R2); bf16* OG = (bf16*)(ws + WS_OG); bf16* OC = (bf16*)(ws + WS_R2 + 192 * MiB); float* LSE = (float*)(ws + WS_R2 + 256 * MiB);
#ifndef DIS_G2
        {
            constexpr int N = LAYER == 2 ? 18432 : 6144;
            pg8::Gemm g{(const bf16*)(ws + WS_X8), LAYER == 2 ? (const bf16*)(ws + WS_WQKV2) : (const bf16*)(ws + WS_WQ3), MROWS, N, DM / 2}; pg8::StaticOrder S; S.init(MROWS, N, G, (int)blockIdx.x);
            pg8::EpiQkv E{QO, KB, VB, SS + (size_t)ssi * MROWS, args.in[11] + (LAYER - 2) * 3 * HDIM, args.in[8], (const _Float16*)(ws + WS_ROPE), 1.0f / (pg8::F8_XSCALE * pg8::F8_WSCALE)};
            pg8::gemm_phase<pg8::EpiQkv, pg8::StaticOrder, true, true, true>(lds, g, S, E);
#ifdef PROBE_REP_GEMM
            pg8::gemm_phase<pg8::EpiQkv, pg8::StaticOrder, true, true>(lds, g, S, E);
#endif
        }
#endif
        GRID_BAR();
#ifndef DIS_ATTN
#ifdef ATTN_OLD
        att::attn_phase((char*)lds_raw, QO, KB, VB, OG, LSE);
#else
        att2::attn_phase(lds, QO, KB, VB, OG, LSE);
#endif
#ifdef PROBE_REP_ATTN
        att2::attn_phase(lds, QO, KB, VB, OG, LSE);
#endif
#endif
        GRID_BAR();
#ifndef DIS_COMB
        combine_phase(OG, LSE, OC);
#endif
        GRID_BAR();
#ifndef DIS_G3
        {
            pg8::Gemm g{OC, (const bf16*)(ws + WS_WB_OUT) + (size_t)(LAYER - 2) * DM * DM, MROWS, DM, DM / 2}; pg8::StaticOrder S; S.init(MROWS, DM, G, (int)blockIdx.x);
            pg8::EpiRes E{XB, nullptr, SS + (size_t)(ssi + 1) * MROWS, 1.0f / (pg8::F8_XSCALE * pg8::F8_WSCALE), LAYER >= F8_FFN1_LAYER ? ws + WS_X8 : nullptr};
            pg8::gemm_phase<pg8::EpiRes, pg8::StaticOrder, true, true, true>(lds, g, S, E);
        }
#endif
    }
    GRID_BAR();
    bf16* HB = (bf16*)(ws + WS_R2);
#ifndef DIS_G4
    {
        constexpr bool I8I = LAYER >= I8_FFN1_LAYER;
        if constexpr (I8I) { int t_ = threadIdx.x; asm volatile("" : "+v"(t_)); quant_rows(XB, SS + (size_t)(ssi + 1) * MROWS, ws + WS_X8, (float*)(ws + WS_ASC), (int)blockIdx.x * NWAVES + (t_ >> 6), G * NWAVES, t_ & 63); GRID_BAR(); }
        constexpr bool F8I = !I8I && LAYER >= F8_FFN1_LAYER;
        pg8::Gemm g{(F8I || I8I) ? (const bf16*)(ws + WS_X8) : XB, (const bf16*)(ws + WS_WF_IN) + (size_t)LAYER * 2 * FFH * DM, MROWS, 2 * FFH, (F8I || I8I) ? DM / 2 : DM}; pg8::StaticOrder S; S.init(MROWS, 2 * FFH, G, (int)blockIdx.x);
#ifdef CONV_ALL_IN_PROLOGUE
        pg8::EpiFfn1 E{HB, FFH, SS + (size_t)(ssi + 1) * MROWS, (const pg8::ConvJob*)(ws + WS_JOBS), 3, LAYER >= F8_FIRST_LAYER && !I8_FFN2(LAYER), F8I ? 1.0f / (pg8::F8_XSCALE * pg8::F8_WSCALE) : 1.0f, I8I ? (const float*)(ws + WS_ASC) : nullptr, I8I ? (const float*)(ws + WS_WSC) + LAYER * 2 * FFH : nullptr};
#else
        pg8::EpiFfn1 E{HB, FFH, SS + (size_t)(ssi + 1) * MROWS, (const pg8::ConvJob*)(ws + WS_JOBS), LAYER, LAYER >= F8_FIRST_LAYER && !I8_FFN2(LAYER), F8I ? 1.0f / (pg8::F8_XSCALE * pg8::F8_WSCALE) : 1.0f, I8I ? (const float*)(ws + WS_ASC) : nullptr, I8I ? (const float*)(ws + WS_WSC) + LAYER * 2 * FFH : nullptr};
#endif
#ifdef PROBE_CLOCK
        const unsigned long long pc0 = clock64(), pw0 = wall_clock64();
#endif
        pg8::gemm_phase<pg8::EpiFfn1, pg8::StaticOrder, true, true, I8I ? 2 : (F8I ? 1 : 0)>(lds, g, S, E);
#ifdef PROBE_CLOCK
        if (LAYER == 0 && blockIdx.x == 0 && threadIdx.x == 0) { const unsigned long long dc = clock64() - pc0, dw = wall_clock64() - pw0;
            ((unsigned long long*)(ws + WS_CTL))[300] = dc; ((unsigned long long*)(ws + WS_CTL))[301] = dw; }
#endif
#ifdef PROBE_REP_GEMM
            pg8::gemm_phase<pg8::EpiFfn1, pg8::StaticOrder, true, true>(lds, g, S, E);
#endif
#ifdef PROBE_G4_L2RES
        { pg8::ProbeOrder00 S0; S0.init(MROWS, 2 * FFH, G, (int)blockIdx.x); pg8::Gemm gp{XB, g.Bt, MROWS, 2 * FFH, PROBE_G4_L2RES}; pg8::EpiFfn1 Ep{(bf16*)(ws + WS_OG), FFH, E.ss, E.jobs, 3, 0, 1.0f, nullptr, nullptr};
          pg8::gemm_phase<pg8::EpiFfn1, pg8::ProbeOrder00, true, true>(lds, gp, S0, Ep); }
#endif
    }
#endif
    GRID_BAR();
#ifndef DIS_G5
    {
        constexpr bool I8O = I8_FFN2(LAYER);
        if constexpr (I8O) { int t_ = threadIdx.x; asm volatile("" : "+v"(t_)); quant_rows<11>(HB, nullptr, ws + WS_OG, (float*)(ws + WS_ASC2), (int)blockIdx.x * NWAVES + (t_ >> 6), G * NWAVES, t_ & 63); GRID_BAR(); }
        constexpr bool F8L = !I8O && LAYER >= F8_FIRST_LAYER;
        pg8::Gemm g{I8O ? (const bf16*)(ws + WS_OG) : HB, (const bf16*)(ws + WS_WF_OUT) + (size_t)LAYER * DM * FFH, MROWS, DM, (F8L || I8O) ? FFH / 2 : FFH}; pg8::StaticOrder S; S.init(MROWS, DM, G, (int)blockIdx.x);
        if constexpr (I8O) {
            pg8::EpiResI8 E{XB, LAYER == 3 ? out : nullptr, SS + (size_t)(ssi + 2) * MROWS, 1.0f, (LAYER == 1 || LAYER == 2) ? ws + WS_X8 : nullptr, (const float*)(ws + WS_ASC2), (const float*)(ws + WS_WSC2) + LAYER * DM};
            pg8::gemm_phase<pg8::EpiResI8, pg8::StaticOrder, true, true, 2>(lds, g, S, E);
        } else {
            pg8::EpiRes E{XB, LAYER == 3 ? out : nullptr, SS + (size_t)(ssi + 2) * MROWS, F8L ? 1.0f / (pg8::F8_HSCALE * pg8::F8_WSCALE) : 1.0f, (LAYER == 1 || LAYER == 2) ? ws + WS_X8 : nullptr};
            pg8::gemm_phase<pg8::EpiRes, pg8::StaticOrder, true, true, F8L ? 1 : 0>(lds, g, S, E);
        }
    }
#endif
    if constexpr (LAYER < 3) GRID_BAR();
}

__global__ void __launch_bounds__(NWAVES * 64, 2) yoco_fwd(Args args) {
    extern __shared__ __attribute__((aligned(16))) unsigned char lds_raw[];
    LAS unsigned char* lds = (LAS unsigned char*)lds_raw;
    const int tid = threadIdx.x;
    volatile LAS unsigned* MISC = (volatile LAS unsigned*)(lds + MISC_OFF);
    if (tid < 64) MISC[tid] = 0u;
    __syncthreads();
    XcdBarrier bar = xcd_barrier_post((unsigned*)(args.ws + WS_CTL) + CW_BAR, MISC + 8);
    if constexpr (I8_FFN1_LAYER < 4) { wmax_pass(args, (int)blockIdx.x * NWAVES + (tid >> 6), (int)gridDim.x * NWAVES, tid & 63); GRID_BAR(); }
#ifndef DIS_PRO
    { const int lane = tid & 63, wave = __builtin_amdgcn_readfirstlane(tid >> 6), G = gridDim.x;
      const int vcu = (G % 8 == 0) ? ((int)blockIdx.x % 8) * (G / 8) + (int)blockIdx.x / 8 : (int)blockIdx.x;
      prologue(args, lds, vcu * NWAVES + wave, G * NWAVES, lane, wave);
#ifdef PROBE_REP_PRO
      prologue(args, lds, vcu * NWAVES + wave, G * NWAVES, lane, wave);
#endif
    }
#endif
    GRID_BAR();
#ifndef ONLY_LAYER
    layer_phases<0>(args, lds, lds_raw, bar);
    layer_phases<1>(args, lds, lds_raw, bar);
    layer_phases<2>(args, lds, lds_raw, bar);
    layer_phases<3>(args, lds, lds_raw, bar);
#else
    layer_phases<ONLY_LAYER>(args, lds, lds_raw, bar);
#endif
#ifdef PROBE_CLOCK
    if (blockIdx.x == 0 && threadIdx.x == 0) {
        const unsigned long long dc = ((volatile unsigned long long*)(args.ws + WS_CTL))[300], dw = ((volatile unsigned long long*)(args.ws + WS_CTL))[301];
        const unsigned long long ticks = dw ? (dc * 10000ull) / dw : 0ull, t0 = wall_clock64();
        while (wall_clock64() - t0 < ticks) __builtin_amdgcn_s_sleep(8);
    }
#endif
}

extern "C" void kernel_launch(void* const* d_in, const int* in_sizes, int n_in, void* d_out, int out_size, void* d_ws, size_t ws_size, hipStream_t stream) {
    static int grid = 0;
    if (grid == 0) {
        if (n_in != 16 || out_size != MROWS * DM || ws_size < WS_END) { fprintf(stderr, "kernel_launch: unexpected shapes (n_in %d out %d ws %zu)\n", n_in, out_size, ws_size); grid = -1; return; }
        int dev = 0, cus = 0, per_cu = 0;
        if (hipGetDevice(&dev) != hipSuccess || hipDeviceGetAttribute(&cus, hipDeviceAttributeMultiprocessorCount, dev) != hipSuccess) { grid = -1; return; }
        if (hipFuncSetAttribute((const void*)yoco_fwd, hipFuncAttributeMaxDynamicSharedMemorySize, LDS_BYTES) != hipSuccess) { fprintf(stderr, "kernel_launch: hipFuncSetAttribute failed\n"); grid = -1; return; }
        if (hipOccupancyMaxActiveBlocksPerMultiprocessor(&per_cu, (const void*)yoco_fwd, NWAVES * 64, LDS_BYTES) != hipSuccess || per_cu < 1) { fprintf(stderr, "kernel_launch: occupancy query says %d\n", per_cu); }
        (void)hipGetLastError();
        grid = cus;
    }
    if (grid < 0) return;
    (void)hipMemsetAsync((char*)d_ws + WS_CTL, 0, CTL_ZERO_BYTES, stream);
    Args a{};
    for (int i = 0; i < 16; ++i) a.in[i] = (const float*)d_in[i];
    a.out = (float*)d_out; a.ws = (unsigned char*)d_ws;
    hipLaunchKernelGGL(yoco_fwd, dim3(grid), dim3(NWAVES * 64), LDS_BYTES, stream, a);
}
```

```cpp
#define CONV_ALL_IN_PROLOGUE 1
#include <hip/hip_runtime.h>
#include <cstdio>
#include <cstdint>
namespace pg8 {
#define PG8_LAS __attribute__((address_space(3)))
typedef unsigned short bf16_t;
typedef short bf16x8 __attribute__((ext_vector_type(8)));
typedef float f32x4 __attribute__((ext_vector_type(4)));
typedef unsigned u32x4 __attribute__((ext_vector_type(4)));
typedef int i32x4 __attribute__((ext_vector_type(4)));
typedef int i32x8 __attribute__((ext_vector_type(8)));
constexpr int BM = 256, BK = 64, HALF = 128, HTB = HALF * BK * 2  , STAGE_BYTES = 8 * HTB, NXCD = 8, WGM = 8;

__host__ __device__ __forceinline__ int lds_byte(int r, int c) { const int st = (r >> 4) * 2 + (c >> 5), rr = r & 15, cc = c & 31, ob = rr * 64 + cc * 2; return st * 1024 + (ob ^ (((ob >> 9) & 1) << 5)); }
__host__ __device__ __forceinline__ void stage_rc(int b, int& R, int& C) { const int st = b / 1024, sb = b % 1024, swz = sb ^ (((sb >> 9) & 1) << 5); R = (st >> 1) * 16 + swz / 64; C = (st & 1) * 32 + (swz % 64) / 2; }
__host__ __device__ __forceinline__ int perm32(int rho) { const int n = rho >> 4, i = rho & 15; return 8 * (i >> 2) + 4 * n + (i & 3); }

struct Unit { int pm, pn; };
struct Gemm { const bf16_t* A; const bf16_t* Bt; int M, N, K; };

struct StaticOrder {
    int nM, nN, nwg, G, c;
    __host__ __device__ void init(int M, int N, int G_, int c_) { nM = M / BM; nN = N / BM; nwg = nM * nN; G = G_; c = c_; }
    __host__ __device__ bool next(int i, Unit& u) const {
        const long L = (long)i * G + c; if (L >= nwg) return false;
        int wgid = (int)L; { const int q = nwg / NXCD, r = nwg % NXCD, xcd = wgid % NXCD, off = wgid / NXCD; wgid = (xcd < r ? xcd * (q + 1) : r * (q + 1) + (xcd - r) * q) + off; }
        const int nig = WGM * nN, gid = wgid / nig, fm = gid * WGM, gsz = (nM - fm) < WGM ? (nM - fm) : WGM;
        u.pm = fm + ((wgid % nig) % gsz); u.pn = (wgid % nig) / gsz; return true;
    }
    __device__ __forceinline__ void a_ready(const Unit&) const {}
    __device__ __forceinline__ void done(const Unit&) const {}
};
struct ProbeOrder00 : StaticOrder {
    __host__ __device__ bool next(int i, Unit& u) const { const long L = (long)i * G + c; if (L >= nwg) return false; u.pm = 0; u.pn = 0; return true; }
};
__device__ __forceinline__ i32x8 cat8(const bf16x8 a, const bf16x8 b) { const i32x4 x = __builtin_bit_cast(i32x4, a), y = __builtin_bit_cast(i32x4, b); return __builtin_shufflevector(x, y, 0, 1, 2, 3, 4, 5, 6, 7); }
constexpr float F8_HSCALE = 8.0f, F8_XSCALE = 16.0f, F8_WSCALE = 512.0f, F8_MAX = 448.0f;
__device__ __forceinline__ unsigned cvt4_fp8(float a, float b, float c, float d, float s) {
    int w = 0;
    w = __builtin_amdgcn_cvt_pk_fp8_f32(__builtin_amdgcn_fmed3f(a * s, -F8_MAX, F8_MAX), __builtin_amdgcn_fmed3f(b * s, -F8_MAX, F8_MAX), w, false);
    w = __builtin_amdgcn_cvt_pk_fp8_f32(__builtin_amdgcn_fmed3f(c * s, -F8_MAX, F8_MAX), __builtin_amdgcn_fmed3f(d * s, -F8_MAX, F8_MAX), w, true);
    return (unsigned)w; }
__device__ __forceinline__ unsigned cvt_pk_bf16(float lo, float hi) { unsigned r; asm volatile("v_cvt_pk_bf16_f32 %0, %1, %2" : "=v"(r) : "v"(lo), "v"(hi)); return r; }
template <class Epi, class Sched, bool ALIGN_EPI = false, bool SP2 = false, int QM = 0>
__device__ __forceinline__ void gemm_phase(PG8_LAS unsigned char* lds, const Gemm g, const Sched& S, const Epi& E) {
    int tid_ = threadIdx.x; asm volatile("" : "+v"(tid_));
    const int tid = tid_, wid = __builtin_amdgcn_readfirstlane(tid >> 6), lane = tid & 63, wr = wid >> 2, wc = wid & 3, fr = lane & 15, fq = lane >> 4;
    const int K = g.K, nt = K / BK;
    unsigned voffA[2], voffB[2];
#pragma unroll
    for (int i = 0; i < 2; ++i) { int R, C; stage_rc(tid * 16 + i * 8192, R, C); const int Rb = Epi::PERM ? ((R & ~31) + perm32(R & 31)) : R;
        voffA[i] = (unsigned)(R * K + C) * 2u; voffB[i] = (unsigned)(Rb * K + C) * 2u; }
    const size_t kstep = (size_t)(BK * 2);
    const size_t hstep = (size_t)HALF * K * 2;
    const size_t tstep = 2 * hstep;
    const unsigned ldsw = (unsigned)wid * 1024u;
    const int aoff = lds_byte(wr * 64 + fr, fq * 8), boff = lds_byte(wc * 32 + fr, fq * 8);
#define PG8_SA(b, h) (((b) * 2 + (h)) * HTB)
#define PG8_SB(b, h) ((4 + (b) * 2 + (h)) * HTB)
#define PG8_STAGE(bufoff, gbase, voff) do { _Pragma("unroll") for (int _i = 0; _i < 2; ++_i) \
        __builtin_amdgcn_global_load_lds((const unsigned*)((const char*)(gbase) + (voff)[_i]), (PG8_LAS unsigned*)(lds + (bufoff) + ldsw + _i * 8192), 16, 0, 0); } while (0)
#define PG8_LDA(dst, b, h) do { _Pragma("unroll") for (int m = 0; m < 4; ++m) _Pragma("unroll") for (int k = 0; k < 2; ++k) dst[m][k] = *(const PG8_LAS bf16x8*)(lds + PG8_SA(b, h) + aoff + m * 2048 + k * 1024); } while (0)
#define PG8_LDB(dst, b, h) do { _Pragma("unroll") for (int n = 0; n < 2; ++n) _Pragma("unroll") for (int k = 0; k < 2; ++k) dst[n][k] = *(const PG8_LAS bf16x8*)(lds + PG8_SB(b, h) + boff + n * 2048 + k * 1024); } while (0)
#define PG8_MMA(ai, bj, At, Bt) do { __builtin_amdgcn_s_setprio(1); _Pragma("unroll") for (int m = 0; m < 4; ++m) _Pragma("unroll") for (int n = 0; n < 2; ++n) { \
        if constexpr (QM == 1) { const i32x8 b8_ = cat8(Bt[n][0], Bt[n][1]), a8_ = cat8(At[m][0], At[m][1]); asm volatile("v_mfma_f32_16x16x128_f8f6f4 %0, %1, %2, %0" : "+v"(acc[ai][bj][m][n]) : "v"(b8_), "v"(a8_)); } \
        else if constexpr (QM == 2) { _Pragma("unroll") for (int k = 0; k < 2; ++k) acc[ai][bj][m][n] = __builtin_bit_cast(f32x4, __builtin_amdgcn_mfma_i32_16x16x64_i8(__builtin_bit_cast(i32x4, Bt[n][k]), __builtin_bit_cast(i32x4, At[m][k]), __builtin_bit_cast(i32x4, acc[ai][bj][m][n]), 0, 0, 0)); } \
        else { _Pragma("unroll") for (int k = 0; k < 2; ++k) acc[ai][bj][m][n] = __builtin_amdgcn_mfma_f32_16x16x32_bf16(Bt[n][k], At[m][k], acc[ai][bj][m][n], 0, 0, 0); } } __builtin_amdgcn_s_setprio(0); } while (0)
#define PG8_WAIT_V(n) asm volatile("s_waitcnt vmcnt(" #n ")" ::: "memory")
#define PG8_WAIT_L(n) asm volatile("s_waitcnt lgkmcnt(" #n ")" ::: "memory")
#define PG8_BAR __builtin_amdgcn_s_barrier()
#define PG8_SCHED __builtin_amdgcn_sched_barrier(0)
    Unit cur, nxt; int ui = 0;
    if (!S.next(0, cur)) return;
    f32x4 acc[2][2][4][2];
    unsigned pre[8];
#pragma unroll
    for (int a = 0; a < 2; ++a)
#pragma unroll
        for (int b = 0; b < 2; ++b)
#pragma unroll
            for (int m = 0; m < 4; ++m)
#pragma unroll
                for (int n = 0; n < 2; ++n) acc[a][b][m][n] = (f32x4){0.f, 0.f, 0.f, 0.f};
    bf16x8 At[4][2], B0[2][2], B1[2][2];
    const char* cA = (const char*)g.A + (size_t)cur.pm * tstep; const char* cB = (const char*)g.Bt + (size_t)cur.pn * tstep;
    S.a_ready(cur);
    if constexpr (SP2) {
        PG8_STAGE(PG8_SB(0, 0), cB, voffB); PG8_STAGE(PG8_SB(0, 1), cB + hstep, voffB); PG8_STAGE(PG8_SA(0, 0), cA, voffA); PG8_STAGE(PG8_SA(0, 1), cA + hstep, voffA);
        if (wr == 1) PG8_BAR;
        PG8_WAIT_V(2); PG8_BAR;
        PG8_STAGE(PG8_SB(1, 0), cB + kstep, voffB); PG8_STAGE(PG8_SA(1, 0), cA + kstep, voffA); PG8_STAGE(PG8_SB(1, 1), cB + hstep + kstep, voffB);
        PG8_WAIT_V(6); PG8_BAR;
    } else {
        PG8_STAGE(PG8_SB(0, 0), cB, voffB); PG8_STAGE(PG8_SA(0, 0), cA, voffA); PG8_STAGE(PG8_SB(0, 1), cB + hstep, voffB); PG8_STAGE(PG8_SA(0, 1), cA + hstep, voffA);
        if (wr == 1) PG8_BAR;
        PG8_WAIT_V(4); PG8_BAR;
        PG8_STAGE(PG8_SB(1, 0), cB + kstep, voffB); PG8_STAGE(PG8_SA(1, 0), cA + kstep, voffA); PG8_STAGE(PG8_SB(1, 1), cB + hstep + kstep, voffB);
        PG8_WAIT_V(6); PG8_BAR;
    }
    for (;;) {
        const bool has_next = S.next(ui + 1, nxt);
        const char* nA = has_next ? (const char*)g.A + (size_t)nxt.pm * tstep : cA; const char* nB = has_next ? (const char*)g.Bt + (size_t)nxt.pn * tstep : cB;
        for (int t = 0; t < nt; t += 2) {
            const bool last = (t == nt - 2);
            const char* a1 = cA + (size_t)(t + 1) * kstep;
            const char* a2 = last ? nA : cA + (size_t)(t + 2) * kstep; const char* b2 = last ? nB : cB + (size_t)(t + 2) * kstep;
            const char* a3 = a2 + kstep; const char* b3 = b2 + kstep;
            if (last && has_next) S.a_ready(nxt);
            if (last) E.prefetch(cur, wr, fr, pre);
            if constexpr (SP2) {
            PG8_LDB(B0, 0, 0); PG8_LDB(B1, 0, 1); PG8_SCHED; PG8_LDA(At, 0, 0); PG8_STAGE(PG8_SA(1, 1), a1 + hstep, voffA);
            PG8_WAIT_V(8); PG8_WAIT_L(0); PG8_BAR; PG8_MMA(0, 0, At, B0); PG8_MMA(0, 1, At, B1); PG8_BAR; PG8_SCHED;
            PG8_LDA(At, 0, 1); PG8_STAGE(PG8_SB(0, 0), b2, voffB); PG8_STAGE(PG8_SB(0, 1), b2 + hstep, voffB); PG8_STAGE(PG8_SA(0, 0), a2, voffA);
            PG8_WAIT_V(8); PG8_WAIT_L(0); PG8_BAR; PG8_MMA(1, 0, At, B0); PG8_MMA(1, 1, At, B1); PG8_BAR; PG8_SCHED;
            PG8_LDB(B0, 1, 0); PG8_LDB(B1, 1, 1); PG8_SCHED; PG8_LDA(At, 1, 0); PG8_STAGE(PG8_SA(0, 1), a2 + hstep, voffA);
            PG8_WAIT_V(8); PG8_WAIT_L(0); PG8_BAR; PG8_MMA(0, 0, At, B0); PG8_MMA(0, 1, At, B1); PG8_BAR; PG8_SCHED;
            PG8_LDA(At, 1, 1); PG8_STAGE(PG8_SB(1, 0), b3, voffB); PG8_STAGE(PG8_SB(1, 1), b3 + hstep, voffB); PG8_STAGE(PG8_SA(1, 0), a3, voffA);
            PG8_WAIT_V(8); PG8_WAIT_L(0); PG8_BAR; PG8_MMA(1, 0, At, B0); PG8_MMA(1, 1, At, B1); PG8_BAR; PG8_SCHED;
            } else {
            PG8_LDB(B0, 0, 0); PG8_SCHED; PG8_LDA(At, 0, 0); PG8_STAGE(PG8_SA(1, 1), a1 + hstep, voffA);
            PG8_WAIT_L(8); PG8_BAR; PG8_WAIT_L(0); PG8_MMA(0, 0, At, B0); PG8_BAR; PG8_SCHED;
            PG8_LDB(B1, 0, 1); PG8_STAGE(PG8_SB(0, 0), b2, voffB);
            PG8_BAR; PG8_WAIT_L(0); PG8_MMA(0, 1, At, B1); PG8_BAR;
            PG8_LDA(At, 0, 1); PG8_STAGE(PG8_SA(0, 0), a2, voffA);
            PG8_BAR; PG8_WAIT_L(0); PG8_MMA(1, 0, At, B0); PG8_BAR; PG8_SCHED;
            PG8_STAGE(PG8_SB(0, 1), b2 + hstep, voffB);
            PG8_WAIT_V(6); PG8_BAR; PG8_MMA(1, 1, At, B1); PG8_BAR;
            PG8_LDB(B0, 1, 0); PG8_SCHED; PG8_LDA(At, 1, 0); PG8_STAGE(PG8_SA(0, 1), a2 + hstep, voffA);
            PG8_WAIT_L(8); PG8_BAR; PG8_WAIT_L(0); PG8_MMA(0, 0, At, B0); PG8_BAR; PG8_SCHED;
            PG8_LDB(B1, 1, 1); PG8_STAGE(PG8_SB(1, 0), b3, voffB);
            PG8_BAR; PG8_WAIT_L(0); PG8_MMA(0, 1, At, B1); PG8_BAR;
            PG8_LDA(At, 1, 1); PG8_STAGE(PG8_SA(1, 0), a3, voffA);
            PG8_BAR; PG8_WAIT_L(0); PG8_MMA(1, 0, At, B0); PG8_BAR; PG8_SCHED;
            PG8_STAGE(PG8_SB(1, 1), b3 + hstep, voffB);
            PG8_WAIT_V(6); PG8_BAR; PG8_MMA(1, 1, At, B1); PG8_BAR;
            }
        }
        if constexpr (QM == 1) asm volatile("s_nop 15\n\ts_nop 15\n\ts_nop 7" ::: "memory");
        if constexpr (ALIGN_EPI) { if (wr == 0) PG8_BAR; }
        E(acc, cur, wr, wc, fr, fq, lds, pre, ui);
        if (!has_next) break;
#pragma unroll
        for (int a = 0; a < 2; ++a)
#pragma unroll
            for (int b = 0; b < 2; ++b)
#pragma unroll
                for (int m = 0; m < 4; ++m)
#pragma unroll
                    for (int n = 0; n < 2; ++n) acc[a][b][m][n] = (f32x4){0.f, 0.f, 0.f, 0.f};
        cur = nxt; cA = nA; cB = nB; ++ui;
        if constexpr (ALIGN_EPI) { if (wr == 1) PG8_BAR; }
    }
    PG8_WAIT_V(0);
    if constexpr (!ALIGN_EPI) { if (wr == 0) PG8_BAR; }
    PG8_BAR;
#undef PG8_SA
#undef PG8_SB
#undef PG8_STAGE
#undef PG8_LDA
#undef PG8_LDB
#undef PG8_MMA
#undef PG8_WAIT_V
#undef PG8_WAIT_L
#undef PG8_BAR
#undef PG8_SCHED
}
}
namespace pg8 {
constexpr int DMODEL = 2048;
constexpr float RMS_EPS = 1e-6f;
__device__ __forceinline__ float fast_exp(float x) { return __builtin_amdgcn_exp2f(x * 1.4426950408889634f); }
__device__ __forceinline__ float fast_log(float x) { return __builtin_amdgcn_logf(x) * 0.6931471805599453f; }
__device__ __forceinline__ float fast_rcp(float x) { return __builtin_amdgcn_rcpf(x); }
__device__ __forceinline__ float silu_f(float v) { return v * fast_rcp(1.0f + fast_exp(-v)); }
__device__ __forceinline__ u32x4 pack8_bf16(const f32x4 a, const f32x4 b) { u32x4 w; w.x = cvt_pk_bf16(a[0], a[1]); w.y = cvt_pk_bf16(a[2], a[3]); w.z = cvt_pk_bf16(b[0], b[1]); w.w = cvt_pk_bf16(b[2], b[3]); return w; }
typedef unsigned ssq_t;
constexpr float SS_SCALE = 1024.0f;
__device__ __forceinline__ float ss_to_rs(ssq_t v) { return __builtin_amdgcn_rsqf((float)v * (1.0f / (SS_SCALE * DMODEL)) + RMS_EPS); }
__device__ __forceinline__ void ss_prefetch(unsigned (&pre)[8], const ssq_t* ss, int row0) {
#pragma unroll
    for (int i = 0; i < 8; ++i) pre[i] = ss[row0 + (i >> 2) * HALF + (i & 3) * 16];
}
__device__ __forceinline__ void row_scales(float (&rs)[2][4], const unsigned (&pre)[8]) {
#pragma unroll
    for (int ai = 0; ai < 2; ++ai)
#pragma unroll
        for (int m = 0; m < 4; ++m) rs[ai][m] = ss_to_rs(pre[ai * 4 + m]);
}

typedef _Float16 f16x2_t __attribute__((ext_vector_type(2)));
typedef float f32x2e __attribute__((ext_vector_type(2)));
__device__ __forceinline__ unsigned pk_f16(float lo, float hi) { const f32x2e v = {lo, hi}; const f16x2_t h = __builtin_convertvector(v, f16x2_t); return __builtin_bit_cast(unsigned, h); }
__device__ __forceinline__ void fz_one(float z, float l, float& k, float& logf) {
    const float e = fast_exp(-__builtin_fabsf(z)), inv = fast_rcp(1.0f + e), sm = e * inv;
    const float sig = z >= 0.f ? inv : sm, nsig = z >= 0.f ? sm : inv;
    k = (1.0f - l) * nsig; logf = fast_log(l + (1.0f - l) * sig);
}

struct EpiHgrnIn {
    static constexpr bool PERM = true, AFTER_DRAIN = false;
    __device__ __forceinline__ void prefetch(const Unit& u, int wr, int fr, unsigned (&pre)[8]) const { ss_prefetch(pre, ss, u.pm * BM + wr * 64 + fr); }
    bf16_t* QKVG; float* LOGF; const ssq_t* ss; const float* lb;
    static constexpr size_t TSTRIDE = (size_t)16384 * DMODEL;
    __device__ __forceinline__ void operator()(const f32x4 (&acc)[2][2][4][2], const Unit& u, int wr, int wc, int fr, int fq, PG8_LAS unsigned char*, const unsigned (&pre)[8], int ui) const {
        const int row0 = u.pm * BM + wr * 64 + fr, type = u.pn >> 3, col0 = (u.pn & 7) * BM + wc * 32 + 8 * fq, hd0 = (u.pn & 7) * 2, dcol = wc * 32 + 8 * fq;
        float rsv[2][4]; row_scales(rsv, pre);
        if (type == 1) {
#pragma unroll
            for (int bj = 0; bj < 2; ++bj) { const f32x4 lb0 = *(const f32x4*)(lb + col0 + bj * HALF), lb1 = *(const f32x4*)(lb + col0 + bj * HALF + 4);
#pragma unroll
                for (int ai = 0; ai < 2; ++ai)
#pragma unroll
                    for (int m = 0; m < 4; ++m) { const int row = row0 + ai * HALF + m * 16; const size_t off = ((size_t)((row >> 12) * 16 + hd0 + bj) * 4096 + (row & 4095)) * 128 + dcol;
                        const float rs = rsv[ai][m]; f32x4 lf0, lf1, kk0, kk1;
#pragma unroll
                        for (int j = 0; j < 4; ++j) { float ka, la, kb, lb_; fz_one(acc[ai][bj][m][0][j] * rs, lb0[j], ka, la); fz_one(acc[ai][bj][m][1][j] * rs, lb1[j], kb, lb_); lf0[j] = la; lf1[j] = lb_; kk0[j] = ka; kk1[j] = kb; }
#ifdef HG_STORE_K
                        *(u32x4*)(QKVG + TSTRIDE + off) = pack8_bf16(kk0, kk1);
#endif
                        *(f32x4*)(LOGF + off) = lf0; *(f32x4*)(LOGF + off + 4) = lf1;
                        asm volatile("" ::: "memory"); } }
        } else {
            bf16_t* dst = QKVG + (size_t)(type == 0 ? 0 : type) * TSTRIDE;
#pragma unroll
            for (int ai = 0; ai < 2; ++ai)
#pragma unroll
                for (int m = 0; m < 4; ++m) { const int row = row0 + ai * HALF + m * 16; const size_t off = ((size_t)((row >> 12) * 16 + hd0) * 4096 + (row & 4095)) * 128 + dcol;
                    const float rs = rsv[ai][m];
#pragma unroll
                    for (int bj = 0; bj < 2; ++bj) { f32x4 v0 = acc[ai][bj][m][0] * rs, v1 = acc[ai][bj][m][1] * rs;
                        if (type == 3) {
#pragma unroll
                            for (int j = 0; j < 4; ++j) { v0[j] = silu_f(v0[j]); v1[j] = silu_f(v1[j]); } }
                        *(u32x4*)(dst + off + (size_t)bj * (4096 * 128)) = pack8_bf16(v0, v1); }
                    asm volatile("" ::: "memory"); }
        }
    }
};

struct EpiRes {
    static constexpr bool PERM = true, AFTER_DRAIN = false;
    bf16_t* xb; float* out; ssq_t* ssn; float ascale; unsigned char* x8;
    __device__ __forceinline__ void prefetch(const Unit&, int, int, unsigned (&)[8]) const {}
    __device__ __forceinline__ void operator()(const f32x4 (&acc)[2][2][4][2], const Unit& u, int wr, int wc, int fr, int fq, PG8_LAS unsigned char*, const unsigned (&pre)[8], int ui) const {
        const int row0 = u.pm * BM + wr * 64 + fr, col0 = u.pn * BM + wc * 32 + 8 * fq;
#pragma unroll
        for (int ai = 0; ai < 2; ++ai) {
            u32x4 rv[4][2];
#pragma unroll
            for (int m = 0; m < 4; ++m) { const size_t off = (size_t)(row0 + ai * HALF + m * 16) * DMODEL + col0;
#pragma unroll
                for (int bj = 0; bj < 2; ++bj) rv[m][bj] = *(const u32x4*)(xb + off + bj * HALF); }
            asm volatile("" ::: "memory");
#pragma unroll
            for (int m = 0; m < 4; ++m) { const int row = row0 + ai * HALF + m * 16; const size_t off = (size_t)row * DMODEL + col0; float s = 0.f;
#pragma unroll
                for (int bj = 0; bj < 2; ++bj) { const u32x4 r = rv[m][bj];
                    const f32x4 r0 = {__uint_as_float(r.x << 16), __uint_as_float(r.x & 0xffff0000u), __uint_as_float(r.y << 16), __uint_as_float(r.y & 0xffff0000u)};
                    const f32x4 r1 = {__uint_as_float(r.z << 16), __uint_as_float(r.z & 0xffff0000u), __uint_as_float(r.w << 16), __uint_as_float(r.w & 0xffff0000u)};
                    const f32x4 x0 = acc[ai][bj][m][0] * ascale + r0, x1 = acc[ai][bj][m][1] * ascale + r1;
                    if (out) { *(f32x4*)(out + off + bj * HALF) = x0; *(f32x4*)(out + off + bj * HALF + 4) = x1; }
                    else { *(u32x4*)(xb + off + bj * HALF) = pack8_bf16(x0, x1);
                        if (x8) { typedef unsigned u32x2_ __attribute__((ext_vector_type(2))); *(u32x2_*)(x8 + off + bj * HALF) = (u32x2_){cvt4_fp8(x0[0], x0[1], x0[2], x0[3], F8_XSCALE), cvt4_fp8(x1[0], x1[1], x1[2], x1[3], F8_XSCALE)}; }
                        s += (x0[0] * x0[0] + x0[1] * x0[1]) + (x0[2] * x0[2] + x0[3] * x0[3]) + (x1[0] * x1[0] + x1[1] * x1[1]) + (x1[2] * x1[2] + x1[3] * x1[3]); } }
                if (!out) { s += __shfl_xor(s, 16); s += __shfl_xor(s, 32);
                    if (fq == 0) atomicAdd(ssn + row, (ssq_t)(s * SS_SCALE + 0.5f)); } }
            asm volatile("" ::: "memory");
        }
    }
};

struct EpiResI8 {
    static constexpr bool PERM = true, AFTER_DRAIN = false;
    bf16_t* xb; float* out; ssq_t* ssn; float ascale; unsigned char* x8; const float* asc; const float* wsc;
    __device__ __forceinline__ void prefetch(const Unit& u, int wr, int fr, unsigned (&pre)[8]) const {
        if (asc) { const int row0 = u.pm * BM + wr * 64 + fr;
#pragma unroll
            for (int i = 0; i < 8; ++i) pre[i] = __builtin_bit_cast(unsigned, asc[row0 + (i >> 2) * HALF + (i & 3) * 16]); } }
    __device__ __forceinline__ void operator()(const f32x4 (&acc)[2][2][4][2], const Unit& u, int wr, int wc, int fr, int fq, PG8_LAS unsigned char*, const unsigned (&pre)[8], int ui) const {
        const int row0 = u.pm * BM + wr * 64 + fr, col0 = u.pn * BM + wc * 32 + 8 * fq;
#pragma unroll
        for (int ai = 0; ai < 2; ++ai) {
            f32x4 cs[2][2] = {{{0.f, 0.f, 0.f, 0.f}, {0.f, 0.f, 0.f, 0.f}}, {{0.f, 0.f, 0.f, 0.f}, {0.f, 0.f, 0.f, 0.f}}};
            if (asc) {
#pragma unroll
                for (int bj = 0; bj < 2; ++bj) { cs[bj][0] = *(const f32x4*)(wsc + col0 + bj * HALF); cs[bj][1] = *(const f32x4*)(wsc + col0 + bj * HALF + 4); } }
            u32x4 rv[4][2];
#pragma unroll
            for (int m = 0; m < 4; ++m) { const size_t off = (size_t)(row0 + ai * HALF + m * 16) * DMODEL + col0;
#pragma unroll
                for (int bj = 0; bj < 2; ++bj) rv[m][bj] = *(const u32x4*)(xb + off + bj * HALF); }
            asm volatile("" ::: "memory");
#pragma unroll
            for (int m = 0; m < 4; ++m) { const int row = row0 + ai * HALF + m * 16; const size_t off = (size_t)row * DMODEL + col0; float s = 0.f;
#pragma unroll
                for (int bj = 0; bj < 2; ++bj) { const u32x4 r = rv[m][bj];
                    const f32x4 r0 = {__uint_as_float(r.x << 16), __uint_as_float(r.x & 0xffff0000u), __uint_as_float(r.y << 16), __uint_as_float(r.y & 0xffff0000u)};
                    const f32x4 r1 = {__uint_as_float(r.z << 16), __uint_as_float(r.z & 0xffff0000u), __uint_as_float(r.w << 16), __uint_as_float(r.w & 0xffff0000u)};
                    f32x4 a0 = acc[ai][bj][m][0], a1 = acc[ai][bj][m][1];
                    if (asc) { const float ra = __builtin_bit_cast(float, pre[ai * 4 + m]);
                        a0 = __builtin_convertvector(__builtin_bit_cast(i32x4, a0), f32x4) * (cs[bj][0] * ra); a1 = __builtin_convertvector(__builtin_bit_cast(i32x4, a1), f32x4) * (cs[bj][1] * ra); }
                    else { a0 = a0 * ascale; a1 = a1 * ascale; }
                    const f32x4 x0 = a0 + r0, x1 = a1 + r1;
                    if (out) { *(f32x4*)(out + off + bj * HALF) = x0; *(f32x4*)(out + off + bj * HALF + 4) = x1; }
                    else { *(u32x4*)(xb + off + bj * HALF) = pack8_bf16(x0, x1);
                        if (x8) { typedef unsigned u32x2_ __attribute__((ext_vector_type(2))); *(u32x2_*)(x8 + off + bj * HALF) = (u32x2_){cvt4_fp8(x0[0], x0[1], x0[2], x0[3], F8_XSCALE), cvt4_fp8(x1[0], x1[1], x1[2], x1[3], F8_XSCALE)}; }
                        s += (x0[0] * x0[0] + x0[1] * x0[1]) + (x0[2] * x0[2] + x0[3] * x0[3]) + (x1[0] * x1[0] + x1[1] * x1[1]) + (x1[2] * x1[2] + x1[3] * x1[3]); } }
                if (!out) { s += __shfl_xor(s, 16); s += __shfl_xor(s, 32);
                    if (fq == 0) atomicAdd(ssn + row, (ssq_t)(s * SS_SCALE + 0.5f)); } }
            asm volatile("" ::: "memory");
        }
    }
};

struct ConvJob { const float* W; const float* gain; unsigned short* dst; int K, N, mode, rowoff; };
__device__ __forceinline__ void conv_item_reg(const ConvJob& J, int item, int lane) {
    const int nblk = J.N >> 6, kb = item / nblk, nb = item - kb * nblk, k0 = 64 * kb, n0 = 64 * nb; int nd0 = n0 + J.rowoff;
    if (J.mode == 1) { const int up = n0 >= 5632, jn = up ? n0 - 5632 : n0; nd0 = 256 * (jn >> 7) + 128 * up + (jn & 127); }
    const float* src = J.W + (size_t)k0 * J.N + n0 + lane; float w[64];
#pragma unroll
    for (int kk = 0; kk < 64; ++kk) w[kk] = __builtin_nontemporal_load(src + (size_t)kk * J.N);
    if (J.gain) {
#pragma unroll
        for (int kk = 0; kk < 64; ++kk) w[kk] *= J.gain[k0 + kk]; }
    unsigned short* drow = J.dst + (size_t)(nd0 + lane) * J.K + k0;
#pragma unroll
    for (int j = 0; j < 8; ++j) { u32x4 o; o.x = cvt_pk_bf16(w[8 * j], w[8 * j + 1]); o.y = cvt_pk_bf16(w[8 * j + 2], w[8 * j + 3]); o.z = cvt_pk_bf16(w[8 * j + 4], w[8 * j + 5]); o.w = cvt_pk_bf16(w[8 * j + 6], w[8 * j + 7]);
        *(u32x4*)(drow + 8 * j) = o; }
}
__host__ __device__ constexpr int conv_items(int job) { return job < 2 ? 4096 : job < 4 ? 1024 : job < 8 ? 5632 : job < 12 ? 2816 : job == 12 ? 3072 : job == 13 ? 6144 : job == 14 ? 3072 : 1024; }
__device__ __forceinline__ bool conv_slot(int phase, int s, int& job, int& item) {
    if (phase == 0) { constexpr int j0 = 1, j1 = 3, j2 = 5, j3 = 9; constexpr int c1 = conv_items(j0), c2 = c1 + conv_items(j1), c3 = c2 + conv_items(j2), c4 = c3 + conv_items(j3);
        if (s < c1) { job = j0; item = s; } else if (s < c2) { job = j1; item = s - c1; } else if (s < c3) { job = j2; item = s - c2; } else if (s < c4) { job = j3; item = s - c3; } else return false; return true; }
    if (phase == 1) { constexpr int j0 = 12, j1 = 13, j2 = 15, j3 = 6, j4 = 10; constexpr int c1 = conv_items(j0), c2 = c1 + conv_items(j1), c3 = c2 + conv_items(j2), c4 = c3 + conv_items(j3), c5 = c4 + conv_items(j4);
        if (s < c1) { job = j0; item = s; } else if (s < c2) { job = j1; item = s - c1; } else if (s < c3) { job = j2; item = s - c2; } else if (s < c4) { job = j3; item = s - c3; } else if (s < c5) { job = j4; item = s - c4; } else return false; return true; }
    if (phase == 2) { constexpr int j0 = 14, j1 = 16, j2 = 7, j3 = 11; constexpr int c1 = conv_items(j0), c2 = c1 + conv_items(j1), c3 = c2 + conv_items(j2), c4 = c3 + conv_items(j3);
        if (s < c1) { job = j0; item = s; } else if (s < c2) { job = j1; item = s - c1; } else if (s < c3) { job = j2; item = s - c2; } else if (s < c4) { job = j3; item = s - c3; } else return false; return true; }
    return false;
}

struct EpiFfn1 {
    static constexpr bool PERM = true, AFTER_DRAIN = false;
    bf16_t* H; int ldh; const ssq_t* ss; const ConvJob* jobs; int phase; int f8; float ascale;
    const float* asc; const float* wsc;
    __device__ __forceinline__ void prefetch(const Unit& u, int wr, int fr, unsigned (&pre)[8]) const {
        const int row0 = u.pm * BM + wr * 64 + fr;
        if (asc) {
#pragma unroll
            for (int i = 0; i < 8; ++i) pre[i] = __builtin_bit_cast(unsigned, asc[row0 + (i >> 2) * HALF + (i & 3) * 16]); }
        else ss_prefetch(pre, ss, row0); }
    __device__ __forceinline__ void operator()(const f32x4 (&acc)[2][2][4][2], const Unit& u, int wr, int wc, int fr, int fq, PG8_LAS unsigned char*, const unsigned (&pre)[8], int ui) const {
        const int row0 = u.pm * BM + wr * 64 + fr, col0 = u.pn * HALF + wc * 32 + 8 * fq;
        float rs[2][4]; f32x4 wg[2], wu[2];
        if (asc) {
#pragma unroll
            for (int i = 0; i < 8; ++i) rs[i >> 2][i & 3] = __builtin_bit_cast(float, pre[i]);
            const float* wp = wsc + u.pn * BM + wc * 32 + 8 * fq;
            wg[0] = *(const f32x4*)wp; wg[1] = *(const f32x4*)(wp + 4); wu[0] = *(const f32x4*)(wp + HALF); wu[1] = *(const f32x4*)(wp + HALF + 4); }
        else { row_scales(rs, pre);
#pragma unroll
            for (int i = 0; i < 8; ++i) rs[i >> 2][i & 3] *= ascale;
            wg[0] = wg[1] = wu[0] = wu[1] = (f32x4){1.f, 1.f, 1.f, 1.f}; }
#pragma unroll
        for (int ai = 0; ai < 2; ++ai)
#pragma unroll
            for (int m = 0; m < 4; ++m) { f32x4 h[2];
#pragma unroll
                for (int n = 0; n < 2; ++n)
#pragma unroll
                    for (int j = 0; j < 4; ++j) { float ag = acc[ai][0][m][n][j], au = acc[ai][1][m][n][j];
                        if (asc) { ag = (float)__builtin_bit_cast(int, ag); au = (float)__builtin_bit_cast(int, au); }
                        const float g = ag * (rs[ai][m] * wg[n][j]), up = au * (rs[ai][m] * wu[n][j]); h[n][j] = silu_f(g) * up; }
                if (f8) { typedef unsigned u32x2_ __attribute__((ext_vector_type(2)));
                    *(u32x2_*)((unsigned char*)H + (size_t)(row0 + ai * HALF + m * 16) * ldh + col0) = (u32x2_){cvt4_fp8(h[0][0], h[0][1], h[0][2], h[0][3], F8_HSCALE), cvt4_fp8(h[1][0], h[1][1], h[1][2], h[1][3], F8_HSCALE)}; }
                else *(u32x4*)(H + (size_t)(row0 + ai * HALF + m * 16) * ldh + col0) = pack8_bf16(h[0], h[1]); }
        if (phase < 3) {
            asm volatile("" ::: "memory");
            const int slot = (ui * (int)gridDim.x + (int)blockIdx.x) * 8 + wr * 4 + wc; int job, item;
            if (conv_slot(phase, slot, job, item)) { const ConvJob J = jobs[job]; conv_item_reg(J, item, fq * 16 + fr); }
        }
    }
};

__host__ __device__ __forceinline__ size_t attn_row(int b, int g, int h, int t) { return (size_t)((b * 3 + g) * 16 + h) * 4096 + (size_t)((t & ((1 << (2 * g)) - 1)) << (12 - 2 * g)) + (size_t)(t >> (2 * g)); }
constexpr int QKV_SCR_OFF = 131072;
constexpr int QKV_ROPE_OFF = QKV_SCR_OFF + 8192;
constexpr int QKV_EPS_OFF = QKV_ROPE_OFF + 16384;
typedef _Float16 f16x8_t __attribute__((ext_vector_type(8)));
typedef float f32x8_t __attribute__((ext_vector_type(8)));
struct EpiQkv {
    static constexpr bool PERM = true, AFTER_DRAIN = false;
    __device__ __forceinline__ void prefetch(const Unit&, int, int, unsigned (&)[8]) const {}
    bf16_t *Qo, *Ko, *Vo; const ssq_t* ss; const float* qgain; const float* kgain; const _Float16* rope; float ascale;
    __device__ __forceinline__ void operator()(const f32x4 (&acc)[2][2][4][2], const Unit& u, int wr, int wc, int fr, int fq, PG8_LAS unsigned char* lds, const unsigned (&pre)[8], int ui) const {
        const int kind = u.pn / 24, pt = u.pn - kind * 24, grp = pt >> 3;
        const int row0 = u.pm * BM + wr * 64 + fr, hd0 = (pt & 7) * 2, dcol = wc * 32 + 8 * fq;
        if (kind == 2) {
            unsigned loc[8]; ss_prefetch(loc, ss, row0);
            float rs[2][4]; row_scales(rs, loc);
#pragma unroll
            for (int i = 0; i < 8; ++i) rs[i >> 2][i & 3] *= ascale;
#pragma unroll
            for (int ai = 0; ai < 2; ++ai)
#pragma unroll
                for (int m = 0; m < 4; ++m) { const int row = row0 + ai * HALF + m * 16; const size_t off = attn_row(row >> 12, grp, hd0, row & 4095) * 128 + dcol;
#pragma unroll
                    for (int bj = 0; bj < 2; ++bj) { const f32x4 a_ = acc[ai][bj][m][0] * rs[ai][m], b_ = acc[ai][bj][m][1] * rs[ai][m];
                        typedef unsigned u32x2_ __attribute__((ext_vector_type(2))); *(u32x2_*)((unsigned char*)Vo + off + (size_t)bj * (4096 * 128)) = (u32x2_){cvt4_fp8(a_[0], a_[1], a_[2], a_[3], F8_XSCALE), cvt4_fp8(b_[0], b_[1], b_[2], b_[3], F8_XSCALE)}; } }
            return;
        }
        int lr = wr * 64 + fr; asm volatile("" : "+v"(lr));
        { const char* src = (const char*)(rope + (size_t)((u.pm * BM) & 4095) * 32) + ((wr * 4 + wc) * 64 + fq * 16 + fr) * 16;
#pragma unroll
          for (int i = 0; i < 2; ++i) __builtin_amdgcn_global_load_lds((const unsigned*)(src + i * 8192), (PG8_LAS unsigned*)(lds + QKV_ROPE_OFF + (wr * 4 + wc) * 1024 + i * 8192), 16, 0, 0); }
        unsigned loc[8];
        if (wc == 0) ss_prefetch(loc, ss, row0);
        const float* gain = (kind == 0 ? qgain : kgain) + grp * 128 + wc * 32 + 8 * fq;
        const f32x4 g0 = *(const f32x4*)gain, g1 = *(const f32x4*)(gain + 4);
        PG8_LAS float* scr = (PG8_LAS float*)(lds + QKV_SCR_OFF);
#pragma unroll
        for (int ai = 0; ai < 2; ++ai)
#pragma unroll
            for (int m = 0; m < 4; ++m)
#pragma unroll
                for (int bj = 0; bj < 2; ++bj) { const f32x4 a = acc[ai][bj][m][0], b = acc[ai][bj][m][1];
                    float s = (a[0] * a[0] + a[1] * a[1]) + (a[2] * a[2] + a[3] * a[3]) + (b[0] * b[0] + b[1] * b[1]) + (b[2] * b[2] + b[3] * b[3]);
                    s += __shfl_xor(s, 16); s += __shfl_xor(s, 32);
                    if (fq == 0) scr[((ai * HALF + m * 16 + lr) * 2 + bj) * 4 + wc] = s; }
        PG8_LAS float* epsl = (PG8_LAS float*)(lds + QKV_EPS_OFF);
        if (wc == 0 && fq == 0) {
#pragma unroll
            for (int am = 0; am < 8; ++am) epsl[(am >> 2) * HALF + (am & 3) * 16 + lr] = RMS_EPS * ((float)loc[am] * (1.0f / (SS_SCALE * DMODEL)) + RMS_EPS) * (1.0f / (ascale * ascale)); }
        asm volatile("s_waitcnt vmcnt(0) lgkmcnt(0)" ::: "memory"); __builtin_amdgcn_s_barrier(); asm volatile("" ::: "memory");
        bf16_t* dst = kind == 0 ? Qo : Ko;
#pragma unroll
        for (int am = 0; am < 8; ++am) { const int ai = am >> 2, m = am & 3; const int row = row0 + ai * HALF + m * 16; const size_t off = attn_row(row >> 12, grp, hd0, row & 4095) * 128 + dcol;
            const int lrow = ai * HALF + m * 16 + lr;
            const float epsr = epsl[lrow];
            f32x4 c0 = {1.f, 1.f, 1.f, 1.f}, c1 = c0, s0 = {0.f, 0.f, 0.f, 0.f}, s1 = s0;
            if (wc == 0) { const PG8_LAS f16x8_t* rp = (const PG8_LAS f16x8_t*)(lds + QKV_ROPE_OFF + lrow * 64 + (fq & 1) * 16);
                const f32x8_t cf = __builtin_convertvector(rp[0], f32x8_t), sf = __builtin_convertvector(rp[2], f32x8_t);
                const float sg = fq < 2 ? -1.0f : 1.0f;
#pragma unroll
                for (int j = 0; j < 4; ++j) { c0[j] = cf[j]; c1[j] = cf[4 + j]; s0[j] = sf[j] * sg; s1[j] = sf[4 + j] * sg; } }
#pragma unroll
            for (int bj = 0; bj < 2; ++bj) { const f32x4 p = *(const PG8_LAS f32x4*)(scr + (lrow * 2 + bj) * 4);
                const float sc = __builtin_amdgcn_rsqf(((p[0] + p[1]) + (p[2] + p[3])) * (1.0f / 128.0f) + epsr);
                f32x4 v0 = acc[ai][bj][m][0] * sc * g0, v1 = acc[ai][bj][m][1] * sc * g1;
                if (wc == 0) { f32x4 p0, p1;
#pragma unroll
                    for (int j = 0; j < 4; ++j) { p0[j] = __shfl_xor(v0[j], 32); p1[j] = __shfl_xor(v1[j], 32); }
                    v0 = v0 * c0 + p0 * s0; v1 = v1 * c1 + p1 * s1; }
                { typedef unsigned u32x2_ __attribute__((ext_vector_type(2))); *(u32x2_*)((unsigned char*)dst + off + (size_t)bj * (4096 * 128)) = (u32x2_){cvt4_fp8(v0[0], v0[1], v0[2], v0[3], F8_XSCALE), cvt4_fp8(v1[0], v1[1], v1[2], v1[3], F8_XSCALE)}; } }
            asm volatile("" ::: "memory");
        }
    }
};
}
namespace att {
typedef unsigned short bf16;
typedef short bf16x8 __attribute__((ext_vector_type(8)));
typedef short s16x4 __attribute__((ext_vector_type(4)));
typedef float f32x16 __attribute__((ext_vector_type(16)));
typedef float f32x4 __attribute__((ext_vector_type(4)));
typedef unsigned u32x4 __attribute__((ext_vector_type(4)));
constexpr int D = 128, NW = 8, QBLK = 32, KVBLK = 64, QB = NW * QBLK;
constexpr int SHM_V = KVBLK * D * 2, SHM_K = KVBLK * D * 2;
constexpr int LDS_BYTES = 2 * SHM_V + 2 * SHM_K + NW * 64 * 4;
constexpr float SCALE = 0.08838834764831845f;
constexpr float THR = 8.f;
constexpr int W = 129;
constexpr bool SK = true;

#define KSWZ(row, colB) ((row) * 256 + ((colB) ^ (((row) & 7) << 4)))
#define SBAR() __builtin_amdgcn_sched_barrier(0)
__device__ __forceinline__ int v_st(int k, int c) { const int kk = (k & ~0xC) | ((k & 4) << 1) | ((k & 8) >> 1); return ((kk >> 3) * 4 + (c >> 5)) * 512 + ((kk & 7) * 32 + (c & 31)) * 2; }
__device__ __forceinline__ int v_rd_base(int lane) { return ((lane & 3) << 3) | (((lane >> 2) & 3) << 6) | (((lane >> 4) & 1) << 5) | (((lane >> 5) & 1) << 8); }
constexpr int v_rd_off(int d0, int ks, int half) { return d0 * 512 + ks * 4096 + half * 2048; }
__device__ __forceinline__ int crow(int r, int hi) { return (r & 3) + 8 * (r >> 2) + 4 * hi; }
__device__ __forceinline__ unsigned cvtpk(float lo, float hi) { unsigned r; asm volatile("v_cvt_pk_bf16_f32 %0, %1, %2" : "=v"(r) : "v"(lo), "v"(hi)); return r; }
__device__ __forceinline__ bf16x8 ld8(const bf16* p) { return *reinterpret_cast<const bf16x8*>(p); }
__device__ __forceinline__ bf16x8 ld8g(const char* ubase, unsigned voff) { return *reinterpret_cast<const bf16x8*>(ubase + voff); }
__device__ __forceinline__ void mask_tile(f32x16& p0, f32x16& p1, int dq, unsigned Wu) {
    const float NEG = -__builtin_inff();
#pragma unroll
    for (int r = 0; r < 16; ++r) {
        const int c = (r & 3) + 8 * (r >> 2);
        if ((unsigned)(dq - c) >= Wu) p0[r] = NEG;
        if ((unsigned)(dq - c - 32) >= Wu) p1[r] = NEG;
    }
}
__device__ __forceinline__ void partialSM(f32x16& p0, f32x16& p1, float& m_reg, float& mn, float& alpha) {
    float pmax = p0[0];
#pragma unroll
    for (int r = 1; r < 16; ++r) pmax = fmaxf(pmax, p0[r]);
#pragma unroll
    for (int r = 0; r < 16; ++r) pmax = fmaxf(pmax, p1[r]);
    { auto rr = __builtin_amdgcn_permlane32_swap(__float_as_uint(pmax), __float_as_uint(pmax), false, false);
      pmax = fmaxf(__uint_as_float(rr[0]), __uint_as_float(rr[1])); }
    constexpr float C2 = 1.4426950408889634f * SCALE;
    if (__builtin_expect(__all((pmax - m_reg) * SCALE <= THR), 1)) { mn = m_reg; alpha = 1.f; }
    else { mn = fmaxf(m_reg, pmax); alpha = __builtin_amdgcn_exp2f((m_reg - mn) * C2); m_reg = mn; }
    const float mnL = -mn * C2;
#pragma unroll
    for (int r = 0; r < 16; ++r) p0[r] = fmaf(p0[r], C2, mnL);
#pragma unroll
    for (int r = 0; r < 16; ++r) p1[r] = fmaf(p1[r], C2, mnL);
#pragma unroll
    for (int r = 0; r < 16; ++r) p0[r] = __builtin_amdgcn_exp2f(p0[r]);
}
__device__ __forceinline__ void finishSM(f32x16& p0, f32x16& p1, float alpha, float& l_reg, bf16x8& pa0, bf16x8& pa1, bf16x8& pa2, bf16x8& pa3) {
#pragma unroll
    for (int r = 0; r < 16; ++r) p1[r] = __builtin_amdgcn_exp2f(p1[r]);
    float ps = 0;
#pragma unroll
    for (int r = 0; r < 16; ++r) ps += p0[r];
#pragma unroll
    for (int r = 0; r < 16; ++r) ps += p1[r];
    { auto rr = __builtin_amdgcn_permlane32_swap(__float_as_uint(ps), __float_as_uint(ps), false, false);
      ps = __uint_as_float(rr[0]) + __uint_as_float(rr[1]); }
    l_reg = l_reg * alpha + ps;
#define PK4(P, B_, OUT) do { unsigned a0 = cvtpk(P[B_+0], P[B_+1]), a1 = cvtpk(P[B_+2], P[B_+3]);                          \
        unsigned b0 = cvtpk(P[B_+4], P[B_+5]), b1 = cvtpk(P[B_+6], P[B_+7]);                                             \
        auto r0 = __builtin_amdgcn_permlane32_swap(a0, b0, false, false); auto r1 = __builtin_amdgcn_permlane32_swap(a1, b1, false, false); \
        u32x4 w = {r0[0], r1[0], r0[1], r1[1]}; OUT = *reinterpret_cast<bf16x8*>(&w); } while (0)
    PK4(p0, 0, pa0); PK4(p0, 8, pa1); PK4(p1, 0, pa2); PK4(p1, 8, pa3);
#undef PK4
}
template <int KB>
__device__ __forceinline__ void qkt(f32x16& p0, f32x16& p1, const char* K_lds, int r32, int hi, const bf16x8* qr, bool act) {
    if (SK && !act) { const float NEG = -__builtin_inff();
#pragma unroll
        for (int r = 0; r < 16; ++r) { p0[r] = NEG; p1[r] = NEG; } return; }
    p0 = f32x16{}; p1 = f32x16{};
    const char* kb[4];
#pragma unroll
    for (int dd = 0; dd < 4; ++dd) kb[dd] = K_lds + KB * SHM_K + KSWZ(r32, (dd * 16 + hi * 8) * 2);
#pragma unroll
    for (int d0 = 0; d0 < 8; ++d0) { const char* a = kb[d0 & 3] + (d0 >> 2) * 128;
        bf16x8 b0 = *reinterpret_cast<const bf16x8*>(a);
        bf16x8 b1 = *reinterpret_cast<const bf16x8*>(a + 32 * 256);
        p0 = __builtin_amdgcn_mfma_f32_32x32x16_bf16(b0, qr[d0], p0, 0, 0, 0);
        p1 = __builtin_amdgcn_mfma_f32_32x32x16_bf16(b1, qr[d0], p1, 0, 0, 0); }
}
template <int VB>
__device__ __forceinline__ void pv_tile(f32x16* o, int vb0, bf16x8 pa0, bf16x8 pa1, bf16x8 pa2, bf16x8 pa3, bool act) {
    if (SK && !act) return;
#define TRRD(dst, off) asm volatile("ds_read_b64_tr_b16 %0, %1 offset:%2" : "=&v"(dst) : "v"(vb0), "i"(off) : "memory")
#define PV_D0(d0) do { s16x4 l0, l1, l2, l3, h0, h1, h2, h3; constexpr int b_ = VB * SHM_V + v_rd_off(d0, 0, 0);   \
        TRRD(l0, b_); TRRD(h0, b_ + 2048); TRRD(l1, b_ + 4096); TRRD(h1, b_ + 6144); TRRD(l2, b_ + 8192); TRRD(h2, b_ + 10240); TRRD(l3, b_ + 12288); TRRD(h3, b_ + 14336); \
        asm volatile("s_waitcnt lgkmcnt(0)" ::: "memory"); SBAR();   \
        o[d0] = __builtin_amdgcn_mfma_f32_32x32x16_bf16(pa0, (bf16x8){l0[0], l0[1], l0[2], l0[3], h0[0], h0[1], h0[2], h0[3]}, o[d0], 0, 0, 0);   \
        o[d0] = __builtin_amdgcn_mfma_f32_32x32x16_bf16(pa1, (bf16x8){l1[0], l1[1], l1[2], l1[3], h1[0], h1[1], h1[2], h1[3]}, o[d0], 0, 0, 0);   \
        o[d0] = __builtin_amdgcn_mfma_f32_32x32x16_bf16(pa2, (bf16x8){l2[0], l2[1], l2[2], l2[3], h2[0], h2[1], h2[2], h2[3]}, o[d0], 0, 0, 0);   \
        o[d0] = __builtin_amdgcn_mfma_f32_32x32x16_bf16(pa3, (bf16x8){l3[0], l3[1], l3[2], l3[3], h3[0], h3[1], h3[2], h3[3]}, o[d0], 0, 0, 0); } while (0)
    PV_D0(0); PV_D0(1); PV_D0(2); PV_D0(3);
#undef PV_D0
#undef TRRD
}

struct BlockRef { const bf16* Q; const bf16* K; const bf16* V; bf16* O; float* LSE; int P0; };
struct Seam { bf16x8 qr[8]; bf16x8 st_v0, st_v1, st_k0, st_k1; };
__device__ __forceinline__ int swa_jlo(int P0) { const int lowk = P0 - W + 1; return lowk > 0 ? lowk / KVBLK : 0; }
#define VMW() asm volatile("s_waitcnt vmcnt(0)" ::: "memory")
#define VMWN(n) asm volatile("s_waitcnt vmcnt(%0)" :: "i"(n) : "memory")
#define SLOAD_H(Kp, Vp, k0, pitch) do { const char* kb_ = (const char*)(Kp) + (size_t)(k0) * (size_t)((pitch) * 2); const char* vb_ = (const char*)(Vp) + (size_t)(k0) * (size_t)((pitch) * 2); \
        S.st_v0 = ld8g(vb_, rowoff); S.st_v1 = ld8g(vb_ + 32 * (pitch) * 2, rowoff); S.st_k0 = ld8g(kb_, rowoff); S.st_k1 = ld8g(kb_ + 32 * (pitch) * 2, rowoff); } while (0)
#define SWRITE_HK(bf) do { *(bf16x8*)(K_lds + (bf) * SHM_K + kws) = S.st_k0; *(bf16x8*)(K_lds + (bf) * SHM_K + kws + 32 * 256) = S.st_k1; } while (0)
#define SWRITE_HV(bf) do { *(bf16x8*)(V_lds + (bf) * SHM_V + vst0) = S.st_v0; *(bf16x8*)(V_lds + (bf) * SHM_V + vst1) = S.st_v1; } while (0)
#define SWRITE_H(bf) do { SWRITE_HV(bf); SWRITE_HK(bf); } while (0)
template <int DIL> __device__ __forceinline__ void swa_prime(const BlockRef& cur, char* lds, Seam& S) {
    constexpr int PITCH = 128;
    int tid_ = threadIdx.x; asm volatile("" : "+v"(tid_));
    const int tid = tid_, wid = __builtin_amdgcn_readfirstlane(tid >> 6), lane = tid & 63, r32 = lane & 31, hi = lane >> 5;
    const int sr = tid >> 4, sc = (tid & 15) * 8, kws = KSWZ(sr, sc * 2); char* K_lds = lds + 2 * SHM_V;
    const unsigned rowoff = (unsigned)(sr * PITCH + sc) * 2u, qoff = (unsigned)((wid * QBLK + r32) * PITCH + hi * 8) * 2u;
    const int kb0 = swa_jlo(cur.P0) * KVBLK;
#pragma unroll
    for (int d0 = 0; d0 < 8; ++d0) S.qr[d0] = ld8g((const char*)cur.Q + d0 * 32, qoff);
    SLOAD_H(cur.K, cur.V, kb0, PITCH); VMW(); SWRITE_HK(0);
    __syncthreads();
}
template <int DIL> __device__ __forceinline__ void swa_block(const BlockRef& cur, const BlockRef& nxt, char* lds, Seam& S) {
    constexpr int PITCH = 128, LPITCH = DIL * 48, SKV = 4096 / DIL;
    int tid_ = threadIdx.x; asm volatile("" : "+v"(tid_));
    const int tid = tid_, wid = __builtin_amdgcn_readfirstlane(tid >> 6), lane = tid & 63, r32 = lane & 31, hi = lane >> 5;
    const int j_lo = swa_jlo(cur.P0);
    int j_hi = (cur.P0 + QB - 1) / KVBLK + 1; if (j_hi > SKV / KVBLK) j_hi = SKV / KVBLK;
    const int NT = j_hi - j_lo;
    const int kbn = swa_jlo(nxt.P0) * KVBLK;
    const int qlo = cur.P0 + wid * QBLK, qm = qlo + r32 - 4 * hi;
    char* V_lds = lds; char* K_lds = lds + 2 * SHM_V;
    float* ws = (float*)(lds + 2 * SHM_V + 2 * SHM_K) + wid * 64; float* li_l = ws, * al_l = ws + 32;
    float m_reg = -1e30f, l_reg = 0; f32x16 o[4] = {};
    const int sr = tid >> 4, sc = (tid & 15) * 8, vst0 = v_st(sr, sc), vst1 = v_st(32 + sr, sc), kws = KSWZ(sr, sc * 2);
    const unsigned rowoff = (unsigned)(sr * PITCH + sc) * 2u, qoff = (unsigned)((wid * QBLK + r32) * PITCH + hi * 8) * 2u;
    const int vb0 = (int)(uintptr_t)V_lds + v_rd_base(lane);
    const bf16* Kh = cur.K; const bf16* Vh = cur.V; constexpr int pitch = PITCH;
#define RESC(a) do { if (__any((a) < 1.f)) { if (hi == 0) al_l[r32] = (a); asm volatile("s_waitcnt lgkmcnt(0)" ::: "memory");              \
                     for (int d_ = 0; d_ < 4; ++d_) for (int r = 0; r < 16; ++r) o[d_][r] *= al_l[crow(r, hi)]; } } while (0)
#define KBASE(t) ((j_lo + (t)) * KVBLK)
#define ACT(t) (KBASE(t) <= qlo + QBLK - 1 && KBASE(t) + KVBLK - 1 >= qlo - W + 1)
#define MASKT(P0_, P1_, t) do { const int kb_ = KBASE(t); if ((!SK || ACT(t)) && (kb_ + KVBLK - 1 > qlo || kb_ <= qlo + QBLK - 1 - W)) mask_tile(P0_, P1_, qm - kb_, (unsigned)W); } while (0)
#define SEAM_K0() do { VMWN(8); SWRITE_HK(0); SBAR(); } while (0)
    f32x16 pA0, pA1, pB0, pB1; float mnA, mnB, alA, alB; bf16x8 pa0, pa1, pa2, pa3;
    SWRITE_HV(0); SBAR();
    if (NT > 1) { SLOAD_H(Kh, Vh, KBASE(1), pitch); }
    SBAR(); qkt<0>(pA0, pA1, K_lds, r32, hi, S.qr, ACT(0));
    MASKT(pA0, pA1, 0); partialSM(pA0, pA1, m_reg, mnA, alA);
    if (NT > 1) { VMW(); SWRITE_H(1); }
    __syncthreads();
#define HALF_STEP(PX0, PX1, mnX, alX, PY0, PY1, alY, t, KB, VB, SB) do {                                                      \
        SBAR(); qkt<KB>(PX0, PX1, K_lds, r32, hi, S.qr, ACT(t));                                             \
        finishSM(PY0, PY1, alY, l_reg, pa0, pa1, pa2, pa3); SBAR();                                                           \
        if ((t) + 1 < NT) { SLOAD_H(Kh, Vh, KBASE((t) + 1), pitch); SBAR(); }                                               \
        pv_tile<VB>(o, vb0, pa0, pa1, pa2, pa3, ACT((t) - 1)); MASKT(PX0, PX1, (t)); partialSM(PX0, PX1, m_reg, mnX, alX);                                        \
        __syncthreads();                                                                                                      \
        if ((t) + 1 < NT) { VMW(); SWRITE_H(SB); }                                                                          \
        RESC(alX); __syncthreads(); } while (0)
    for (int t = 1; t + 1 < NT; t += 2) {
        HALF_STEP(pB0, pB1, mnB, alB, pA0, pA1, alA, t, 1, 0, 0);
        HALF_STEP(pA0, pA1, mnA, alA, pB0, pB1, alB, t + 1, 0, 1, 1);
    }
    const bool even = (NT & 1) == 0;
    if (even) { SBAR(); qkt<1>(pB0, pB1, K_lds, r32, hi, S.qr, ACT(NT - 1)); SBAR(); }
    SLOAD_H(nxt.K, nxt.V, kbn, PITCH); SBAR();
#pragma unroll
    for (int d0 = 0; d0 < 8; ++d0) S.qr[d0] = ld8g((const char*)nxt.Q + d0 * 32, qoff);
    SBAR();
    finishSM(pA0, pA1, alA, l_reg, pa0, pa1, pa2, pa3); SBAR();
    pv_tile<0>(o, vb0, pa0, pa1, pa2, pa3, ACT(even ? NT - 2 : NT - 1));
    if (even) { MASKT(pB0, pB1, NT - 1); partialSM(pB0, pB1, m_reg, mnB, alB); __syncthreads(); RESC(alB);
        finishSM(pB0, pB1, alB, l_reg, pa0, pa1, pa2, pa3); SBAR(); pv_tile<1>(o, vb0, pa0, pa1, pa2, pa3, ACT(NT - 1)); }
    SBAR(); SEAM_K0();
    if (hi == 0) li_l[r32] = l_reg; asm volatile("s_waitcnt lgkmcnt(0)" ::: "memory");
    float rli[16];
#pragma unroll
    for (int r = 0; r < 16; ++r) rli[r] = __builtin_amdgcn_rcpf(li_l[crow(r, hi)]);
    { char* Ob = (char*)cur.O + (size_t)(wid * QBLK) * (size_t)(PITCH * 2); const unsigned ooff = (unsigned)(4 * hi * PITCH + r32) * 2u;
#pragma unroll
      for (int r = 0; r < 16; ++r) { char* Or = Ob + (size_t)((r & 3) + 8 * (r >> 2)) * (size_t)(PITCH * 2);
#pragma unroll
        for (int d0 = 0; d0 < 4; ++d0) { const float v = o[d0][r] * rli[r];
            const float vn = __shfl_xor(v, 1);
            if ((r32 & 1) == 0) *(unsigned*)(Or + d0 * 64 + ooff) = cvtpk(v, vn); } } }
    if (hi == 0) cur.LSE[(size_t)(wid * QBLK + r32) * (size_t)LPITCH] = m_reg * SCALE + __builtin_amdgcn_logf(l_reg) * 0.6931471805599453f;
    __syncthreads();
#undef RESC
#undef KBASE
#undef ACT
#undef MASKT
#undef SEAM_K0
#undef HALF_STEP
}
#undef VMW
#undef VMWN
#undef SLOAD_H
#undef SWRITE_HK
#undef SWRITE_HV
#undef SWRITE_H
#undef KSWZ
#undef SBAR

template <int DIL> __device__ __forceinline__ BlockRef make_ref(int idx, const bf16* Q, const bf16* K, const bf16* V, bf16* O, float* LSE) {
    constexpr int GI = DIL == 1 ? 0 : (DIL == 4 ? 1 : 2), NQB = 16 / DIL, PITCH = 128;
    const int j = idx & 15, h = (idx >> 4) & 15, b = idx >> 8, r = j / NQB, qb = j - r * NQB;
    const size_t base = ((size_t)((b * 3 + GI) * 16 + h) * 4096 + (size_t)r * (4096 / DIL)) * 128;
    BlockRef R; R.P0 = qb * QB;
    R.K = K + base; R.V = V + base; R.Q = Q + base + (size_t)R.P0 * (size_t)PITCH; R.O = O + base + (size_t)R.P0 * (size_t)PITCH;
    R.LSE = LSE + (size_t)(b * 4096 + r + R.P0 * DIL) * 48 + GI * 16 + h;
    return R;
}
template <int DIL> __device__ __forceinline__ void attn_group(char* lds, const bf16* Q, const bf16* K, const bf16* V, bf16* O, float* LSE) {
    const int total = 1024, stride = gridDim.x; int L = blockIdx.x; if (L >= total) return;
    BlockRef cur = make_ref<DIL>(L, Q, K, V, O, LSE); Seam S;
    swa_prime<DIL>(cur, lds, S);
    for (;;) {
        const int Ln = L + stride; const bool last = Ln >= total;
        const BlockRef nxt = last ? cur : make_ref<DIL>(Ln, Q, K, V, O, LSE);
        swa_block<DIL>(cur, nxt, lds, S);
        if (last) break;
        cur = nxt; L = Ln;
    }
}
__device__ __forceinline__ void attn_phase(char* lds, const bf16* Q, const bf16* K, const bf16* V, bf16* O, float* LSE) {
#ifndef ATT_ONLY
    attn_group<1>(lds, Q, K, V, O, LSE);
    attn_group<4>(lds, Q, K, V, O, LSE);
    attn_group<16>(lds, Q, K, V, O, LSE);
#else
    attn_group<ATT_ONLY>(lds, Q, K, V, O, LSE);
#endif
}
}
namespace att2 {
typedef unsigned short bf16;
typedef short bf16x8 __attribute__((ext_vector_type(8)));
typedef short v4i16_t __attribute__((ext_vector_type(4)));
typedef float f32x4 __attribute__((ext_vector_type(4)));
typedef float f32x2 __attribute__((ext_vector_type(2)));
typedef unsigned u32x4 __attribute__((ext_vector_type(4)));
typedef unsigned u32x2 __attribute__((ext_vector_type(2)));
typedef __bf16 bf16x2_t __attribute__((ext_vector_type(2)));
#define ALAS __attribute__((address_space(3)))
constexpr int KST = 272, VST = 288, GRAN_K = 128 * KST, GRAN = GRAN_K + 128 * VST;
constexpr int LDS_NEED = 2 * GRAN;
constexpr float F8S = 16.0f;
constexpr float SCALE = 0.08838834764831845f / (F8S * F8S), C2 = 1.4426950408889634f * SCALE;
__device__ __forceinline__ u32x2 f8x4_to_bf16(unsigned w) { const f32x2 lo = __builtin_amdgcn_cvt_pk_f32_fp8((int)w, false), hi = __builtin_amdgcn_cvt_pk_f32_fp8((int)w, true);
    const bf16x2_t a = __builtin_convertvector(lo, bf16x2_t), b = __builtin_convertvector(hi, bf16x2_t); return (u32x2){__builtin_bit_cast(unsigned, a), __builtin_bit_cast(unsigned, b)}; }
__device__ __forceinline__ u32x4 f8x8_to_bf16(unsigned w0, unsigned w1) { const u32x2 a = f8x4_to_bf16(w0), b = f8x4_to_bf16(w1); return (u32x4){a.x, a.y, b.x, b.y}; }
__device__ __forceinline__ unsigned cvtpk(float lo, float hi) { const f32x2 v = {lo, hi}; const bf16x2_t b = __builtin_convertvector(v, bf16x2_t); return __builtin_bit_cast(unsigned, b); }
__device__ __forceinline__ v4i16_t vtr(const ALAS unsigned char* p) { return __builtin_amdgcn_ds_read_tr16_b64_v4i16((ALAS v4i16_t*)p); }

__device__ __forceinline__ void a2_compute(ALAS unsigned char* lds, int G, bool has_prev, int wid, int q16, int g4, const bf16x8 (&qf)[4], bf16* Oq, float* LSE, int b, int GI, int h, int DIL, int NBM, int NBS) {
        const ALAS unsigned char* slotP = lds + ((G - 1) & 1) * GRAN; const ALAS unsigned char* slotC = lds + (G & 1) * GRAN;
        f32x4 sc[9];
        const int nprev = 8 - wid;
#pragma unroll
        for (int kt = 0; kt < 9; ++kt) { sc[kt] = (f32x4){0.f, 0.f, 0.f, 0.f};
            const int kb = 16 * wid + 16 * kt; const bool inprev = kt < nprev;
            if (!inprev || has_prev) { const ALAS unsigned char* kp = (inprev ? slotP + kb * KST : slotC + (kb - 128) * KST) + q16 * KST + g4 * 16;
#pragma unroll
                for (int s = 0; s < 4; ++s) sc[kt] = __builtin_amdgcn_mfma_f32_16x16x32_bf16(*(const ALAS bf16x8*)(kp + s * 64), qf[s], sc[kt], 0, 0, 0); } }
        const float NEG = -__builtin_inff();
#pragma unroll
        for (int r = 0; r < 4; ++r) { if (4 * g4 + r < q16) sc[0][r] = NEG; if (4 * g4 + r > q16) sc[8][r] = NEG; }
        if (!has_prev) {
#pragma unroll
            for (int kt = 0; kt < 8; ++kt) if (kt < nprev) sc[kt] = (f32x4){NEG, NEG, NEG, NEG}; }
        float mx = NEG;
#pragma unroll
        for (int kt = 0; kt < 9; ++kt) mx = fmaxf(mx, fmaxf(fmaxf(sc[kt][0], sc[kt][1]), fmaxf(sc[kt][2], sc[kt][3])));
        mx = fmaxf(mx, __shfl_xor(mx, 16)); mx = fmaxf(mx, __shfl_xor(mx, 32));
        const float mL = -mx * C2; float ls = 0.f;
#pragma unroll
        for (int kt = 0; kt < 9; ++kt)
#pragma unroll
            for (int r = 0; r < 4; ++r) { const float p = __builtin_amdgcn_exp2f(fmaf(sc[kt][r], C2, mL)); sc[kt][r] = p; ls += p; }
        ls += __shfl_xor(ls, 16); ls += __shfl_xor(ls, 32);
        f32x4 o[8];
#pragma unroll
        for (int dt = 0; dt < 8; ++dt) o[dt] = (f32x4){0.f, 0.f, 0.f, 0.f};
#pragma unroll
        for (int p = 0; p < 5; ++p) { const int t0 = 2 * p, t1 = 2 * p + 1;
            const bool v0 = !(t0 < nprev) || has_prev, v1 = (t1 < 9) && (!(t1 < nprev) || has_prev);
            if (v0 || v1) {
                u32x4 pw; pw.x = cvtpk(sc[t0][0], sc[t0][1]); pw.y = cvtpk(sc[t0][2], sc[t0][3]);
                if (t1 < 9) { pw.z = cvtpk(sc[t1 < 9 ? t1 : 8][0], sc[t1 < 9 ? t1 : 8][1]); pw.w = cvtpk(sc[t1 < 9 ? t1 : 8][2], sc[t1 < 9 ? t1 : 8][3]); } else { pw.z = 0u; pw.w = 0u; }
                const bf16x8 pf = __builtin_bit_cast(bf16x8, pw);
                const int kb0 = 16 * wid + 16 * t0, kb1 = 16 * wid + 16 * t1;
                const ALAS unsigned char* vb0 = (t0 < nprev) ? slotP + GRAN_K + kb0 * VST : slotC + GRAN_K + (kb0 - 128) * VST;
                const ALAS unsigned char* vb1 = (t1 < 9) ? ((t1 < nprev) ? slotP + GRAN_K + kb1 * VST : slotC + GRAN_K + (kb1 - 128) * VST) : vb0;
                if (!v0) vb0 = vb1;
                if (!v1) vb1 = vb0;
                const ALAS unsigned char* a0 = vb0 + (4 * g4 + (q16 >> 2)) * VST + (q16 & 3) * 8; const ALAS unsigned char* a1 = vb1 + (4 * g4 + (q16 >> 2)) * VST + (q16 & 3) * 8;
#pragma unroll
                for (int dt = 0; dt < 8; ++dt) { const v4i16_t lo = vtr(a0 + dt * 32), hi = vtr(a1 + dt * 32);
                    o[dt] = __builtin_amdgcn_mfma_f32_16x16x32_bf16((bf16x8){lo[0], lo[1], lo[2], lo[3], hi[0], hi[1], hi[2], hi[3]}, pf, o[dt], 0, 0, 0); } } }
        { const float inv = __builtin_amdgcn_rcpf(ls); unsigned char* orow = (unsigned char*)Oq + 4 * g4;
#pragma unroll
          for (int dt = 0; dt < 8; ++dt) *(unsigned*)(orow + 16 * dt) = pg8::cvt4_fp8(o[dt][0] * inv, o[dt][1] * inv, o[dt][2] * inv, o[dt][3] * inv, 1.0f);
          if (g4 == 0) { const int blk = G & NBM, r = G >> NBS, t = (128 * blk + 16 * wid + q16) * DIL + r;
              LSE[((size_t)b * 4096 + t) * 48 + GI * 16 + h] = mx * SCALE + __builtin_amdgcn_logf(ls) * 0.6931471805599453f; } }
}

__device__ __forceinline__ void attn_item(ALAS unsigned char* lds, int b, int GI, int h, int G0, const bf16* Q, const bf16* K, const bf16* V, bf16* O, float* LSE) {
    const int DIL = 1 << (2 * GI), NBM = (32 >> (2 * GI)) - 1, NBS = 5 - 2 * GI;
    int tid_ = threadIdx.x; asm volatile("" : "+v"(tid_));
    const int tid = tid_, wid = __builtin_amdgcn_readfirstlane(tid >> 6), lane = tid & 63, q16 = lane & 15, g4 = lane >> 4;
    const size_t hb = (size_t)((b * 3 + GI) * 16 + h) * 4096;
    const char* Kh = (const char*)K + hb * 128; const char* Vh = (const char*)V + hb * 128;
    u32x4 skA[2], svA[2], skB[2], svB[2];
#define A2_GLOAD(G_, sk, sv) do { _Pragma("unroll") for (int i = 0; i < 2; ++i) { const unsigned o_ = (unsigned)((G_) * 128 * 128) + (unsigned)(tid + 512 * i) * 16u; \
        sk[i] = *(const u32x4*)(Kh + o_); sv[i] = *(const u32x4*)(Vh + o_); } } while (0)
#define A2_WIDEN(dstp_, src_) do { *(ALAS u32x4*)(dstp_) = f8x8_to_bf16(src_.x, src_.y); *(ALAS u32x4*)((dstp_) + 16) = f8x8_to_bf16(src_.z, src_.w); } while (0)
#define A2_GWRITE(G_, sk, sv) do { ALAS unsigned char* sl_ = lds + ((G_) & 1) * GRAN; _Pragma("unroll") for (int i = 0; i < 2; ++i) { const int id_ = tid + 512 * i, r_ = id_ >> 3, c_ = id_ & 7; \
        A2_WIDEN(sl_ + r_ * KST + c_ * 32, sk[i]); A2_WIDEN(sl_ + GRAN_K + r_ * VST + c_ * 32, sv[i]); } } while (0)
#define A2_QLOAD(G_, qf_) do { const size_t qr_ = hb + (size_t)(G_) * 128 + 16 * wid + q16; _Pragma("unroll") for (int s = 0; s < 4; ++s) { const u32x2 w_ = *(const u32x2*)((const unsigned char*)Q + qr_ * 128 + 32 * s + 8 * g4); \
        qf_[s] = __builtin_bit_cast(bf16x8, f8x8_to_bf16(w_.x, w_.y)); } } while (0)
    bf16x8 qfA[4], qfB[4];
    __syncthreads();
    if ((G0 & NBM) != 0) { A2_GLOAD(G0 - 1, skA, svA); A2_GWRITE(G0 - 1, skA, svA); }
    A2_GLOAD(G0, skB, svB); A2_QLOAD(G0, qfA); A2_GLOAD(G0 + 1, skA, svA); A2_GWRITE(G0, skB, svB);
    __syncthreads();
#define A2_BLOCK(n, skC, svC, skN, svN, qf, qn) do { \
        const int G = G0 + (n); const bool has_prev = (G & NBM) != 0; \
        if ((n) < 6) A2_GLOAD(G + 2, skN, svN); \
        if ((n) < 7) A2_QLOAD(G + 1, qn); \
        const size_t qrow = hb + (size_t)G * 128 + 16 * wid + q16; \
        a2_compute(lds, G, has_prev, wid, q16, g4, qf, O + qrow * 64, LSE, b, GI, h, DIL, NBM, NBS);   \
        __syncthreads(); \
        if ((n) < 7) A2_GWRITE(G + 1, skC, svC); \
        __syncthreads(); } while (0)
    A2_BLOCK(0, skA, svA, skB, svB, qfA, qfB); A2_BLOCK(1, skB, svB, skA, svA, qfB, qfA);
    A2_BLOCK(2, skA, svA, skB, svB, qfA, qfB); A2_BLOCK(3, skB, svB, skA, svA, qfB, qfA);
    A2_BLOCK(4, skA, svA, skB, svB, qfA, qfB); A2_BLOCK(5, skB, svB, skA, svA, qfB, qfA);
    A2_BLOCK(6, skA, svA, skB, svB, qfA, qfB); A2_BLOCK(7, skB, svB, skA, svA, qfB, qfA);
#undef A2_BLOCK
#undef A2_GLOAD
#undef A2_GWRITE
#undef A2_WIDEN
#undef A2_QLOAD
}

__device__ __forceinline__ void attn_phase(ALAS unsigned char* lds, const bf16* Q, const bf16* K, const bf16* V, bf16* O, float* LSE) {
    const int G_ = gridDim.x, vcu = (G_ % 8 == 0) ? ((int)blockIdx.x % 8) * (G_ / 8) + (int)blockIdx.x / 8 : (int)blockIdx.x;
    for (int it = vcu; it < 768; it += G_) { const int i4 = it & 3, h = (it >> 2) & 15, bg = it >> 6, b = bg / 3, g = bg - 3 * b;
        attn_item(lds, b, g, h, 8 * i4, Q, K, V, O, LSE); }
}
#undef ALAS
}
namespace hg {
typedef short bf16x8 __attribute__((ext_vector_type(8)));
typedef short s16x4 __attribute__((ext_vector_type(4)));
typedef float f32x16 __attribute__((ext_vector_type(16)));
typedef float f32x4 __attribute__((ext_vector_type(4)));
typedef float f32x2 __attribute__((ext_vector_type(2)));
typedef unsigned u32x4 __attribute__((ext_vector_type(4)));
typedef _Float16 f16x2_t __attribute__((ext_vector_type(2)));
#define HLAS __attribute__((address_space(3)))
constexpr int QT_OFF = 0, QT_ST = 264;
constexpr int QH_OFF = 16896, QH_ST = 272;
constexpr int KC_OFF = 34304, KC_ST = 272;
constexpr int KCT_OFF = 51712, KCT_ST = 144;
constexpr int VT_OFF = 70144, VT_ST = 144;
constexpr int GAM_OFF = 88576;
constexpr int TOT_OFF = 89088;
constexpr int OB_OFF = 93184, OB_ST = 132;
constexpr int LDS_END = OB_OFF + 64 * OB_ST * 4;
static_assert(LDS_END <= 131072, "hgrn LDS map");
typedef __bf16 bf16x2_t __attribute__((ext_vector_type(2)));
__device__ __forceinline__ unsigned cvtpk(float lo, float hi) { const f32x2 v = {lo, hi}; const bf16x2_t b = __builtin_convertvector(v, bf16x2_t); return __builtin_bit_cast(unsigned, b); }
__device__ __forceinline__ float ex(float x) { return __builtin_amdgcn_exp2f(x * 1.4426950408889634f); }
__device__ __forceinline__ float blo(unsigned w) { return __builtin_bit_cast(float, w << 16); }
__device__ __forceinline__ float bhi(unsigned w) { return __builtin_bit_cast(float, w & 0xffff0000u); }
__device__ __forceinline__ bf16x8 pack8(const f32x16& x, int o) {
    u32x4 w = {cvtpk(x[o + 0], x[o + 1]), cvtpk(x[o + 2], x[o + 3]), cvtpk(x[o + 4], x[o + 5]), cvtpk(x[o + 6], x[o + 7])}; return __builtin_bit_cast(bf16x8, w); }
__device__ __forceinline__ bf16x8 ld2x8(const HLAS unsigned char* p) {
    const s16x4 lo = *(const HLAS s16x4*)p, hi = *(const HLAS s16x4*)(p + 16); return (bf16x8){lo[0], lo[1], lo[2], lo[3], hi[0], hi[1], hi[2], hi[3]}; }

template <bool STATE_ONLY>
__device__ __forceinline__ void hgrn_chunked(HLAS unsigned char* lds, int bh, int seg_i, int ch0, int nch, const unsigned short* Qb, const unsigned short* Kb, const unsigned short* Vb, unsigned short* Ob,
                                             const float* LOGF, const unsigned short* SGb, const float* ogain, float* Sbase, float* Gbase) {
    constexpr int SEQ_ = 4096, DM_ = 2048, HD_ = 128;
    int tid_ = threadIdx.x; asm volatile("" : "+v"(tid_));
    const int tid = tid_, wid = __builtin_amdgcn_readfirstlane(tid >> 6), lane = tid & 63, wt = wid >> 2, wv = wid & 3, c = lane & 31, hi = lane >> 5;
    const int b = bh >> 4, h = bh & 15;
    const size_t goff0 = ((size_t)bh * SEQ_ + 8 * wid) * HD_ + 2 * lane;
    const int t4 = tid >> 3, seg = tid & 7;
    f32x4 gn[4];
    if constexpr (!STATE_ONLY) {
#pragma unroll
        for (int i = 0; i < 4; ++i) gn[i] = *(const f32x4*)(ogain + 16 * seg + 4 * i); }
    f32x16 S[4];
#pragma unroll
    for (int kt = 0; kt < 4; ++kt)
#pragma unroll
        for (int r = 0; r < 16; ++r) S[kt][r] = 0.f;
    if constexpr (!STATE_ONLY) {
        for (int j = 0; j < seg_i; ++j) { const float* Sj = Sbase + (size_t)j * HD_ * HD_ + 32 * wv + c; const float* Gj = Gbase + j * HD_;
#pragma unroll
            for (int kt = 0; kt < 4; ++kt)
#pragma unroll
                for (int r = 0; r < 16; ++r) { const int k = 32 * kt + (r & 3) + 8 * (r >> 2) + 4 * hi; S[kt][r] = ex(Gj[k]) * S[kt][r] + Sj[(size_t)k * HD_]; } } }
    float gs0 = 0.f, gs1 = 0.f;
#ifdef HG_STORE_K
    unsigned kv[8];
#endif
    f32x2 lfh[8]; unsigned qv[8], vv[8];
#ifdef HG_STORE_K
#define HG_KLOAD(i, o_) kv[i] = *(const unsigned*)(Kb + o_)
#define HG_K(i) const float k0 = blo(kv[i]), k1 = bhi(kv[i])
#else
#define HG_KLOAD(i, o_)
#define HG_K(i) const float k0 = 1.0f - ex(l0[i]), k1 = 1.0f - ex(l1[i])
#endif
#define HG_LOAD(t0_) do { _Pragma("unroll") for (int i = 0; i < 8; ++i) { const size_t o_ = goff0 + (size_t)((t0_) + i) * HD_; \
        lfh[i] = *(const f32x2*)(LOGF + o_); HG_KLOAD(i, o_); vv[i] = *(const unsigned*)(Vb + o_); if constexpr (!STATE_ONLY) qv[i] = *(const unsigned*)(Qb + o_); } } while (0)
    HG_LOAD(ch0 * 64);
    HLAS float* TOT = (HLAS float*)(lds + TOT_OFF); HLAS float* GAM = (HLAS float*)(lds + GAM_OFF); HLAS float* OB = (HLAS float*)(lds + OB_OFF);
    for (int ch = ch0; ch < ch0 + nch; ++ch) {
        const int t0 = ch * 64;
        float f0[8], f1[8], cs0 = 0.f, cs1 = 0.f;
#pragma unroll
        for (int i = 0; i < 8; ++i) { const float a0 = lfh[i][0], a1 = lfh[i][1]; cs0 += a0; cs1 += a1; f0[i] = ex(a0); f1[i] = ex(a1); }
        *(HLAS f32x2*)(TOT + wid * 128 + 2 * lane) = (f32x2){cs0, cs1};
        __syncthreads();
        {
            float pre0 = 0.f, pre1 = 0.f, tot0 = 0.f, tot1 = 0.f;
#pragma unroll
            for (int w = 0; w < 8; ++w) { const f32x2 tv = *(const HLAS f32x2*)(TOT + w * 128 + 2 * lane); tot0 += tv[0]; tot1 += tv[1]; if (w < wid) { pre0 += tv[0]; pre1 += tv[1]; } }
            gs0 += tot0; gs1 += tot1;
            const float rg0 = ex(fminf(-tot0, 80.f)), rg1 = ex(fminf(-tot1, 80.f));
            float kc0[8], kc1[8];
            { float r0 = ex(tot0 - pre0 - cs0), r1 = ex(tot1 - pre1 - cs1);
#pragma unroll
              for (int i = 7; i >= 0; --i) { kc0[i] = (1.0f - f0[i]) * r0; kc1[i] = (1.0f - f1[i]) * r1; r0 *= f0[i]; r1 *= f1[i]; } }
            if constexpr (!STATE_ONLY) { float e0 = ex(pre0), e1 = ex(pre1);
#pragma unroll
                for (int i = 0; i < 8; ++i) { const int t = 8 * wid + i; e0 *= f0[i]; e1 *= f1[i];
                    const float qt0 = blo(qv[i]) * e0, qt1 = bhi(qv[i]) * e1;
                    *(HLAS unsigned*)(lds + QT_OFF + t * QT_ST + lane * 4) = cvtpk(qt0, qt1);
                    *(HLAS unsigned*)(lds + QH_OFF + t * QH_ST + lane * 4) = cvtpk(qt0 * rg0, qt1 * rg1);
                    *(HLAS unsigned*)(lds + KC_OFF + t * KC_ST + lane * 4) = cvtpk(kc0[i], kc1[i]); } }
            *(HLAS u32x4*)(lds + KCT_OFF + (2 * lane) * KCT_ST + wid * 16) = (u32x4){cvtpk(kc0[0], kc0[1]), cvtpk(kc0[2], kc0[3]), cvtpk(kc0[4], kc0[5]), cvtpk(kc0[6], kc0[7])};
            *(HLAS u32x4*)(lds + KCT_OFF + (2 * lane + 1) * KCT_ST + wid * 16) = (u32x4){cvtpk(kc1[0], kc1[1]), cvtpk(kc1[2], kc1[3]), cvtpk(kc1[4], kc1[5]), cvtpk(kc1[6], kc1[7])};
            *(HLAS u32x4*)(lds + VT_OFF + (2 * lane) * VT_ST + wid * 16) = (u32x4){(vv[0] & 0xffffu) | (vv[1] << 16), (vv[2] & 0xffffu) | (vv[3] << 16), (vv[4] & 0xffffu) | (vv[5] << 16), (vv[6] & 0xffffu) | (vv[7] << 16)};
            *(HLAS u32x4*)(lds + VT_OFF + (2 * lane + 1) * VT_ST + wid * 16) = (u32x4){(vv[0] >> 16) | (vv[1] & 0xffff0000u), (vv[2] >> 16) | (vv[3] & 0xffff0000u), (vv[4] >> 16) | (vv[5] & 0xffff0000u), (vv[6] >> 16) | (vv[7] & 0xffff0000u)};
            if (wid == 0) *(HLAS f32x2*)(GAM + 2 * lane) = (f32x2){ex(tot0), ex(tot1)};
        }
        if (ch + 1 < ch0 + nch) HG_LOAD(t0 + 64);
        const size_t ooff = (size_t)(b * SEQ_ + t0 + t4) * DM_ + h * HD_ + 16 * seg;
        u32x4 sg0, sg1;
        if constexpr (!STATE_ONLY) { const size_t so_ = ((size_t)bh * SEQ_ + t0 + t4) * HD_ + 16 * seg; sg0 = *(const u32x4*)(SGb + so_); sg1 = *(const u32x4*)(SGb + so_ + 8); }
        __syncthreads();
        {
            const HLAS unsigned char* vrow = lds + VT_OFF + (32 * wv + c) * VT_ST;
            f32x16 O;
            if constexpr (!STATE_ONLY) {
            f32x16 X0, X1;
#pragma unroll
            for (int r = 0; r < 16; ++r) { O[r] = 0.f; X0[r] = 0.f; X1[r] = 0.f; }
            const HLAS unsigned char* qhp = lds + QH_OFF + (32 * wt + c) * QH_ST + hi * 16;
            { const HLAS unsigned char* kp = lds + KC_OFF + c * KC_ST + hi * 16;
#pragma unroll
              for (int ks = 0; ks < 8; ++ks) X0 = __builtin_amdgcn_mfma_f32_32x32x16_bf16(*(const HLAS bf16x8*)(kp + ks * 32), *(const HLAS bf16x8*)(qhp + ks * 32), X0, 0, 0, 0); }
            if (wt == 1) { const HLAS unsigned char* kp = lds + KC_OFF + (32 + c) * KC_ST + hi * 16;
#pragma unroll
              for (int ks = 0; ks < 8; ++ks) X1 = __builtin_amdgcn_mfma_f32_32x32x16_bf16(*(const HLAS bf16x8*)(kp + ks * 32), *(const HLAS bf16x8*)(qhp + ks * 32), X1, 0, 0, 0); }
#pragma unroll
            for (int r = 0; r < 16; ++r) { const bool drop = ((r & 3) + 8 * (r >> 2) + 4 * hi) > c; if (wt == 0) { if (drop) X0[r] = 0.f; } else { if (drop) X1[r] = 0.f; } }
#pragma unroll
            for (int st = 0; st < 2; ++st) O = __builtin_amdgcn_mfma_f32_32x32x16_bf16(pack8(X0, 8 * st), ld2x8(vrow + (16 * st + 4 * hi) * 2), O, 0, 0, 0);
            if (wt == 1) {
#pragma unroll
                for (int st = 0; st < 2; ++st) O = __builtin_amdgcn_mfma_f32_32x32x16_bf16(pack8(X1, 8 * st), ld2x8(vrow + (32 + 16 * st + 4 * hi) * 2), O, 0, 0, 0); }
            const HLAS unsigned char* qtp = lds + QT_OFF + (32 * wt + c) * QT_ST + 8 * hi;
#pragma unroll
            for (int kt = 0; kt < 4; ++kt)
#pragma unroll
                for (int st = 0; st < 2; ++st) O = __builtin_amdgcn_mfma_f32_32x32x16_bf16(ld2x8(qtp + (32 * kt + 16 * st) * 2), pack8(S[kt], 8 * st), O, 0, 0, 0);
            }
            bf16x8 vb[4];
#pragma unroll
            for (int st = 0; st < 4; ++st) vb[st] = *(const HLAS bf16x8*)(vrow + (16 * st + 8 * hi) * 2);
#pragma unroll
            for (int kt = 0; kt < 4; ++kt) {
#pragma unroll
                for (int g = 0; g < 4; ++g) { const f32x4 gm = *(const HLAS f32x4*)(GAM + 32 * kt + 8 * g + 4 * hi);
#pragma unroll
                    for (int j = 0; j < 4; ++j) S[kt][4 * g + j] *= gm[j]; }
                const HLAS unsigned char* kp = lds + KCT_OFF + (32 * kt + c) * KCT_ST + hi * 16;
#pragma unroll
                for (int st = 0; st < 4; ++st) S[kt] = __builtin_amdgcn_mfma_f32_32x32x16_bf16(*(const HLAS bf16x8*)(kp + st * 32), vb[st], S[kt], 0, 0, 0);
            }
            if constexpr (!STATE_ONLY) {
#pragma unroll
            for (int r = 0; r < 16; ++r) OB[(32 * wt + (r & 3) + 8 * (r >> 2) + 4 * hi) * OB_ST + 32 * wv + c] = O[r]; }
        }
        if constexpr (!STATE_ONLY) {
        __syncthreads();
        {
            f32x4 o[4]; float s = 0.f;
#pragma unroll
            for (int i = 0; i < 4; ++i) { o[i] = *(const HLAS f32x4*)(OB + t4 * OB_ST + 16 * seg + 4 * i); s += (o[i][0] * o[i][0] + o[i][1] * o[i][1]) + (o[i][2] * o[i][2] + o[i][3] * o[i][3]); }
            s += __shfl_xor(s, 1); s += __shfl_xor(s, 2); s += __shfl_xor(s, 4);
            const float sc = __builtin_amdgcn_rsqf(s * (1.0f / HD_) + 1e-6f);
            u32x4 w0, w1;
#pragma unroll
            for (int e = 0; e < 4; ++e) { const int i = e >> 1, j = (e & 1) * 2;
                w0[e] = cvtpk(o[i][j] * sc * gn[i][j] * blo(sg0[e]), o[i][j + 1] * sc * gn[i][j + 1] * bhi(sg0[e]));
                w1[e] = cvtpk(o[2 + i][j] * sc * gn[2 + i][j] * blo(sg1[e]), o[2 + i][j + 1] * sc * gn[2 + i][j + 1] * bhi(sg1[e])); }
            *(u32x4*)(Ob + ooff) = w0; *(u32x4*)(Ob + ooff + 8) = w1;
        }
        }
    }
    if constexpr (STATE_ONLY) {
        if (wt == 0) { float* Sj = Sbase + (size_t)seg_i * HD_ * HD_ + 32 * wv + c;
#pragma unroll
            for (int kt = 0; kt < 4; ++kt)
#pragma unroll
                for (int r = 0; r < 16; ++r) Sj[(size_t)(32 * kt + (r & 3) + 8 * (r >> 2) + 4 * hi) * HD_] = S[kt][r]; }
        if (wid == 0) *(f32x2*)(Gbase + seg_i * HD_ + 2 * lane) = (f32x2){gs0, gs1};
    }
#undef HG_LOAD
}
#undef HLAS
}
constexpr int BATCH = 4, SEQ = 4096, DM = 2048, MROWS = BATCH * SEQ, FFH = 5632, NHEAD = 16, HDIM = 128;
constexpr int NWAVES = 8;
constexpr int F8_FIRST_LAYER = 3, F8_FFN1_LAYER = 4;
constexpr size_t MiB = 1u << 20;
constexpr size_t WS_CTL = 0, WS_SS = 1 * MiB, CTL_ZERO_BYTES = 3 * MiB;
constexpr size_t WS_LBS = 3 * MiB, WS_JOBS = 3 * MiB + 32768, WS_ROPE = 3 * MiB + 65536;
constexpr size_t WS_WMAX = 2 * MiB;
constexpr size_t WS_ASC = 3 * MiB + 640 * 1024, WS_WSC = 3 * MiB + 704 * 1024;
constexpr size_t WS_WMAX2 = WS_WMAX + 256 * 1024, WS_ASC2 = 3 * MiB + 576 * 1024, WS_WSC2 = 3 * MiB + 896 * 1024;
#define I8_FFN2(L_) ((L_) == 2)
constexpr int I8_FFN1_LAYER = 0;
constexpr size_t WS_W = 4 * MiB;
constexpr size_t WS_WA_IN = WS_W, WS_WA_OUT = WS_W + 64 * MiB, WS_WF_IN = WS_W + 80 * MiB, WS_WF_OUT = WS_W + 256 * MiB,
                 WS_WQKV2 = WS_W + 344 * MiB, WS_WQ3 = WS_W + 416 * MiB, WS_WB_OUT = WS_W + 440 * MiB;
constexpr size_t WS_XB = 460 * MiB;
constexpr size_t WS_R1 = 524 * MiB;
constexpr size_t WS_R2 = 908 * MiB;
constexpr size_t WS_OG = 1168 * MiB;
constexpr size_t WS_X8 = 1360 * MiB;
constexpr size_t WS_END = 1392 * MiB;
constexpr int CW_BAR = 1024;
constexpr int RING_BYTES = 131072, SCR_OFF = 131072, LDS_BYTES = 163840, MISC_OFF = LDS_BYTES - 512;
static_assert(SCR_OFF == pg8::QKV_SCR_OFF && att2::LDS_NEED <= MISC_OFF && pg8::QKV_EPS_OFF + 1024 <= MISC_OFF, "LDS map");

#define GAS __attribute__((address_space(1)))
#define LAS __attribute__((address_space(3)))
typedef unsigned short bf16;
typedef unsigned v4u __attribute__((ext_vector_type(4)));
typedef unsigned v2u __attribute__((ext_vector_type(2)));
typedef float f32x4 __attribute__((ext_vector_type(4)));
#define LDS_WAIT() asm volatile("s_waitcnt lgkmcnt(0)" ::: "memory")
__device__ __forceinline__ unsigned f2bf(float f) { unsigned u = __builtin_bit_cast(unsigned, f); return (u + 0x7fffu + ((u >> 16) & 1u)) >> 16; }
__device__ __forceinline__ unsigned pk2(float lo, float hi) { return f2bf(lo) | (f2bf(hi) << 16); }
__device__ __forceinline__ float bflo(unsigned w) { return __builtin_bit_cast(float, w << 16); }
__device__ __forceinline__ float bfhi(unsigned w) { return __builtin_bit_cast(float, w & 0xffff0000u); }

#define XB_TMO      128
#define XB_XCNT(j)  (256  + 64 * (j))
#define XB_XSUB(j)  (1280 + 64 * (j))
#define XB_XGEN(j)  (2304 + 64 * (j))
#define XB_TOP      3328
#define XB_TOPGEN   3392
#define XCD_BAR_WORDS 3456
#define XB_SPIN_CAP (1u << 18)

__device__ __forceinline__ unsigned xb_ld(unsigned* p)              { return __hip_atomic_load(p, __ATOMIC_RELAXED, __HIP_MEMORY_SCOPE_AGENT); }
__device__ __forceinline__ unsigned xb_add(unsigned* p, unsigned v) { return __hip_atomic_fetch_add(p, v, __ATOMIC_RELAXED, __HIP_MEMORY_SCOPE_AGENT); }
__device__ __forceinline__ unsigned xb_xcc_id() { return (unsigned)__builtin_amdgcn_s_getreg((3 << 11) | 20) & 0xFu; }
#define XB_SPIN(cond, bar) do { unsigned _sp = 0; while (cond) { __builtin_amdgcn_s_sleep(1); \
    if ((++_sp & 255u) == 0u) { if (xb_ld(&(bar)[XB_TMO])) break; if (_sp > XB_SPIN_CAP) { atomicAdd(&(bar)[XB_TMO], 1u); break; } } } } while (0)

struct XcdBarrier {
    unsigned* bar; unsigned x;
    volatile LAS unsigned* st;
};

__device__ __forceinline__ XcdBarrier xcd_barrier_post(unsigned* bar, volatile LAS unsigned* st) {
    XcdBarrier b; b.bar = bar; b.x = xb_xcc_id(); b.st = st;
    if (threadIdx.x == 0) (void)xb_add(&bar[XB_XCNT(b.x)], 1u);
    return b;
}
__device__ __forceinline__ void xcd_barrier_complete(unsigned* bar, unsigned x, unsigned& nloc, unsigned& nx) {
    const unsigned G = gridDim.x * gridDim.y * gridDim.z;
    unsigned sum, cnt, mine, sp = 0u;
    for (;;) {
        sum = 0u; cnt = 0u; mine = 0u;
#pragma unroll
        for (unsigned j = 0; j < 16; ++j) { const unsigned c = xb_ld(&bar[XB_XCNT(j)]); sum += c; cnt += (c > 0u) ? 1u : 0u; mine = (j == x) ? c : mine; }
        if (sum == G) break;
        __builtin_amdgcn_s_sleep(1);
        if ((++sp & 255u) == 0u) { if (xb_ld(&bar[XB_TMO])) break; if (sp > XB_SPIN_CAP) { atomicAdd(&bar[XB_TMO], 1u); break; } }
    }
    nloc = mine > 0u ? mine : 1u; nx = cnt > 0u ? cnt : 1u;
}

__device__ __forceinline__ void xcd_barrier(const XcdBarrier& b) {
    asm volatile("s_waitcnt vmcnt(0)" ::: "memory");
    __syncthreads();
    if (threadIdx.x == 0) {
        unsigned* bar = b.bar;
        __builtin_amdgcn_s_waitcnt(0);
        unsigned nloc = b.st[0], nx = b.st[1];
        if (nloc == 0u) { xcd_barrier_complete(bar, b.x, nloc, nx); b.st[0] = nloc; b.st[1] = nx; }
        const unsigned old = xb_add(&bar[XB_XSUB(b.x)], 1u);
        const unsigned gen = old / nloc;
        if (old + 1u == (gen + 1u) * nloc) {
            __builtin_amdgcn_fence(__ATOMIC_RELEASE, "agent");
            asm volatile("s_waitcnt vmcnt(0)" ::: "memory");
            const unsigned og = xb_add(&bar[XB_TOP], 1u);
            const unsigned tg = og / nx;
            if (og + 1u == (tg + 1u) * nx) xb_add(&bar[XB_TOPGEN], 1u);
            else XB_SPIN(xb_ld(&bar[XB_TOPGEN]) == tg, bar);
            __builtin_amdgcn_fence(__ATOMIC_ACQUIRE, "agent");
            asm volatile("s_waitcnt vmcnt(0)" ::: "memory");
        } else {
            XB_SPIN(xb_ld(&bar[XB_TOPGEN]) == gen, bar);
            __builtin_amdgcn_fence(__ATOMIC_ACQUIRE, "agent");
            asm volatile("s_waitcnt vmcnt(0)" ::: "memory");
        }
    }
    __syncthreads();
}


__device__ __forceinline__ float wave_sum(float v) {
#pragma unroll
    for (int o = 1; o < 64; o <<= 1) v += __shfl_xor(v, o);
    return v;
}
__device__ __forceinline__ void conv_load64(float (&w)[64], const float* W, int ldw, int k0, int n0, int lane) {
    const float* src = W + (size_t)k0 * ldw + n0 + lane;
#pragma unroll
    for (int kk = 0; kk < 64; ++kk) w[kk] = __builtin_nontemporal_load(src + (size_t)kk * ldw);
}
__device__ __forceinline__ unsigned pack4_i8(float a, float b, float c, float d, float s) {
    const int q0 = (int)__builtin_rintf(__builtin_amdgcn_fmed3f(a * s, -127.f, 127.f)), q1 = (int)__builtin_rintf(__builtin_amdgcn_fmed3f(b * s, -127.f, 127.f)), q2 = (int)__builtin_rintf(__builtin_amdgcn_fmed3f(c * s, -127.f, 127.f)), q3 = (int)__builtin_rintf(__builtin_amdgcn_fmed3f(d * s, -127.f, 127.f));
    return (unsigned)(q0 & 255) | ((unsigned)(q1 & 255) << 8) | ((unsigned)(q2 & 255) << 16) | ((unsigned)(q3 & 255) << 24); }
__device__ __forceinline__ void conv_store64(const float (&w)[64], int K, const float* gain, bf16* WT, int k0, int nd0, LAS float* scr, int lane, bool f8 = false, const unsigned* wmax = nullptr, float* wsc = nullptr, int n0 = 0) {
    if (gain) {
#pragma unroll
        for (int kk = 0; kk < 64; ++kk) scr[kk * 65 + lane] = w[kk] * gain[k0 + kk]; }
    else {
#pragma unroll
        for (int kk = 0; kk < 64; ++kk) scr[kk * 65 + lane] = w[kk]; }
    LDS_WAIT(); asm volatile("" ::: "memory");
    const int c = lane & 7;
#pragma unroll
    for (int j = 0; j < 8; ++j) { const int n = (lane >> 3) + 8 * j; const LAS float* s = scr + (8 * c) * 65 + n;
        if (wmax) { const float am = fmaxf(__builtin_bit_cast(float, wmax[n0 + n]), 1e-30f), sc = 127.0f / am;
            v2u o; o.x = pack4_i8(s[0 * 65], s[1 * 65], s[2 * 65], s[3 * 65], sc); o.y = pack4_i8(s[4 * 65], s[5 * 65], s[6 * 65], s[7 * 65], sc);
            __builtin_nontemporal_store(o, (GAS v2u*)((unsigned char*)WT + (size_t)(nd0 + n) * K + k0 + 8 * c));
            if (k0 == 0 && c == 0) wsc[nd0 + n] = am * (1.0f / 127.0f); }
        else if (f8) { v2u o; o.x = pg8::cvt4_fp8(s[0 * 65], s[1 * 65], s[2 * 65], s[3 * 65], pg8::F8_WSCALE); o.y = pg8::cvt4_fp8(s[4 * 65], s[5 * 65], s[6 * 65], s[7 * 65], pg8::F8_WSCALE);
            __builtin_nontemporal_store(o, (GAS v2u*)((unsigned char*)WT + (size_t)(nd0 + n) * K + k0 + 8 * c)); }
        else { v4u o; o.x = pk2(s[0 * 65], s[1 * 65]); o.y = pk2(s[2 * 65], s[3 * 65]); o.z = pk2(s[4 * 65], s[5 * 65]); o.w = pk2(s[6 * 65], s[7 * 65]);
            __builtin_nontemporal_store(o, (GAS v4u*)(WT + (size_t)(nd0 + n) * K + k0 + 8 * c)); } }
    LDS_WAIT(); asm volatile("" ::: "memory");
}

struct Args { const float* in[16]; float* out; unsigned char* ws; };


__device__ __forceinline__ void wmax_tensor(const float* W, const float* gain, int K, int N, unsigned* wm, int gw, int NGW, int lane) {
    const int nblk = N / 64, nkb = K / 64, nitems = nkb * nblk;
    for (int it = gw; it < nitems; it += NGW) { const int k0 = 64 * (it % nkb), n0 = 64 * (it / nkb); const float* src = W + (size_t)k0 * N + n0 + lane; float m = 0.f;
#pragma unroll 16
        for (int kk = 0; kk < 64; ++kk) m = fmaxf(m, __builtin_fabsf(src[(size_t)kk * N] * (gain ? gain[k0 + kk] : 1.0f)));
        atomicMax(wm + n0 + lane, __builtin_bit_cast(unsigned, m)); }
}
__device__ __forceinline__ void wmax_pass(const Args& a, int gw, int NGW, int lane) {
    for (int l = I8_FFN1_LAYER; l < 4; ++l) wmax_tensor(a.in[14] + (size_t)l * DM * 2 * FFH, a.in[13] + l * DM, DM, 2 * FFH, (unsigned*)(a.ws + WS_WMAX) + l * 2 * FFH, gw, NGW, lane);
    for (int l = 0; l < 4; ++l) if (I8_FFN2(l)) wmax_tensor(a.in[15] + (size_t)l * FFH * DM, nullptr, FFH, DM, (unsigned*)(a.ws + WS_WMAX2) + l * DM, gw, NGW, lane);
}
template <int NP = 4>
__device__ __forceinline__ void quant_rows(const bf16* xb, const pg8::ssq_t* ss, unsigned char* xq, float* asc, int gw, int NGW, int lane) {
    constexpr int DM = NP * 512;
    for (int r = gw; r < MROWS; r += NGW) { const float rs = ss ? pg8::ss_to_rs(ss[r]) : 1.0f; const GAS v4u* src = (const GAS v4u*)(xb + (size_t)r * DM) + lane; v4u w[NP]; float m = 0.f;
#pragma unroll
        for (int j = 0; j < NP; ++j) { w[j] = src[64 * j];
#pragma unroll
            for (int q = 0; q < 4; ++q) m = fmaxf(m, fmaxf(__builtin_fabsf(bflo(w[j][q])), __builtin_fabsf(bfhi(w[j][q])))); }
#pragma unroll
        for (int o = 1; o < 64; o <<= 1) m = fmaxf(m, __shfl_xor(m, o));
        const float am = fmaxf(m * rs, 1e-30f), sc = rs * (127.0f / am);
#pragma unroll
        for (int j = 0; j < NP; ++j) { v2u o; o.x = pack4_i8(bflo(w[j][0]), bfhi(w[j][0]), bflo(w[j][1]), bfhi(w[j][1]), sc); o.y = pack4_i8(bflo(w[j][2]), bfhi(w[j][2]), bflo(w[j][3]), bfhi(w[j][3]), sc);
            *((GAS v2u*)(xq + (size_t)r * DM) + lane + 64 * j) = o; }
        if (lane == 0) asc[r] = am * (1.0f / 127.0f); }
}
__device__ __forceinline__ void prologue(const Args& a, LAS unsigned char* lds, int gw, int NGW, int lane, int wave) {
    unsigned char* ws = a.ws;
    { float* lbs = (float*)(ws + WS_LBS); const float* alb = a.in[5];
      for (int i = gw * 64 + lane; i < DM; i += NGW * 64) { const float a0 = alb[i], a1 = alb[DM + i]; float s1 = 1.0f / (1.0f + expf(a0 - a1)); s1 = fminf(fmaxf(s1, 0.0f), 1.0f - 1e-6f); lbs[i] = 0.0f; lbs[DM + i] = s1; } }
    { _Float16* rope = (_Float16*)(ws + WS_ROPE);
      for (int i = gw * 64 + lane; i < SEQ * 16; i += NGW * 64) { const int pos = i >> 4, j = i & 15; double inv = 1.0;
          for (int q = 0; q < j; ++q) inv *= 0.4403666026717805;
          const double ang = (double)pos * inv, nrev = __builtin_rint(ang * 0.15915494309189535);
          const double r = (ang - nrev * 6.283185307179586) - nrev * 2.4492935982947064e-16, r2 = r * r;
          double ts = r, sn = r, tc = 1.0, cs = 1.0;
          for (int q = 1; q <= 14; ++q) { tc *= -r2 / (double)((2 * q - 1) * (2 * q)); cs += tc; ts *= -r2 / (double)((2 * q) * (2 * q + 1)); sn += ts; }
          rope[pos * 32 + j] = (_Float16)(float)cs; rope[pos * 32 + 16 + j] = (_Float16)(float)sn; } }
    { const float* x = a.in[0]; bf16* xb = (bf16*)(ws + WS_XB); pg8::ssq_t* ss0 = (pg8::ssq_t*)(ws + WS_SS);
      for (int m = gw; m < MROWS; m += NGW) { const GAS f32x4* xr = (const GAS f32x4*)(x + (size_t)m * DM) + lane; GAS v2u* o8 = (GAS v2u*)(xb + (size_t)m * DM) + lane; float s = 0.f;
#pragma unroll
          for (int j = 0; j < 8; ++j) { const f32x4 v = xr[64 * j]; s += (v.x * v.x + v.y * v.y) + (v.z * v.z + v.w * v.w); v2u w; w.x = pk2(v.x, v.y); w.y = pk2(v.z, v.w); o8[64 * j] = w; }
          s = wave_sum(s); if (lane == 0) ss0[m] = (pg8::ssq_t)(s * pg8::SS_SCALE + 0.5f); } }
    pg8::ConvJob* jobs = (pg8::ConvJob*)(ws + WS_JOBS);
    LAS float* scr = (LAS float*)(lds + wave * 16640);
    for (int job = 0; job < 17; ++job) {
        const float* W; const float* gain = nullptr; bf16* dst; int K = DM, N, mode = 0, rowoff = 0;
        if (job < 2)       { W = a.in[2] + (size_t)job * DM * 8192; N = 8192; gain = a.in[1] + job * DM; dst = (bf16*)(ws + WS_WA_IN) + (size_t)job * 8192 * DM; }
        else if (job < 4)  { const int l = job - 2; W = a.in[4] + (size_t)l * DM * DM; N = DM; dst = (bf16*)(ws + WS_WA_OUT) + (size_t)l * DM * DM; }
        else if (job < 8)  { const int l = job - 4; W = a.in[14] + (size_t)l * DM * 2 * FFH; N = 2 * FFH; gain = a.in[13] + l * DM; dst = (bf16*)(ws + WS_WF_IN) + (size_t)l * 2 * FFH * DM; mode = 1; }
        else if (job < 12) { const int l = job - 8; W = a.in[15] + (size_t)l * FFH * DM; K = FFH; N = DM; dst = (bf16*)(ws + WS_WF_OUT) + (size_t)l * DM * FFH; }
        else if (job == 12) { W = a.in[10]; N = 6144; gain = a.in[9]; dst = (bf16*)(ws + WS_WQKV2); }
        else if (job == 13) { W = a.in[7]; N = 12288; gain = a.in[6]; dst = (bf16*)(ws + WS_WQKV2); rowoff = 6144; }
        else if (job == 14) { W = a.in[10] + (size_t)DM * 6144; N = 6144; gain = a.in[9] + DM; dst = (bf16*)(ws + WS_WQ3); }
        else { const int l = job - 15; W = a.in[12] + (size_t)l * DM * DM; N = DM; dst = (bf16*)(ws + WS_WB_OUT) + (size_t)l * DM * DM; }
        if (gw == 0 && lane == 0) { pg8::ConvJob J; J.W = W; J.gain = gain; J.dst = dst; J.K = K; J.N = N; J.mode = mode; J.rowoff = rowoff; jobs[job] = J; }
#ifndef CONV_ALL_IN_PROLOGUE
        if (!(job == 0 || job == 2 || job == 4 || job == 8)) continue;
#endif
        const bool i8job = job >= 4 + I8_FFN1_LAYER && job < 8;
        const bool i8ojob = job >= 8 && job < 12 && I8_FFN2(job - 8);
        const int nblk = N / 64, nkb = K / 64, nitems = nkb * nblk;
        float wa[64], wb[64];
#define CONV_KB 2
#define CONV_DEC(it_, k0_, n0_, nd0_) const int sg_##k0_ = (it_) >> 3, w_##k0_ = (it_) & 7, nkg_##k0_ = nkb / CONV_KB; \
        const int k0_ = 64 * (CONV_KB * (sg_##k0_ % nkg_##k0_) + (w_##k0_ % CONV_KB)), n0_ = 64 * ((8 / CONV_KB) * (sg_##k0_ / nkg_##k0_) + (w_##k0_ / CONV_KB)); int nd0_ = n0_ + rowoff; \
        if (mode == 1) { const int up_ = n0_ >= FFH, jn_ = up_ ? n0_ - FFH : n0_; nd0_ = 256 * (jn_ >> 7) + 128 * up_ + (jn_ & 127); }
        if (gw < nitems) { { CONV_DEC(gw, k0, n0, nd0); (void)nd0; conv_load64(wa, W, N, k0, n0, lane); }
            for (int it = gw; it < nitems; it += 2 * NGW) {
                const bool h1 = it + NGW < nitems, h2 = it + 2 * NGW < nitems;
                if (h1) { CONV_DEC(it + NGW, k0, n0, nd0); (void)nd0; conv_load64(wb, W, N, k0, n0, lane); }
                { CONV_DEC(it, k0, n0, nd0); conv_store64(wa, K, gain, dst, k0, nd0, scr, lane, (job >= 8 + F8_FIRST_LAYER && job < 12) || job >= 12 || (job >= 4 + F8_FFN1_LAYER && job < 8), i8job ? (const unsigned*)(ws + WS_WMAX) + (job - 4) * 2 * FFH : i8ojob ? (const unsigned*)(ws + WS_WMAX2) + (job - 8) * DM : nullptr, i8ojob ? (float*)(ws + WS_WSC2) + (job - 8) * DM : (float*)(ws + WS_WSC) + (job - 4) * 2 * FFH, n0); }
                if (h2) { CONV_DEC(it + 2 * NGW, k0, n0, nd0); (void)nd0; conv_load64(wa, W, N, k0, n0, lane); }
                if (h1) { CONV_DEC(it + NGW, k0, n0, nd0); conv_store64(wb, K, gain, dst, k0, nd0, scr, lane, (job >= 8 + F8_FIRST_LAYER && job < 12) || job >= 12 || (job >= 4 + F8_FFN1_LAYER && job < 8), i8job ? (const unsigned*)(ws + WS_WMAX) + (job - 4) * 2 * FFH : i8ojob ? (const unsigned*)(ws + WS_WMAX2) + (job - 8) * DM : nullptr, i8ojob ? (float*)(ws + WS_WSC2) + (job - 8) * DM : (float*)(ws + WS_WSC) + (job - 4) * 2 * FFH, n0); }
            } }
#undef CONV_DEC
    }
}

__device__ __forceinline__ void hgrn_naive(LAS unsigned char* lds, int bh, const bf16* Qb, const bf16* Kb, bf16* Vb, const float* LOGF, const bf16* SGb, const float* ogain) {
    int tid_ = threadIdx.x; asm volatile("" : "+v"(tid_));
    const int tid = tid_, b = bh >> 4, h = bh & 15, v = tid & 127, kg = tid >> 7;
    LAS float* Lf = (LAS float*)lds; LAS float* Lk = Lf + 2048; LAS float* Lq = Lk + 2048; LAS float* Lv = Lq + 2048; LAS float* Lp = Lv + 2048;
    float S[32];
#pragma unroll
    for (int j = 0; j < 32; ++j) S[j] = 0.f;
    const int stok = tid >> 5, sch = (tid & 31) * 4;
    for (int t0 = 0; t0 < SEQ; t0 += 16) {
        { const size_t off = (size_t)(b * SEQ + t0 + stok) * DM + h * HDIM + sch;
          const f32x4 lf = *(const f32x4*)(LOGF + off); const v2u kq = *(const v2u*)(Kb + off), qq = *(const v2u*)(Qb + off), vq = *(const v2u*)(Vb + off);
          *(LAS f32x4*)(Lf + stok * 128 + sch) = (f32x4){__expf(lf.x), __expf(lf.y), __expf(lf.z), __expf(lf.w)};
          *(LAS f32x4*)(Lk + stok * 128 + sch) = (f32x4){bflo(kq.x), bfhi(kq.x), bflo(kq.y), bfhi(kq.y)};
          *(LAS f32x4*)(Lq + stok * 128 + sch) = (f32x4){bflo(qq.x), bfhi(qq.x), bflo(qq.y), bfhi(qq.y)};
          *(LAS f32x4*)(Lv + stok * 128 + sch) = (f32x4){bflo(vq.x), bfhi(vq.x), bflo(vq.y), bfhi(vq.y)}; }
        __syncthreads();
        for (int tok = 0; tok < 16; ++tok) { const float vv = Lv[tok * 128 + v]; float acc = 0.f;
#pragma unroll
            for (int j4 = 0; j4 < 8; ++j4) { const f32x4 f = *(const LAS f32x4*)(Lf + tok * 128 + kg * 32 + 4 * j4), kk = *(const LAS f32x4*)(Lk + tok * 128 + kg * 32 + 4 * j4), qq = *(const LAS f32x4*)(Lq + tok * 128 + kg * 32 + 4 * j4);
#pragma unroll
                for (int e = 0; e < 4; ++e) { S[4 * j4 + e] = f[e] * S[4 * j4 + e] + kk[e] * vv; acc += qq[e] * S[4 * j4 + e]; } }
            Lp[(tok * 4 + kg) * 128 + v] = acc; }
        __syncthreads();
        { f32x4 o = *(const LAS f32x4*)(Lp + (stok * 4 + 0) * 128 + sch);
#pragma unroll
          for (int g = 1; g < 4; ++g) o += *(const LAS f32x4*)(Lp + (stok * 4 + g) * 128 + sch);
          float s = (o.x * o.x + o.y * o.y) + (o.z * o.z + o.w * o.w);
#pragma unroll
          for (int d = 1; d < 32; d <<= 1) s += __shfl_xor(s, d);
          const float sc = 1.0f / sqrtf(s * (1.0f / HDIM) + 1e-6f);
          const size_t off = (size_t)(b * SEQ + t0 + stok) * DM + h * HDIM + sch;
          const f32x4 gn = *(const f32x4*)(ogain + sch); const v2u sg = *(const v2u*)(SGb + off);
          v2u w; w.x = pk2(o.x * sc * gn.x * bflo(sg.x), o.y * sc * gn.y * bfhi(sg.x)); w.y = pk2(o.z * sc * gn.z * bflo(sg.y), o.w * sc * gn.w * bfhi(sg.y));
          *(v2u*)(Vb + off) = w; }
        __syncthreads();
    }
}

__device__ __forceinline__ void combine_phase(const bf16* OG, const float* LSE, bf16* OC) {
    typedef float f32x2c __attribute__((ext_vector_type(2)));
    const unsigned char* OG8 = (const unsigned char*)OG;
    const size_t nitem = (size_t)MROWS * (DM / 8), stride = (size_t)gridDim.x * blockDim.x;
    for (size_t i0 = (size_t)blockIdx.x * blockDim.x + threadIdx.x; i0 < nitem; i0 += 4 * stride) {
        v2u a[4], bb[4], cc[4]; float l0[4], l1[4], l2[4];
#pragma unroll
        for (int u = 0; u < 4; ++u) { const size_t i = i0 + u * stride; const size_t tok = i >> 8; const int c = (int)(i & 255) * 8, h = c >> 7, bb_ = (int)(tok >> 12), t_ = (int)(tok & 4095), d_ = c & 127;
            l0[u] = LSE[tok * 48 + h]; l1[u] = LSE[tok * 48 + 16 + h]; l2[u] = LSE[tok * 48 + 32 + h];
            a[u] = *(const v2u*)(OG8 + pg8::attn_row(bb_, 0, h, t_) * 128 + d_); bb[u] = *(const v2u*)(OG8 + pg8::attn_row(bb_, 1, h, t_) * 128 + d_); cc[u] = *(const v2u*)(OG8 + pg8::attn_row(bb_, 2, h, t_) * 128 + d_); }
#pragma unroll
        for (int u = 0; u < 4; ++u) { const size_t i = i0 + u * stride; const size_t tok = i >> 8; const int c = (int)(i & 255) * 8;
            const float mx = fmaxf(l0[u], fmaxf(l1[u], l2[u])); float w0 = __expf(l0[u] - mx), w1 = __expf(l1[u] - mx), w2 = __expf(l2[u] - mx); const float inv = 1.0f / (w0 + w1 + w2); w0 *= inv; w1 *= inv; w2 *= inv;
            float r[8];
#pragma unroll
            for (int e = 0; e < 2; ++e) {
                const f32x2c a0 = __builtin_amdgcn_cvt_pk_f32_fp8((int)a[u][e], false), a1 = __builtin_amdgcn_cvt_pk_f32_fp8((int)a[u][e], true);
                const f32x2c b0 = __builtin_amdgcn_cvt_pk_f32_fp8((int)bb[u][e], false), b1 = __builtin_amdgcn_cvt_pk_f32_fp8((int)bb[u][e], true);
                const f32x2c c0 = __builtin_amdgcn_cvt_pk_f32_fp8((int)cc[u][e], false), c1 = __builtin_amdgcn_cvt_pk_f32_fp8((int)cc[u][e], true);
                r[4 * e + 0] = w0 * a0[0] + w1 * b0[0] + w2 * c0[0]; r[4 * e + 1] = w0 * a0[1] + w1 * b0[1] + w2 * c0[1];
                r[4 * e + 2] = w0 * a1[0] + w1 * b1[0] + w2 * c1[0]; r[4 * e + 3] = w0 * a1[1] + w1 * b1[1] + w2 * c1[1]; }
            v2u o; o.x = pg8::cvt4_fp8(r[0], r[1], r[2], r[3], 1.0f); o.y = pg8::cvt4_fp8(r[4], r[5], r[6], r[7], 1.0f);
            *(v2u*)((unsigned char*)OC + tok * DM + c) = o; }
    }
}

#define GRID_BAR() xcd_barrier(bar)
template <int LAYER>
__device__ __forceinline__ void layer_phases(const Args& args, LAS unsigned char* lds, unsigned char* lds_raw, const XcdBarrier& bar) {
    unsigned char* ws = args.ws; const int G = gridDim.x;
    bf16* XB = (bf16*)(ws + WS_XB); pg8::ssq_t* SS = (pg8::ssq_t*)(ws + WS_SS); float* out = args.out;
    constexpr int ssi = 2 * LAYER;
    if constexpr (LAYER < 2) {
        bf16* HGO = (bf16*)(ws + WS_OG);
        bf16* Aq = (bf16*)(ws + WS_R1); bf16* Ak = Aq + (size_t)MROWS * DM; bf16* Av = Ak + (size_t)MROWS * DM; bf16* Asg = Av + (size_t)MROWS * DM; float* Alogf = (float*)(ws + WS_R1 + 256 * MiB);
#ifndef DIS_G1
        {
            pg8::Gemm g{XB, (const bf16*)(ws + WS_WA_IN) + (size_t)LAYER * 8192 * DM, MROWS, 8192, DM}; pg8::StaticOrder S; S.init(MROWS, 8192, G, (int)blockIdx.x);
            pg8::EpiHgrnIn E{Aq, Alogf, SS + (size_t)ssi * MROWS, (const float*)(ws + WS_LBS) + LAYER * DM};
            pg8::gemm_phase<pg8::EpiHgrnIn, pg8::StaticOrder, true, true>(lds, g, S, E);
#ifdef PROBE_REP_GEMM
            pg8::gemm_phase<pg8::EpiHgrnIn, pg8::StaticOrder, true, true>(lds, g, S, E);
#endif
        }
#endif
        GRID_BAR();
#ifndef DIS_HGRN
        {
            float* HS = (float*)(ws + WS_R2); float* HGm = (float*)(ws + WS_R2 + 16 * MiB);
            for (int u = blockIdx.x; u < BATCH * NHEAD * 3; u += G) { const int bh = u & 63, sg_ = u >> 6;
                hg::hgrn_chunked<true>(lds, bh, sg_, 16 * sg_, 16, Aq, Ak, Av, HGO, Alogf, Asg, args.in[3] + LAYER * HDIM, HS + (size_t)bh * 3 * HDIM * HDIM, HGm + bh * 3 * HDIM); }
#ifdef PROBE_REP_HG1
            __syncthreads();
            for (int u = blockIdx.x; u < BATCH * NHEAD * 3; u += G) { const int bh = u & 63, sg_ = u >> 6;
                hg::hgrn_chunked<true>(lds, bh, sg_, 16 * sg_, 16, Aq, Ak, Av, HGO, Alogf, Asg, args.in[3] + LAYER * HDIM, HS + (size_t)bh * 3 * HDIM * HDIM, HGm + bh * 3 * HDIM); }
#endif
            GRID_BAR();
            for (int u = blockIdx.x; u < BATCH * NHEAD * 4; u += G) { const int bh = u & 63, sg_ = u >> 6;
                hg::hgrn_chunked<false>(lds, bh, sg_, 16 * sg_, 16, Aq, Ak, Av, HGO, Alogf, Asg, args.in[3] + LAYER * HDIM, HS + (size_t)bh * 3 * HDIM * HDIM, HGm + bh * 3 * HDIM); }
#ifdef PROBE_REP_HG2
            __syncthreads();
            for (int u = blockIdx.x; u < BATCH * NHEAD * 4; u += G) { const int bh = u & 63, sg_ = u >> 6;
                hg::hgrn_chunked<false>(lds, bh, sg_, 16 * sg_, 16, Aq, Ak, Av, HGO, Alogf, Asg, args.in[3] + LAYER * HDIM, HS + (size_t)bh * 3 * HDIM * HDIM, HGm + bh * 3 * HDIM); }
#endif
        }
#endif
        GRID_BAR();
#ifndef DIS_G3
        {
            pg8::Gemm g{HGO, (const bf16*)(ws + WS_WA_OUT) + (size_t)LAYER * DM * DM, MROWS, DM, DM}; pg8::StaticOrder S; S.init(MROWS, DM, G, (int)blockIdx.x);
            pg8::EpiRes E{XB, nullptr, SS + (size_t)(ssi + 1) * MROWS, 1.0f, nullptr};
            pg8::gemm_phase<pg8::EpiRes, pg8::StaticOrder, true, true>(lds, g, S, E);
        }
#endif
    } else {
        bf16* KB = (bf16*)(ws + WS_R1); bf16* VB = (bf16*)(ws + WS_R1 + 192 * MiB);
        bf16* QO = (bf16*)(ws + WS_R2); bf16* OG = (bf16*)(ws + WS_OG); bf16* OC = (bf16*)(ws + WS_R2 + 192 * MiB); float* LSE = (float*)(ws + WS_R2 + 256 * MiB);
#ifndef DIS_G2
        {
            constexpr int N = LAYER == 2 ? 18432 : 6144;
            pg8::Gemm g{(const bf16*)(ws + WS_X8), LAYER == 2 ? (const bf16*)(ws + WS_WQKV2) : (const bf16*)(ws + WS_WQ3), MROWS, N, DM / 2}; pg8::StaticOrder S; S.init(MROWS, N, G, (int)blockIdx.x);
            pg8::EpiQkv E{QO, KB, VB, SS + (size_t)ssi * MROWS, args.in[11] + (LAYER - 2) * 3 * HDIM, args.in[8], (const _Float16*)(ws + WS_ROPE), 1.0f / (pg8::F8_XSCALE * pg8::F8_WSCALE)};
            pg8::gemm_phase<pg8::EpiQkv, pg8::StaticOrder, true, true, true>(lds, g, S, E);
#ifdef PROBE_REP_GEMM
            pg8::gemm_phase<pg8::EpiQkv, pg8::StaticOrder, true, true>(lds, g, S, E);
#endif
        }
#endif
        GRID_BAR();
#ifndef DIS_ATTN
#ifdef ATTN_OLD
        att::attn_phase((char*)lds_raw, QO, KB, VB, OG, LSE);
#else
        att2::attn_phase(lds, QO, KB, VB, OG, LSE);
#endif
#ifdef PROBE_REP_ATTN
        att2::attn_phase(lds, QO, KB, VB, OG, LSE);
#endif
#endif
        GRID_BAR();
#ifndef DIS_COMB
        combine_phase(OG, LSE, OC);
#endif
        GRID_BAR();
#ifndef DIS_G3
        {
            pg8::Gemm g{OC, (const bf16*)(ws + WS_WB_OUT) + (size_t)(LAYER - 2) * DM * DM, MROWS, DM, DM / 2}; pg8::StaticOrder S; S.init(MROWS, DM, G, (int)blockIdx.x);
            pg8::EpiRes E{XB, nullptr, SS + (size_t)(ssi + 1) * MROWS, 1.0f / (pg8::F8_XSCALE * pg8::F8_WSCALE), LAYER >= F8_FFN1_LAYER ? ws + WS_X8 : nullptr};
            pg8::gemm_phase<pg8::EpiRes, pg8::StaticOrder, true, true, true>(lds, g, S, E);
        }
#endif
    }
    GRID_BAR();
    bf16* HB = (bf16*)(ws + WS_R2);
#ifndef DIS_G4
    {
        constexpr bool I8I = LAYER >= I8_FFN1_LAYER;
        if constexpr (I8I) { int t_ = threadIdx.x; asm volatile("" : "+v"(t_)); quant_rows(XB, SS + (size_t)(ssi + 1) * MROWS, ws + WS_X8, (float*)(ws + WS_ASC), (int)blockIdx.x * NWAVES + (t_ >> 6), G * NWAVES, t_ & 63); GRID_BAR(); }
        constexpr bool F8I = !I8I && LAYER >= F8_FFN1_LAYER;
        pg8::Gemm g{(F8I || I8I) ? (const bf16*)(ws + WS_X8) : XB, (const bf16*)(ws + WS_WF_IN) + (size_t)LAYER * 2 * FFH * DM, MROWS, 2 * FFH, (F8I || I8I) ? DM / 2 : DM}; pg8::StaticOrder S; S.init(MROWS, 2 * FFH, G, (int)blockIdx.x);
#ifdef CONV_ALL_IN_PROLOGUE
        pg8::EpiFfn1 E{HB, FFH, SS + (size_t)(ssi + 1) * MROWS, (const pg8::ConvJob*)(ws + WS_JOBS), 3, LAYER >= F8_FIRST_LAYER && !I8_FFN2(LAYER), F8I ? 1.0f / (pg8::F8_XSCALE * pg8::F8_WSCALE) : 1.0f, I8I ? (const float*)(ws + WS_ASC) : nullptr, I8I ? (const float*)(ws + WS_WSC) + LAYER * 2 * FFH : nullptr};
#else
        pg8::EpiFfn1 E{HB, FFH, SS + (size_t)(ssi + 1) * MROWS, (const pg8::ConvJob*)(ws + WS_JOBS), LAYER, LAYER >= F8_FIRST_LAYER && !I8_FFN2(LAYER), F8I ? 1.0f / (pg8::F8_XSCALE * pg8::F8_WSCALE) : 1.0f, I8I ? (const float*)(ws + WS_ASC) : nullptr, I8I ? (const float*)(ws + WS_WSC) + LAYER * 2 * FFH : nullptr};
#endif
#ifdef PROBE_CLOCK
        const unsigned long long pc0 = clock64(), pw0 = wall_clock64();
#endif
        pg8::gemm_phase<pg8::EpiFfn1, pg8::StaticOrder, true, true, I8I ? 2 : (F8I ? 1 : 0)>(lds, g, S, E);
#ifdef PROBE_CLOCK
        if (LAYER == 0 && blockIdx.x == 0 && threadIdx.x == 0) { const unsigned long long dc = clock64() - pc0, dw = wall_clock64() - pw0;
            ((unsigned long long*)(ws + WS_CTL))[300] = dc; ((unsigned long long*)(ws + WS_CTL))[301] = dw; }
#endif
#ifdef PROBE_REP_GEMM
            pg8::gemm_phase<pg8::EpiFfn1, pg8::StaticOrder, true, true>(lds, g, S, E);
#endif
#ifdef PROBE_G4_L2RES
        { pg8::ProbeOrder00 S0; S0.init(MROWS, 2 * FFH, G, (int)blockIdx.x); pg8::Gemm gp{XB, g.Bt, MROWS, 2 * FFH, PROBE_G4_L2RES}; pg8::EpiFfn1 Ep{(bf16*)(ws + WS_OG), FFH, E.ss, E.jobs, 3, 0, 1.0f, nullptr, nullptr};
          pg8::gemm_phase<pg8::EpiFfn1, pg8::ProbeOrder00, true, true>(lds, gp, S0, Ep); }
#endif
    }
#endif
    GRID_BAR();
#ifndef DIS_G5
    {
        constexpr bool I8O = I8_FFN2(LAYER);
        if constexpr (I8O) { int t_ = threadIdx.x; asm volatile("" : "+v"(t_)); quant_rows<11>(HB, nullptr, ws + WS_OG, (float*)(ws + WS_ASC2), (int)blockIdx.x * NWAVES + (t_ >> 6), G * NWAVES, t_ & 63); GRID_BAR(); }
        constexpr bool F8L = !I8O && LAYER >= F8_FIRST_LAYER;
        pg8::Gemm g{I8O ? (const bf16*)(ws + WS_OG) : HB, (const bf16*)(ws + WS_WF_OUT) + (size_t)LAYER * DM * FFH, MROWS, DM, (F8L || I8O) ? FFH / 2 : FFH}; pg8::StaticOrder S; S.init(MROWS, DM, G, (int)blockIdx.x);
        if constexpr (I8O) {
            pg8::EpiResI8 E{XB, LAYER == 3 ? out : nullptr, SS + (size_t)(ssi + 2) * MROWS, 1.0f, (LAYER == 1 || LAYER == 2) ? ws + WS_X8 : nullptr, (const float*)(ws + WS_ASC2), (const float*)(ws + WS_WSC2) + LAYER * DM};
            pg8::gemm_phase<pg8::EpiResI8, pg8::StaticOrder, true, true, 2>(lds, g, S, E);
        } else {
            pg8::EpiRes E{XB, LAYER == 3 ? out : nullptr, SS + (size_t)(ssi + 2) * MROWS, F8L ? 1.0f / (pg8::F8_HSCALE * pg8::F8_WSCALE) : 1.0f, (LAYER == 1 || LAYER == 2) ? ws + WS_X8 : nullptr};
            pg8::gemm_phase<pg8::EpiRes, pg8::StaticOrder, true, true, F8L ? 1 : 0>(lds, g, S, E);
        }
    }
#endif
    if constexpr (LAYER < 3) GRID_BAR();
}

__global__ void __launch_bounds__(NWAVES * 64, 2) yoco_fwd(Args args) {
    extern __shared__ __attribute__((aligned(16))) unsigned char lds_raw[];
    LAS unsigned char* lds = (LAS unsigned char*)lds_raw;
    const int tid = threadIdx.x;
    volatile LAS unsigned* MISC = (volatile LAS unsigned*)(lds + MISC_OFF);
    if (tid < 64) MISC[tid] = 0u;
    __syncthreads();
    XcdBarrier bar = xcd_barrier_post((unsigned*)(args.ws + WS_CTL) + CW_BAR, MISC + 8);
    if constexpr (I8_FFN1_LAYER < 4) { wmax_pass(args, (int)blockIdx.x * NWAVES + (tid >> 6), (int)gridDim.x * NWAVES, tid & 63); GRID_BAR(); }
#ifndef DIS_PRO
    { const int lane = tid & 63, wave = __builtin_amdgcn_readfirstlane(tid >> 6), G = gridDim.x;
      const int vcu = (G % 8 == 0) ? ((int)blockIdx.x % 8) * (G / 8) + (int)blockIdx.x / 8 : (int)blockIdx.x;
      prologue(args, lds, vcu * NWAVES + wave, G * NWAVES, lane, wave);
#ifdef PROBE_REP_PRO
      prologue(args, lds, vcu * NWAVES + wave, G * NWAVES, lane, wave);
#endif
    }
#endif
    GRID_BAR();
#ifndef ONLY_LAYER
    layer_phases<0>(args, lds, lds_raw, bar);
    layer_phases<1>(args, lds, lds_raw, bar);
    layer_phases<2>(args, lds, lds_raw, bar);
    layer_phases<3>(args, lds, lds_raw, bar);
#else
    layer_phases<ONLY_LAYER>(args, lds, lds_raw, bar);
#endif
#ifdef PROBE_CLOCK
    if (blockIdx.x == 0 && threadIdx.x == 0) {
        const unsigned long long dc = ((volatile unsigned long long*)(args.ws + WS_CTL))[300], dw = ((volatile unsigned long long*)(args.ws + WS_CTL))[301];
        const unsigned long long ticks = dw ? (dc * 10000ull) / dw : 0ull, t0 = wall_clock64();
        while (wall_clock64() - t0 < ticks) __builtin_amdgcn_s_sleep(8);
    }
#endif
}

extern "C" void kernel_launch(void* const* d_in, const int* in_sizes, int n_in, void* d_out, int out_size, void* d_ws, size_t ws_size, hipStream_t stream) {
    static int grid = 0;
    if (grid == 0) {
        if (n_in != 16 || out_size != MROWS * DM || ws_size < WS_END) { fprintf(stderr, "kernel_launch: unexpected shapes (n_in %d out %d ws %zu)\n", n_in, out_size, ws_size); grid = -1; return; }
        int dev = 0, cus = 0, per_cu = 0;
        if (hipGetDevice(&dev) != hipSuccess || hipDeviceGetAttribute(&cus, hipDeviceAttributeMultiprocessorCount, dev) != hipSuccess) { grid = -1; return; }
        if (hipFuncSetAttribute((const void*)yoco_fwd, hipFuncAttributeMaxDynamicSharedMemorySize, LDS_BYTES) != hipSuccess) { fprintf(stderr, "kernel_launch: hipFuncSetAttribute failed\n"); grid = -1; return; }
        if (hipOccupancyMaxActiveBlocksPerMultiprocessor(&per_cu, (const void*)yoco_fwd, NWAVES * 64, LDS_BYTES) != hipSuccess || per_cu < 1) { fprintf(stderr, "kernel_launch: occupancy query says %d\n", per_cu); }
        (void)hipGetLastError();
        grid = cus;
    }
    if (grid < 0) return;
    (void)hipMemsetAsync((char*)d_ws + WS_CTL, 0, CTL_ZERO_BYTES, stream);
    Args a{};
    for (int i = 0; i < 16; ++i) a.in[i] = (const float*)d_in[i];
    a.out = (float*)d_out; a.ws = (unsigned char*)d_ws;
    hipLaunchKernelGGL(yoco_fwd, dim3(grid), dim3(NWAVES * 64), LDS_BYTES, stream, a);
}
```

```cpp
#define CONV_ALL_IN_PROLOGUE 1
#include <hip/hip_runtime.h>
#include <cstdio>
#include <cstdint>
namespace pg8 {
#define PG8_LAS __attribute__((address_space(3)))
typedef unsigned short bf16_t;
typedef short bf16x8 __attribute__((ext_vector_type(8)));
typedef float f32x4 __attribute__((ext_vector_type(4)));
typedef unsigned u32x4 __attribute__((ext_vector_type(4)));
typedef int i32x4 __attribute__((ext_vector_type(4)));
typedef int i32x8 __attribute__((ext_vector_type(8)));
constexpr int BM = 256, BK = 64, HALF = 128, HTB = HALF * BK * 2  , STAGE_BYTES = 8 * HTB, NXCD = 8, WGM = 8;

__host__ __device__ __forceinline__ int lds_byte(int r, int c) { const int st = (r >> 4) * 2 + (c >> 5), rr = r & 15, cc = c & 31, ob = rr * 64 + cc * 2; return st * 1024 + (ob ^ (((ob >> 9) & 1) << 5)); }
__host__ __device__ __forceinline__ void stage_rc(int b, int& R, int& C) { const int st = b / 1024, sb = b % 1024, swz = sb ^ (((sb >> 9) & 1) << 5); R = (st >> 1) * 16 + swz / 64; C = (st & 1) * 32 + (swz % 64) / 2; }
__host__ __device__ __forceinline__ int perm32(int rho) { const int n = rho >> 4, i = rho & 15; return 8 * (i >> 2) + 4 * n + (i & 3); }

struct Unit { int pm, pn; };
struct Gemm { const bf16_t* A; const bf16_t* Bt; int M, N, K; };

struct StaticOrder {
    int nM, nN, nwg, G, c;
    __host__ __device__ void init(int M, int N, int G_, int c_) { nM = M / BM; nN = N / BM; nwg = nM * nN; G = G_; c = c_; }
    __host__ __device__ bool next(int i, Unit& u) const {
        const long L = (long)i * G + c; if (L >= nwg) return false;
        int wgid = (int)L; { const int q = nwg / NXCD, r = nwg % NXCD, xcd = wgid % NXCD, off = wgid / NXCD; wgid = (xcd < r ? xcd * (q + 1) : r * (q + 1) + (xcd - r) * q) + off; }
        const int nig = WGM * nN, gid = wgid / nig, fm = gid * WGM, gsz = (nM - fm) < WGM ? (nM - fm) : WGM;
        u.pm = fm + ((wgid % nig) % gsz); u.pn = (wgid % nig) / gsz; return true;
    }
    __device__ __forceinline__ void a_ready(const Unit&) const {}
    __device__ __forceinline__ void done(const Unit&) const {}
};
struct ProbeOrder00 : StaticOrder {
    __host__ __device__ bool next(int i, Unit& u) const { const long L = (long)i * G + c; if (L >= nwg) return false; u.pm = 0; u.pn = 0; return true; }
};
__device__ __forceinline__ i32x8 cat8(const bf16x8 a, const bf16x8 b) { const i32x4 x = __builtin_bit_cast(i32x4, a), y = __builtin_bit_cast(i32x4, b); return __builtin_shufflevector(x, y, 0, 1, 2, 3, 4, 5, 6, 7); }
constexpr float F8_HSCALE = 8.0f, F8_XSCALE = 16.0f, F8_WSCALE = 512.0f, F8_MAX = 448.0f;
__device__ __forceinline__ unsigned cvt4_fp8(float a, float b, float c, float d, float s) {
    int w = 0;
    w = __builtin_amdgcn_cvt_pk_fp8_f32(__builtin_amdgcn_fmed3f(a * s, -F8_MAX, F8_MAX), __builtin_amdgcn_fmed3f(b * s, -F8_MAX, F8_MAX), w, false);
    w = __builtin_amdgcn_cvt_pk_fp8_f32(__builtin_amdgcn_fmed3f(c * s, -F8_MAX, F8_MAX), __builtin_amdgcn_fmed3f(d * s, -F8_MAX, F8_MAX), w, true);
    return (unsigned)w; }
__device__ __forceinline__ unsigned cvt_pk_bf16(float lo, float hi) { unsigned r; asm volatile("v_cvt_pk_bf16_f32 %0, %1, %2" : "=v"(r) : "v"(lo), "v"(hi)); return r; }
template <class Epi, class Sched, bool ALIGN_EPI = false, bool SP2 = false, int QM = 0>
__device__ __forceinline__ void gemm_phase(PG8_LAS unsigned char* lds, const Gemm g, const Sched& S, const Epi& E) {
    int tid_ = threadIdx.x; asm volatile("" : "+v"(tid_));
    const int tid = tid_, wid = __builtin_amdgcn_readfirstlane(tid >> 6), lane = tid & 63, wr = wid >> 2, wc = wid & 3, fr = lane & 15, fq = lane >> 4;
    const int K = g.K, nt = K / BK;
    unsigned voffA[2], voffB[2];
#pragma unroll
    for (int i = 0; i < 2; ++i) { int R, C; stage_rc(tid * 16 + i * 8192, R, C); const int Rb = Epi::PERM ? ((R & ~31) + perm32(R & 31)) : R;
        voffA[i] = (unsigned)(R * K + C) * 2u; voffB[i] = (unsigned)(Rb * K + C) * 2u; }
    const size_t kstep = (size_t)(BK * 2);
    const size_t hstep = (size_t)HALF * K * 2;
    const size_t tstep = 2 * hstep;
    const unsigned ldsw = (unsigned)wid * 1024u;
    const int aoff = lds_byte(wr * 64 + fr, fq * 8), boff = lds_byte(wc * 32 + fr, fq * 8);
#define PG8_SA(b, h) (((b) * 2 + (h)) * HTB)
#define PG8_SB(b, h) ((4 + (b) * 2 + (h)) * HTB)
#define PG8_STAGE(bufoff, gbase, voff) do { _Pragma("unroll") for (int _i = 0; _i < 2; ++_i) \
        __builtin_amdgcn_global_load_lds((const unsigned*)((const char*)(gbase) + (voff)[_i]), (PG8_LAS unsigned*)(lds + (bufoff) + ldsw + _i * 8192), 16, 0, 0); } while (0)
#define PG8_LDA(dst, b, h) do { _Pragma("unroll") for (int m = 0; m < 4; ++m) _Pragma("unroll") for (int k = 0; k < 2; ++k) dst[m][k] = *(const PG8_LAS bf16x8*)(lds + PG8_SA(b, h) + aoff + m * 2048 + k * 1024); } while (0)
#define PG8_LDB(dst, b, h) do { _Pragma("unroll") for (int n = 0; n < 2; ++n) _Pragma("unroll") for (int k = 0; k < 2; ++k) dst[n][k] = *(const PG8_LAS bf16x8*)(lds + PG8_SB(b, h) + boff + n * 2048 + k * 1024); } while (0)
#define PG8_MMA(ai, bj, At, Bt) do { __builtin_amdgcn_s_setprio(1); _Pragma("unroll") for (int m = 0; m < 4; ++m) _Pragma("unroll") for (int n = 0; n < 2; ++n) { \
        if constexpr (QM == 1) { const i32x8 b8_ = cat8(Bt[n][0], Bt[n][1]), a8_ = cat8(At[m][0], At[m][1]); asm volatile("v_mfma_f32_16x16x128_f8f6f4 %0, %1, %2, %0" : "+v"(acc[ai][bj][m][n]) : "v"(b8_), "v"(a8_)); } \
        else if constexpr (QM == 2) { _Pragma("unroll") for (int k = 0; k < 2; ++k) acc[ai][bj][m][n] = __builtin_bit_cast(f32x4, __builtin_amdgcn_mfma_i32_16x16x64_i8(__builtin_bit_cast(i32x4, Bt[n][k]), __builtin_bit_cast(i32x4, At[m][k]), __builtin_bit_cast(i32x4, acc[ai][bj][m][n]), 0, 0, 0)); } \
        else { _Pragma("unroll") for (int k = 0; k < 2; ++k) acc[ai][bj][m][n] = __builtin_amdgcn_mfma_f32_16x16x32_bf16(Bt[n][k], At[m][k], acc[ai][bj][m][n], 0, 0, 0); } } __builtin_amdgcn_s_setprio(0); } while (0)
#define PG8_WAIT_V(n) asm volatile("s_waitcnt vmcnt(" #n ")" ::: "memory")
#define PG8_WAIT_L(n) asm volatile("s_waitcnt lgkmcnt(" #n ")" ::: "memory")
#define PG8_BAR __builtin_amdgcn_s_barrier()
#define PG8_SCHED __builtin_amdgcn_sched_barrier(0)
    Unit cur, nxt; int ui = 0;
    if (!S.next(0, cur)) return;
    f32x4 acc[2][2][4][2];
    unsigned pre[8];
#pragma unroll
    for (int a = 0; a < 2; ++a)
#pragma unroll
        for (int b = 0; b < 2; ++b)
#pragma unroll
            for (int m = 0; m < 4; ++m)
#pragma unroll
                for (int n = 0; n < 2; ++n) acc[a][b][m][n] = (f32x4){0.f, 0.f, 0.f, 0.f};
    bf16x8 At[4][2], B0[2][2], B1[2][2];
    const char* cA = (const char*)g.A + (size_t)cur.pm * tstep; const char* cB = (const char*)g.Bt + (size_t)cur.pn * tstep;
    S.a_ready(cur);
    if constexpr (SP2) {
        PG8_STAGE(PG8_SB(0, 0), cB, voffB); PG8_STAGE(PG8_SB(0, 1), cB + hstep, voffB); PG8_STAGE(PG8_SA(0, 0), cA, voffA); PG8_STAGE(PG8_SA(0, 1), cA + hstep, voffA);
        if (wr == 1) PG8_BAR;
        PG8_WAIT_V(2); PG8_BAR;
        PG8_STAGE(PG8_SB(1, 0), cB + kstep, voffB); PG8_STAGE(PG8_SA(1, 0), cA + kstep, voffA); PG8_STAGE(PG8_SB(1, 1), cB + hstep + kstep, voffB);
        PG8_WAIT_V(6); PG8_BAR;
    } else {
        PG8_STAGE(PG8_SB(0, 0), cB, voffB); PG8_STAGE(PG8_SA(0, 0), cA, voffA); PG8_STAGE(PG8_SB(0, 1), cB + hstep, voffB); PG8_STAGE(PG8_SA(0, 1), cA + hstep, voffA);
        if (wr == 1) PG8_BAR;
        PG8_WAIT_V(4); PG8_BAR;
        PG8_STAGE(PG8_SB(1, 0), cB + kstep, voffB); PG8_STAGE(PG8_SA(1, 0), cA + kstep, voffA); PG8_STAGE(PG8_SB(1, 1), cB + hstep + kstep, voffB);
        PG8_WAIT_V(6); PG8_BAR;
    }
    for (;;) {
        const bool has_next = S.next(ui + 1, nxt);
        const char* nA = has_next ? (const char*)g.A + (size_t)nxt.pm * tstep : cA; const char* nB = has_next ? (const char*)g.Bt + (size_t)nxt.pn * tstep : cB;
        for (int t = 0; t < nt; t += 2) {
            const bool last = (t == nt - 2);
            const char* a1 = cA + (size_t)(t + 1) * kstep;
            const char* a2 = last ? nA : cA + (size_t)(t + 2) * kstep; const char* b2 = last ? nB : cB + (size_t)(t + 2) * kstep;
            const char* a3 = a2 + kstep; const char* b3 = b2 + kstep;
            if (last && has_next) S.a_ready(nxt);
            if (last) { E.prefetch(cur, wr, fr, pre); E.prefetch_lds(cur, wid, lane, lds); }
            if constexpr (SP2) {
            PG8_LDB(B0, 0, 0); PG8_LDB(B1, 0, 1); PG8_SCHED; PG8_LDA(At, 0, 0); PG8_STAGE(PG8_SA(1, 1), a1 + hstep, voffA);
            PG8_WAIT_V(8); PG8_WAIT_L(0); PG8_BAR; PG8_MMA(0, 0, At, B0); PG8_MMA(0, 1, At, B1); PG8_BAR; PG8_SCHED;
            PG8_LDA(At, 0, 1); PG8_STAGE(PG8_SB(0, 0), b2, voffB); PG8_STAGE(PG8_SB(0, 1), b2 + hstep, voffB); PG8_STAGE(PG8_SA(0, 0), a2, voffA);
            PG8_WAIT_V(8); PG8_WAIT_L(0); PG8_BAR; PG8_MMA(1, 0, At, B0); PG8_MMA(1, 1, At, B1); PG8_BAR; PG8_SCHED;
            PG8_LDB(B0, 1, 0); PG8_LDB(B1, 1, 1); PG8_SCHED; PG8_LDA(At, 1, 0); PG8_STAGE(PG8_SA(0, 1), a2 + hstep, voffA);
            PG8_WAIT_V(8); PG8_WAIT_L(0); PG8_BAR; PG8_MMA(0, 0, At, B0); PG8_MMA(0, 1, At, B1); PG8_BAR; PG8_SCHED;
            PG8_LDA(At, 1, 1); PG8_STAGE(PG8_SB(1, 0), b3, voffB); PG8_STAGE(PG8_SB(1, 1), b3 + hstep, voffB); PG8_STAGE(PG8_SA(1, 0), a3, voffA);
            PG8_WAIT_V(8); PG8_WAIT_L(0); PG8_BAR; PG8_MMA(1, 0, At, B0); PG8_MMA(1, 1, At, B1); PG8_BAR; PG8_SCHED;
            } else {
            PG8_LDB(B0, 0, 0); PG8_SCHED; PG8_LDA(At, 0, 0); PG8_STAGE(PG8_SA(1, 1), a1 + hstep, voffA);
            PG8_WAIT_L(8); PG8_BAR; PG8_WAIT_L(0); PG8_MMA(0, 0, At, B0); PG8_BAR; PG8_SCHED;
            PG8_LDB(B1, 0, 1); PG8_STAGE(PG8_SB(0, 0), b2, voffB);
            PG8_BAR; PG8_WAIT_L(0); PG8_MMA(0, 1, At, B1); PG8_BAR;
            PG8_LDA(At, 0, 1); PG8_STAGE(PG8_SA(0, 0), a2, voffA);
            PG8_BAR; PG8_WAIT_L(0); PG8_MMA(1, 0, At, B0); PG8_BAR; PG8_SCHED;
            PG8_STAGE(PG8_SB(0, 1), b2 + hstep, voffB);
            PG8_WAIT_V(6); PG8_BAR; PG8_MMA(1, 1, At, B1); PG8_BAR;
            PG8_LDB(B0, 1, 0); PG8_SCHED; PG8_LDA(At, 1, 0); PG8_STAGE(PG8_SA(0, 1), a2 + hstep, voffA);
            PG8_WAIT_L(8); PG8_BAR; PG8_WAIT_L(0); PG8_MMA(0, 0, At, B0); PG8_BAR; PG8_SCHED;
            PG8_LDB(B1, 1, 1); PG8_STAGE(PG8_SB(1, 0), b3, voffB);
            PG8_BAR; PG8_WAIT_L(0); PG8_MMA(0, 1, At, B1); PG8_BAR;
            PG8_LDA(At, 1, 1); PG8_STAGE(PG8_SA(1, 0), a3, voffA);
            PG8_BAR; PG8_WAIT_L(0); PG8_MMA(1, 0, At, B0); PG8_BAR; PG8_SCHED;
            PG8_STAGE(PG8_SB(1, 1), b3 + hstep, voffB);
            PG8_WAIT_V(6); PG8_BAR; PG8_MMA(1, 1, At, B1); PG8_BAR;
            }
        }
        if constexpr (QM == 1) asm volatile("s_nop 15\n\ts_nop 15\n\ts_nop 7" ::: "memory");
        if constexpr (ALIGN_EPI) { if (wr == 0) PG8_BAR; }
        E(acc, cur, wr, wc, fr, fq, lds, pre, ui);
        if (!has_next) break;
#pragma unroll
        for (int a = 0; a < 2; ++a)
#pragma unroll
            for (int b = 0; b < 2; ++b)
#pragma unroll
                for (int m = 0; m < 4; ++m)
#pragma unroll
                    for (int n = 0; n < 2; ++n) acc[a][b][m][n] = (f32x4){0.f, 0.f, 0.f, 0.f};
        cur = nxt; cA = nA; cB = nB; ++ui;
        if constexpr (ALIGN_EPI) { if (wr == 1) PG8_BAR; }
    }
    PG8_WAIT_V(0);
    if constexpr (!ALIGN_EPI) { if (wr == 0) PG8_BAR; }
    PG8_BAR;
#undef PG8_SA
#undef PG8_SB
#undef PG8_STAGE
#undef PG8_LDA
#undef PG8_LDB
#undef PG8_MMA
#undef PG8_WAIT_V
#undef PG8_WAIT_L
#undef PG8_BAR
#undef PG8_SCHED
}
}
namespace pg8 {
constexpr int DMODEL = 2048;
constexpr float RMS_EPS = 1e-6f;
__device__ __forceinline__ float fast_exp(float x) { return __builtin_amdgcn_exp2f(x * 1.4426950408889634f); }
__device__ __forceinline__ float fast_log(float x) { return __builtin_amdgcn_logf(x) * 0.6931471805599453f; }
__device__ __forceinline__ float fast_rcp(float x) { return __builtin_amdgcn_rcpf(x); }
__device__ __forceinline__ float silu_f(float v) { return v * fast_rcp(1.0f + fast_exp(-v)); }
__device__ __forceinline__ u32x4 pack8_bf16(const f32x4 a, const f32x4 b) { u32x4 w; w.x = cvt_pk_bf16(a[0], a[1]); w.y = cvt_pk_bf16(a[2], a[3]); w.z = cvt_pk_bf16(b[0], b[1]); w.w = cvt_pk_bf16(b[2], b[3]); return w; }
typedef unsigned ssq_t;
constexpr float SS_SCALE = 1024.0f;
__device__ __forceinline__ float ss_to_rs(ssq_t v) { return __builtin_amdgcn_rsqf((float)v * (1.0f / (SS_SCALE * DMODEL)) + RMS_EPS); }
__device__ __forceinline__ void ss_prefetch(unsigned (&pre)[8], const ssq_t* ss, int row0) {
#pragma unroll
    for (int i = 0; i < 8; ++i) pre[i] = ss[row0 + (i >> 2) * HALF + (i & 3) * 16];
}
__device__ __forceinline__ void row_scales(float (&rs)[2][4], const unsigned (&pre)[8]) {
#pragma unroll
    for (int ai = 0; ai < 2; ++ai)
#pragma unroll
        for (int m = 0; m < 4; ++m) rs[ai][m] = ss_to_rs(pre[ai * 4 + m]);
}

typedef _Float16 f16x2_t __attribute__((ext_vector_type(2)));
typedef float f32x2e __attribute__((ext_vector_type(2)));
__device__ __forceinline__ unsigned pk_f16(float lo, float hi) { const f32x2e v = {lo, hi}; const f16x2_t h = __builtin_convertvector(v, f16x2_t); return __builtin_bit_cast(unsigned, h); }
__device__ __forceinline__ void fz_one(float z, float l, float& k, float& logf) {
    const float e = fast_exp(-__builtin_fabsf(z)), inv = fast_rcp(1.0f + e), sm = e * inv;
    const float sig = z >= 0.f ? inv : sm, nsig = z >= 0.f ? sm : inv;
    k = (1.0f - l) * nsig; logf = fast_log(l + (1.0f - l) * sig);
}

constexpr int QKV_SCR_OFF_FWD = 131072;
struct EpiHgrnIn {
    static constexpr bool PERM = true, AFTER_DRAIN = false;
    __device__ __forceinline__ void prefetch(const Unit& u, int wr, int fr, unsigned (&pre)[8]) const { ss_prefetch(pre, ss, u.pm * BM + wr * 64 + fr); }
    __device__ __forceinline__ void prefetch_lds(const Unit&, int, int, PG8_LAS unsigned char*) const {}
    bf16_t* QKVG; float* LOGF; const ssq_t* ss; const float* lb;
    static constexpr size_t TSTRIDE = (size_t)16384 * DMODEL;
    __device__ __forceinline__ void operator()(const f32x4 (&acc)[2][2][4][2], const Unit& u, int wr, int wc, int fr, int fq, PG8_LAS unsigned char*, const unsigned (&pre)[8], int ui) const {
        const int row0 = u.pm * BM + wr * 64 + fr, type = u.pn >> 3, col0 = (u.pn & 7) * BM + wc * 32 + 8 * fq, hd0 = (u.pn & 7) * 2, dcol = wc * 32 + 8 * fq;
        float rsv[2][4]; row_scales(rsv, pre);
        if (type == 1) {
#pragma unroll
            for (int bj = 0; bj < 2; ++bj) { const f32x4 lb0 = *(const f32x4*)(lb + col0 + bj * HALF), lb1 = *(const f32x4*)(lb + col0 + bj * HALF + 4);
#pragma unroll
                for (int ai = 0; ai < 2; ++ai)
#pragma unroll
                    for (int m = 0; m < 4; ++m) { const int row = row0 + ai * HALF + m * 16; const size_t off = ((size_t)((row >> 12) * 16 + hd0 + bj) * 4096 + (row & 4095)) * 128 + dcol;
                        const float rs = rsv[ai][m]; f32x4 lf0, lf1, kk0, kk1;
#pragma unroll
                        for (int j = 0; j < 4; ++j) { float ka, la, kb, lb_; fz_one(acc[ai][bj][m][0][j] * rs, lb0[j], ka, la); fz_one(acc[ai][bj][m][1][j] * rs, lb1[j], kb, lb_); lf0[j] = la; lf1[j] = lb_; kk0[j] = ka; kk1[j] = kb; }
#ifdef HG_STORE_K
                        *(u32x4*)(QKVG + TSTRIDE + off) = pack8_bf16(kk0, kk1);
#endif
                        *(f32x4*)(LOGF + off) = lf0; *(f32x4*)(LOGF + off + 4) = lf1;
                        asm volatile("" ::: "memory"); } }
        } else {
            bf16_t* dst = QKVG + (size_t)(type == 0 ? 0 : type) * TSTRIDE;
#pragma unroll
            for (int ai = 0; ai < 2; ++ai)
#pragma unroll
                for (int m = 0; m < 4; ++m) { const int row = row0 + ai * HALF + m * 16; const size_t off = ((size_t)((row >> 12) * 16 + hd0) * 4096 + (row & 4095)) * 128 + dcol;
                    const float rs = rsv[ai][m];
#pragma unroll
                    for (int bj = 0; bj < 2; ++bj) { f32x4 v0 = acc[ai][bj][m][0] * rs, v1 = acc[ai][bj][m][1] * rs;
                        if (type == 3) {
#pragma unroll
                            for (int j = 0; j < 4; ++j) { v0[j] = silu_f(v0[j]); v1[j] = silu_f(v1[j]); } }
                        *(u32x4*)(dst + off + (size_t)bj * (4096 * 128)) = pack8_bf16(v0, v1); }
                    asm volatile("" ::: "memory"); }
        }
    }
};

struct EpiRes {
    static constexpr bool PERM = true, AFTER_DRAIN = false;
    bf16_t* xb; float* out; ssq_t* ssn; float ascale; unsigned char* x8;
    __device__ __forceinline__ void prefetch(const Unit&, int, int, unsigned (&)[8]) const {}
    __device__ __forceinline__ void prefetch_lds(const Unit&, int, int, PG8_LAS unsigned char*) const {}
    __device__ __forceinline__ void operator()(const f32x4 (&acc)[2][2][4][2], const Unit& u, int wr, int wc, int fr, int fq, PG8_LAS unsigned char*, const unsigned (&pre)[8], int ui) const {
        const int row0 = u.pm * BM + wr * 64 + fr, col0 = u.pn * BM + wc * 32 + 8 * fq;
#pragma unroll
        for (int ai = 0; ai < 2; ++ai) {
            u32x4 rv[4][2];
#pragma unroll
            for (int m = 0; m < 4; ++m) { const size_t off = (size_t)(row0 + ai * HALF + m * 16) * DMODEL + col0;
#pragma unroll
                for (int bj = 0; bj < 2; ++bj) rv[m][bj] = *(const u32x4*)(xb + off + bj * HALF); }
            asm volatile("" ::: "memory");
#pragma unroll
            for (int m = 0; m < 4; ++m) { const int row = row0 + ai * HALF + m * 16; const size_t off = (size_t)row * DMODEL + col0; float s = 0.f;
#pragma unroll
                for (int bj = 0; bj < 2; ++bj) { const u32x4 r = rv[m][bj];
                    const f32x4 r0 = {__uint_as_float(r.x << 16), __uint_as_float(r.x & 0xffff0000u), __uint_as_float(r.y << 16), __uint_as_float(r.y & 0xffff0000u)};
                    const f32x4 r1 = {__uint_as_float(r.z << 16), __uint_as_float(r.z & 0xffff0000u), __uint_as_float(r.w << 16), __uint_as_float(r.w & 0xffff0000u)};
                    const f32x4 x0 = acc[ai][bj][m][0] * ascale + r0, x1 = acc[ai][bj][m][1] * ascale + r1;
                    if (out) { *(f32x4*)(out + off + bj * HALF) = x0; *(f32x4*)(out + off + bj * HALF + 4) = x1; }
                    else { *(u32x4*)(xb + off + bj * HALF) = pack8_bf16(x0, x1);
                        if (x8) { typedef unsigned u32x2_ __attribute__((ext_vector_type(2))); *(u32x2_*)(x8 + off + bj * HALF) = (u32x2_){cvt4_fp8(x0[0], x0[1], x0[2], x0[3], F8_XSCALE), cvt4_fp8(x1[0], x1[1], x1[2], x1[3], F8_XSCALE)}; }
                        s += (x0[0] * x0[0] + x0[1] * x0[1]) + (x0[2] * x0[2] + x0[3] * x0[3]) + (x1[0] * x1[0] + x1[1] * x1[1]) + (x1[2] * x1[2] + x1[3] * x1[3]); } }
                if (!out) { s += __shfl_xor(s, 16); s += __shfl_xor(s, 32);
                    if (fq == 0) atomicAdd(ssn + row, (ssq_t)(s * SS_SCALE + 0.5f)); } }
            asm volatile("" ::: "memory");
        }
    }
};

struct EpiResI8 {
    static constexpr bool PERM = true, AFTER_DRAIN = false;
    bf16_t* xb; float* out; ssq_t* ssn; float ascale; unsigned char* x8; const float* asc; const float* wsc;
    __device__ __forceinline__ void prefetch_lds(const Unit&, int, int, PG8_LAS unsigned char*) const {}
    __device__ __forceinline__ void prefetch(const Unit& u, int wr, int fr, unsigned (&pre)[8]) const {
        if (asc) { const int row0 = u.pm * BM + wr * 64 + fr;
#pragma unroll
            for (int i = 0; i < 8; ++i) pre[i] = __builtin_bit_cast(unsigned, asc[row0 + (i >> 2) * HALF + (i & 3) * 16]); } }
    __device__ __forceinline__ void operator()(const f32x4 (&acc)[2][2][4][2], const Unit& u, int wr, int wc, int fr, int fq, PG8_LAS unsigned char*, const unsigned (&pre)[8], int ui) const {
        const int row0 = u.pm * BM + wr * 64 + fr, col0 = u.pn * BM + wc * 32 + 8 * fq;
#pragma unroll
        for (int ai = 0; ai < 2; ++ai) {
            f32x4 cs[2][2] = {{{0.f, 0.f, 0.f, 0.f}, {0.f, 0.f, 0.f, 0.f}}, {{0.f, 0.f, 0.f, 0.f}, {0.f, 0.f, 0.f, 0.f}}};
            if (asc) {
#pragma unroll
                for (int bj = 0; bj < 2; ++bj) { cs[bj][0] = *(const f32x4*)(wsc + col0 + bj * HALF); cs[bj][1] = *(const f32x4*)(wsc + col0 + bj * HALF + 4); } }
            u32x4 rv[4][2];
#pragma unroll
            for (int m = 0; m < 4; ++m) { const size_t off = (size_t)(row0 + ai * HALF + m * 16) * DMODEL + col0;
#pragma unroll
                for (int bj = 0; bj < 2; ++bj) rv[m][bj] = *(const u32x4*)(xb + off + bj * HALF); }
            asm volatile("" ::: "memory");
#pragma unroll
            for (int m = 0; m < 4; ++m) { const int row = row0 + ai * HALF + m * 16; const size_t off = (size_t)row * DMODEL + col0; float s = 0.f;
#pragma unroll
                for (int bj = 0; bj < 2; ++bj) { const u32x4 r = rv[m][bj];
                    const f32x4 r0 = {__uint_as_float(r.x << 16), __uint_as_float(r.x & 0xffff0000u), __uint_as_float(r.y << 16), __uint_as_float(r.y & 0xffff0000u)};
                    const f32x4 r1 = {__uint_as_float(r.z << 16), __uint_as_float(r.z & 0xffff0000u), __uint_as_float(r.w << 16), __uint_as_float(r.w & 0xffff0000u)};
                    f32x4 a0 = acc[ai][bj][m][0], a1 = acc[ai][bj][m][1];
                    if (asc) { const float ra = __builtin_bit_cast(float, pre[ai * 4 + m]);
                        a0 = __builtin_convertvector(__builtin_bit_cast(i32x4, a0), f32x4) * (cs[bj][0] * ra); a1 = __builtin_convertvector(__builtin_bit_cast(i32x4, a1), f32x4) * (cs[bj][1] * ra); }
                    else { a0 = a0 * ascale; a1 = a1 * ascale; }
                    const f32x4 x0 = a0 + r0, x1 = a1 + r1;
                    if (out) { *(f32x4*)(out + off + bj * HALF) = x0; *(f32x4*)(out + off + bj * HALF + 4) = x1; }
                    else { *(u32x4*)(xb + off + bj * HALF) = pack8_bf16(x0, x1);
                        if (x8) { typedef unsigned u32x2_ __attribute__((ext_vector_type(2))); *(u32x2_*)(x8 + off + bj * HALF) = (u32x2_){cvt4_fp8(x0[0], x0[1], x0[2], x0[3], F8_XSCALE), cvt4_fp8(x1[0], x1[1], x1[2], x1[3], F8_XSCALE)}; }
                        s += (x0[0] * x0[0] + x0[1] * x0[1]) + (x0[2] * x0[2] + x0[3] * x0[3]) + (x1[0] * x1[0] + x1[1] * x1[1]) + (x1[2] * x1[2] + x1[3] * x1[3]); } }
                if (!out) { s += __shfl_xor(s, 16); s += __shfl_xor(s, 32);
                    if (fq == 0) atomicAdd(ssn + row, (ssq_t)(s * SS_SCALE + 0.5f)); } }
            asm volatile("" ::: "memory");
        }
    }
};

struct ConvJob { const float* W; const float* gain; unsigned short* dst; int K, N, mode, rowoff; };
__device__ __forceinline__ void conv_item_reg(const ConvJob& J, int item, int lane) {
    const int nblk = J.N >> 6, kb = item / nblk, nb = item - kb * nblk, k0 = 64 * kb, n0 = 64 * nb; int nd0 = n0 + J.rowoff;
    if (J.mode == 1) { const int up = n0 >= 5632, jn = up ? n0 - 5632 : n0; nd0 = 256 * (jn >> 7) + 128 * up + (jn & 127); }
    const float* src = J.W + (size_t)k0 * J.N + n0 + lane; float w[64];
#pragma unroll
    for (int kk = 0; kk < 64; ++kk) w[kk] = __builtin_nontemporal_load(src + (size_t)kk * J.N);
    if (J.gain) {
#pragma unroll
        for (int kk = 0; kk < 64; ++kk) w[kk] *= J.gain[k0 + kk]; }
    unsigned short* drow = J.dst + (size_t)(nd0 + lane) * J.K + k0;
#pragma unroll
    for (int j = 0; j < 8; ++j) { u32x4 o; o.x = cvt_pk_bf16(w[8 * j], w[8 * j + 1]); o.y = cvt_pk_bf16(w[8 * j + 2], w[8 * j + 3]); o.z = cvt_pk_bf16(w[8 * j + 4], w[8 * j + 5]); o.w = cvt_pk_bf16(w[8 * j + 6], w[8 * j + 7]);
        *(u32x4*)(drow + 8 * j) = o; }
}
__host__ __device__ constexpr int conv_items(int job) { return job < 2 ? 4096 : job < 4 ? 1024 : job < 8 ? 5632 : job < 12 ? 2816 : job == 12 ? 3072 : job == 13 ? 6144 : job == 14 ? 3072 : 1024; }
__device__ __forceinline__ bool conv_slot(int phase, int s, int& job, int& item) {
    if (phase == 0) { constexpr int j0 = 1, j1 = 3, j2 = 5, j3 = 9; constexpr int c1 = conv_items(j0), c2 = c1 + conv_items(j1), c3 = c2 + conv_items(j2), c4 = c3 + conv_items(j3);
        if (s < c1) { job = j0; item = s; } else if (s < c2) { job = j1; item = s - c1; } else if (s < c3) { job = j2; item = s - c2; } else if (s < c4) { job = j3; item = s - c3; } else return false; return true; }
    if (phase == 1) { constexpr int j0 = 12, j1 = 13, j2 = 15, j3 = 6, j4 = 10; constexpr int c1 = conv_items(j0), c2 = c1 + conv_items(j1), c3 = c2 + conv_items(j2), c4 = c3 + conv_items(j3), c5 = c4 + conv_items(j4);
        if (s < c1) { job = j0; item = s; } else if (s < c2) { job = j1; item = s - c1; } else if (s < c3) { job = j2; item = s - c2; } else if (s < c4) { job = j3; item = s - c3; } else if (s < c5) { job = j4; item = s - c4; } else return false; return true; }
    if (phase == 2) { constexpr int j0 = 14, j1 = 16, j2 = 7, j3 = 11; constexpr int c1 = conv_items(j0), c2 = c1 + conv_items(j1), c3 = c2 + conv_items(j2), c4 = c3 + conv_items(j3);
        if (s < c1) { job = j0; item = s; } else if (s < c2) { job = j1; item = s - c1; } else if (s < c3) { job = j2; item = s - c2; } else if (s < c4) { job = j3; item = s - c3; } else return false; return true; }
    return false;
}

struct EpiFfn1 {
    static constexpr bool PERM = true, AFTER_DRAIN = false;
    bf16_t* H; int ldh; const ssq_t* ss; const ConvJob* jobs; int phase; int f8; float ascale;
    const float* asc; const float* wsc;
    __device__ __forceinline__ void prefetch_lds(const Unit& u, int wid, int lane, PG8_LAS unsigned char* lds) const {
        if (asc && wid == 0) __builtin_amdgcn_global_load_lds((const unsigned*)(wsc + u.pn * BM + 4 * lane), (PG8_LAS unsigned*)(lds + QKV_SCR_OFF_FWD), 16, 0, 0); }
    __device__ __forceinline__ void prefetch(const Unit& u, int wr, int fr, unsigned (&pre)[8]) const {
        const int row0 = u.pm * BM + wr * 64 + fr;
        if (asc) {
#pragma unroll
            for (int i = 0; i < 8; ++i) pre[i] = __builtin_bit_cast(unsigned, asc[row0 + (i >> 2) * HALF + (i & 3) * 16]); }
        else ss_prefetch(pre, ss, row0); }
    __device__ __forceinline__ void operator()(const f32x4 (&acc)[2][2][4][2], const Unit& u, int wr, int wc, int fr, int fq, PG8_LAS unsigned char* lds_, const unsigned (&pre)[8], int ui) const {
        const int row0 = u.pm * BM + wr * 64 + fr, col0 = u.pn * HALF + wc * 32 + 8 * fq;
        float rs[2][4]; f32x4 wg[2], wu[2];
        if (asc) {
#pragma unroll
            for (int i = 0; i < 8; ++i) rs[i >> 2][i & 3] = __builtin_bit_cast(float, pre[i]);
            const PG8_LAS float* wp = (const PG8_LAS float*)(lds_ + QKV_SCR_OFF_FWD) + wc * 32 + 8 * fq;
            wg[0] = *(const PG8_LAS f32x4*)wp; wg[1] = *(const PG8_LAS f32x4*)(wp + 4); wu[0] = *(const PG8_LAS f32x4*)(wp + HALF); wu[1] = *(const PG8_LAS f32x4*)(wp + HALF + 4); }
        else { row_scales(rs, pre);
#pragma unroll
            for (int i = 0; i < 8; ++i) rs[i >> 2][i & 3] *= ascale;
            wg[0] = wg[1] = wu[0] = wu[1] = (f32x4){1.f, 1.f, 1.f, 1.f}; }
#pragma unroll
        for (int ai = 0; ai < 2; ++ai)
#pragma unroll
            for (int m = 0; m < 4; ++m) { f32x4 h[2];
#pragma unroll
                for (int n = 0; n < 2; ++n)
#pragma unroll
                    for (int j = 0; j < 4; ++j) { float ag = acc[ai][0][m][n][j], au = acc[ai][1][m][n][j];
                        if (asc) { ag = (float)__builtin_bit_cast(int, ag); au = (float)__builtin_bit_cast(int, au); }
                        const float g = ag * (rs[ai][m] * wg[n][j]), up = au * (rs[ai][m] * wu[n][j]); h[n][j] = silu_f(g) * up; }
                if (f8) { typedef unsigned u32x2_ __attribute__((ext_vector_type(2)));
                    *(u32x2_*)((unsigned char*)H + (size_t)(row0 + ai * HALF + m * 16) * ldh + col0) = (u32x2_){cvt4_fp8(h[0][0], h[0][1], h[0][2], h[0][3], F8_HSCALE), cvt4_fp8(h[1][0], h[1][1], h[1][2], h[1][3], F8_HSCALE)}; }
                else *(u32x4*)(H + (size_t)(row0 + ai * HALF + m * 16) * ldh + col0) = pack8_bf16(h[0], h[1]); }
        if (phase < 3) {
            asm volatile("" ::: "memory");
            const int slot = (ui * (int)gridDim.x + (int)blockIdx.x) * 8 + wr * 4 + wc; int job, item;
            if (conv_slot(phase, slot, job, item)) { const ConvJob J = jobs[job]; conv_item_reg(J, item, fq * 16 + fr); }
        }
    }
};

__host__ __device__ __forceinline__ size_t attn_row(int b, int g, int h, int t) { return (size_t)((b * 3 + g) * 16 + h) * 4096 + (size_t)((t & ((1 << (2 * g)) - 1)) << (12 - 2 * g)) + (size_t)(t >> (2 * g)); }
constexpr int QKV_SCR_OFF = 131072;
constexpr int QKV_ROPE_OFF = QKV_SCR_OFF + 8192;
constexpr int QKV_EPS_OFF = QKV_ROPE_OFF + 16384;
typedef _Float16 f16x8_t __attribute__((ext_vector_type(8)));
typedef float f32x8_t __attribute__((ext_vector_type(8)));
struct EpiQkv {
    static constexpr bool PERM = true, AFTER_DRAIN = false;
    __device__ __forceinline__ void prefetch_lds(const Unit&, int, int, PG8_LAS unsigned char*) const {}
    __device__ __forceinline__ void prefetch(const Unit&, int, int, unsigned (&)[8]) const {}
    bf16_t *Qo, *Ko, *Vo; const ssq_t* ss; const float* qgain; const float* kgain; const _Float16* rope; float ascale;
    __device__ __forceinline__ void operator()(const f32x4 (&acc)[2][2][4][2], const Unit& u, int wr, int wc, int fr, int fq, PG8_LAS unsigned char* lds, const unsigned (&pre)[8], int ui) const {
        const int kind = u.pn / 24, pt = u.pn - kind * 24, grp = pt >> 3;
        const int row0 = u.pm * BM + wr * 64 + fr, hd0 = (pt & 7) * 2, dcol = wc * 32 + 8 * fq;
        if (kind == 2) {
            unsigned loc[8]; ss_prefetch(loc, ss, row0);
            float rs[2][4]; row_scales(rs, loc);
#pragma unroll
            for (int i = 0; i < 8; ++i) rs[i >> 2][i & 3] *= ascale;
#pragma unroll
            for (int ai = 0; ai < 2; ++ai)
#pragma unroll
                for (int m = 0; m < 4; ++m) { const int row = row0 + ai * HALF + m * 16; const size_t off = attn_row(row >> 12, grp, hd0, row & 4095) * 128 + dcol;
#pragma unroll
                    for (int bj = 0; bj < 2; ++bj) { const f32x4 a_ = acc[ai][bj][m][0] * rs[ai][m], b_ = acc[ai][bj][m][1] * rs[ai][m];
                        typedef unsigned u32x2_ __attribute__((ext_vector_type(2))); *(u32x2_*)((unsigned char*)Vo + off + (size_t)bj * (4096 * 128)) = (u32x2_){cvt4_fp8(a_[0], a_[1], a_[2], a_[3], F8_XSCALE), cvt4_fp8(b_[0], b_[1], b_[2], b_[3], F8_XSCALE)}; } }
            return;
        }
        int lr = wr * 64 + fr; asm volatile("" : "+v"(lr));
        { const char* src = (const char*)(rope + (size_t)((u.pm * BM) & 4095) * 32) + ((wr * 4 + wc) * 64 + fq * 16 + fr) * 16;
#pragma unroll
          for (int i = 0; i < 2; ++i) __builtin_amdgcn_global_load_lds((const unsigned*)(src + i * 8192), (PG8_LAS unsigned*)(lds + QKV_ROPE_OFF + (wr * 4 + wc) * 1024 + i * 8192), 16, 0, 0); }
        unsigned loc[8];
        if (wc == 0) ss_prefetch(loc, ss, row0);
        const float* gain = (kind == 0 ? qgain : kgain) + grp * 128 + wc * 32 + 8 * fq;
        const f32x4 g0 = *(const f32x4*)gain, g1 = *(const f32x4*)(gain + 4);
        PG8_LAS float* scr = (PG8_LAS float*)(lds + QKV_SCR_OFF);
#pragma unroll
        for (int ai = 0; ai < 2; ++ai)
#pragma unroll
            for (int m = 0; m < 4; ++m)
#pragma unroll
                for (int bj = 0; bj < 2; ++bj) { const f32x4 a = acc[ai][bj][m][0], b = acc[ai][bj][m][1];
                    float s = (a[0] * a[0] + a[1] * a[1]) + (a[2] * a[2] + a[3] * a[3]) + (b[0] * b[0] + b[1] * b[1]) + (b[2] * b[2] + b[3] * b[3]);
                    s += __shfl_xor(s, 16); s += __shfl_xor(s, 32);
                    if (fq == 0) scr[((ai * HALF + m * 16 + lr) * 2 + bj) * 4 + wc] = s; }
        PG8_LAS float* epsl = (PG8_LAS float*)(lds + QKV_EPS_OFF);
        if (wc == 0 && fq == 0) {
#pragma unroll
            for (int am = 0; am < 8; ++am) epsl[(am >> 2) * HALF + (am & 3) * 16 + lr] = RMS_EPS * ((float)loc[am] * (1.0f / (SS_SCALE * DMODEL)) + RMS_EPS) * (1.0f / (ascale * ascale)); }
        asm volatile("s_waitcnt vmcnt(0) lgkmcnt(0)" ::: "memory"); __builtin_amdgcn_s_barrier(); asm volatile("" ::: "memory");
        bf16_t* dst = kind == 0 ? Qo : Ko;
#pragma unroll
        for (int am = 0; am < 8; ++am) { const int ai = am >> 2, m = am & 3; const int row = row0 + ai * HALF + m * 16; const size_t off = attn_row(row >> 12, grp, hd0, row & 4095) * 128 + dcol;
            const int lrow = ai * HALF + m * 16 + lr;
            const float epsr = epsl[lrow];
            f32x4 c0 = {1.f, 1.f, 1.f, 1.f}, c1 = c0, s0 = {0.f, 0.f, 0.f, 0.f}, s1 = s0;
            if (wc == 0) { const PG8_LAS f16x8_t* rp = (const PG8_LAS f16x8_t*)(lds + QKV_ROPE_OFF + lrow * 64 + (fq & 1) * 16);
                const f32x8_t cf = __builtin_convertvector(rp[0], f32x8_t), sf = __builtin_convertvector(rp[2], f32x8_t);
                const float sg = fq < 2 ? -1.0f : 1.0f;
#pragma unroll
                for (int j = 0; j < 4; ++j) { c0[j] = cf[j]; c1[j] = cf[4 + j]; s0[j] = sf[j] * sg; s1[j] = sf[4 + j] * sg; } }
#pragma unroll
            for (int bj = 0; bj < 2; ++bj) { const f32x4 p = *(const PG8_LAS f32x4*)(scr + (lrow * 2 + bj) * 4);
                const float sc = __builtin_amdgcn_rsqf(((p[0] + p[1]) + (p[2] + p[3])) * (1.0f / 128.0f) + epsr);
                f32x4 v0 = acc[ai][bj][m][0] * sc * g0, v1 = acc[ai][bj][m][1] * sc * g1;
                if (wc == 0) { f32x4 p0, p1;
#pragma unroll
                    for (int j = 0; j < 4; ++j) { p0[j] = __shfl_xor(v0[j], 32); p1[j] = __shfl_xor(v1[j], 32); }
                    v0 = v0 * c0 + p0 * s0; v1 = v1 * c1 + p1 * s1; }
                { typedef unsigned u32x2_ __attribute__((ext_vector_type(2))); *(u32x2_*)((unsigned char*)dst + off + (size_t)bj * (4096 * 128)) = (u32x2_){cvt4_fp8(v0[0], v0[1], v0[2], v0[3], F8_XSCALE), cvt4_fp8(v1[0], v1[1], v1[2], v1[3], F8_XSCALE)}; } }
            asm volatile("" ::: "memory");
        }
    }
};
}
namespace att {
typedef unsigned short bf16;
typedef short bf16x8 __attribute__((ext_vector_type(8)));
typedef short s16x4 __attribute__((ext_vector_type(4)));
typedef float f32x16 __attribute__((ext_vector_type(16)));
typedef float f32x4 __attribute__((ext_vector_type(4)));
typedef unsigned u32x4 __attribute__((ext_vector_type(4)));
constexpr int D = 128, NW = 8, QBLK = 32, KVBLK = 64, QB = NW * QBLK;
constexpr int SHM_V = KVBLK * D * 2, SHM_K = KVBLK * D * 2;
constexpr int LDS_BYTES = 2 * SHM_V + 2 * SHM_K + NW * 64 * 4;
constexpr float SCALE = 0.08838834764831845f;
constexpr float THR = 8.f;
constexpr int W = 129;
constexpr bool SK = true;

#define KSWZ(row, colB) ((row) * 256 + ((colB) ^ (((row) & 7) << 4)))
#define SBAR() __builtin_amdgcn_sched_barrier(0)
__device__ __forceinline__ int v_st(int k, int c) { const int kk = (k & ~0xC) | ((k & 4) << 1) | ((k & 8) >> 1); return ((kk >> 3) * 4 + (c >> 5)) * 512 + ((kk & 7) * 32 + (c & 31)) * 2; }
__device__ __forceinline__ int v_rd_base(int lane) { return ((lane & 3) << 3) | (((lane >> 2) & 3) << 6) | (((lane >> 4) & 1) << 5) | (((lane >> 5) & 1) << 8); }
constexpr int v_rd_off(int d0, int ks, int half) { return d0 * 512 + ks * 4096 + half * 2048; }
__device__ __forceinline__ int crow(int r, int hi) { return (r & 3) + 8 * (r >> 2) + 4 * hi; }
__device__ __forceinline__ unsigned cvtpk(float lo, float hi) { unsigned r; asm volatile("v_cvt_pk_bf16_f32 %0, %1, %2" : "=v"(r) : "v"(lo), "v"(hi)); return r; }
__device__ __forceinline__ bf16x8 ld8(const bf16* p) { return *reinterpret_cast<const bf16x8*>(p); }
__device__ __forceinline__ bf16x8 ld8g(const char* ubase, unsigned voff) { return *reinterpret_cast<const bf16x8*>(ubase + voff); }
__device__ __forceinline__ void mask_tile(f32x16& p0, f32x16& p1, int dq, unsigned Wu) {
    const float NEG = -__builtin_inff();
#pragma unroll
    for (int r = 0; r < 16; ++r) {
        const int c = (r & 3) + 8 * (r >> 2);
        if ((unsigned)(dq - c) >= Wu) p0[r] = NEG;
        if ((unsigned)(dq - c - 32) >= Wu) p1[r] = NEG;
    }
}
__device__ __forceinline__ void partialSM(f32x16& p0, f32x16& p1, float& m_reg, float& mn, float& alpha) {
    float pmax = p0[0];
#pragma unroll
    for (int r = 1; r < 16; ++r) pmax = fmaxf(pmax, p0[r]);
#pragma unroll
    for (int r = 0; r < 16; ++r) pmax = fmaxf(pmax, p1[r]);
    { auto rr = __builtin_amdgcn_permlane32_swap(__float_as_uint(pmax), __float_as_uint(pmax), false, false);
      pmax = fmaxf(__uint_as_float(rr[0]), __uint_as_float(rr[1])); }
    constexpr float C2 = 1.4426950408889634f * SCALE;
    if (__builtin_expect(__all((pmax - m_reg) * SCALE <= THR), 1)) { mn = m_reg; alpha = 1.f; }
    else { mn = fmaxf(m_reg, pmax); alpha = __builtin_amdgcn_exp2f((m_reg - mn) * C2); m_reg = mn; }
    const float mnL = -mn * C2;
#pragma unroll
    for (int r = 0; r < 16; ++r) p0[r] = fmaf(p0[r], C2, mnL);
#pragma unroll
    for (int r = 0; r < 16; ++r) p1[r] = fmaf(p1[r], C2, mnL);
#pragma unroll
    for (int r = 0; r < 16; ++r) p0[r] = __builtin_amdgcn_exp2f(p0[r]);
}
__device__ __forceinline__ void finishSM(f32x16& p0, f32x16& p1, float alpha, float& l_reg, bf16x8& pa0, bf16x8& pa1, bf16x8& pa2, bf16x8& pa3) {
#pragma unroll
    for (int r = 0; r < 16; ++r) p1[r] = __builtin_amdgcn_exp2f(p1[r]);
    float ps = 0;
#pragma unroll
    for (int r = 0; r < 16; ++r) ps += p0[r];
#pragma unroll
    for (int r = 0; r < 16; ++r) ps += p1[r];
    { auto rr = __builtin_amdgcn_permlane32_swap(__float_as_uint(ps), __float_as_uint(ps), false, false);
      ps = __uint_as_float(rr[0]) + __uint_as_float(rr[1]); }
    l_reg = l_reg * alpha + ps;
#define PK4(P, B_, OUT) do { unsigned a0 = cvtpk(P[B_+0], P[B_+1]), a1 = cvtpk(P[B_+2], P[B_+3]);                          \
        unsigned b0 = cvtpk(P[B_+4], P[B_+5]), b1 = cvtpk(P[B_+6], P[B_+7]);                                             \
        auto r0 = __builtin_amdgcn_permlane32_swap(a0, b0, false, false); auto r1 = __builtin_amdgcn_permlane32_swap(a1, b1, false, false); \
        u32x4 w = {r0[0], r1[0], r0[1], r1[1]}; OUT = *reinterpret_cast<bf16x8*>(&w); } while (0)
    PK4(p0, 0, pa0); PK4(p0, 8, pa1); PK4(p1, 0, pa2); PK4(p1, 8, pa3);
#undef PK4
}
template <int KB>
__device__ __forceinline__ void qkt(f32x16& p0, f32x16& p1, const char* K_lds, int r32, int hi, const bf16x8* qr, bool act) {
    if (SK && !act) { const float NEG = -__builtin_inff();
#pragma unroll
        for (int r = 0; r < 16; ++r) { p0[r] = NEG; p1[r] = NEG; } return; }
    p0 = f32x16{}; p1 = f32x16{};
    const char* kb[4];
#pragma unroll
    for (int dd = 0; dd < 4; ++dd) kb[dd] = K_lds + KB * SHM_K + KSWZ(r32, (dd * 16 + hi * 8) * 2);
#pragma unroll
    for (int d0 = 0; d0 < 8; ++d0) { const char* a = kb[d0 & 3] + (d0 >> 2) * 128;
        bf16x8 b0 = *reinterpret_cast<const bf16x8*>(a);
        bf16x8 b1 = *reinterpret_cast<const bf16x8*>(a + 32 * 256);
        p0 = __builtin_amdgcn_mfma_f32_32x32x16_bf16(b0, qr[d0], p0, 0, 0, 0);
        p1 = __builtin_amdgcn_mfma_f32_32x32x16_bf16(b1, qr[d0], p1, 0, 0, 0); }
}
template <int VB>
__device__ __forceinline__ void pv_tile(f32x16* o, int vb0, bf16x8 pa0, bf16x8 pa1, bf16x8 pa2, bf16x8 pa3, bool act) {
    if (SK && !act) return;
#define TRRD(dst, off) asm volatile("ds_read_b64_tr_b16 %0, %1 offset:%2" : "=&v"(dst) : "v"(vb0), "i"(off) : "memory")
#define PV_D0(d0) do { s16x4 l0, l1, l2, l3, h0, h1, h2, h3; constexpr int b_ = VB * SHM_V + v_rd_off(d0, 0, 0);   \
        TRRD(l0, b_); TRRD(h0, b_ + 2048); TRRD(l1, b_ + 4096); TRRD(h1, b_ + 6144); TRRD(l2, b_ + 8192); TRRD(h2, b_ + 10240); TRRD(l3, b_ + 12288); TRRD(h3, b_ + 14336); \
        asm volatile("s_waitcnt lgkmcnt(0)" ::: "memory"); SBAR();   \
        o[d0] = __builtin_amdgcn_mfma_f32_32x32x16_bf16(pa0, (bf16x8){l0[0], l0[1], l0[2], l0[3], h0[0], h0[1], h0[2], h0[3]}, o[d0], 0, 0, 0);   \
        o[d0] = __builtin_amdgcn_mfma_f32_32x32x16_bf16(pa1, (bf16x8){l1[0], l1[1], l1[2], l1[3], h1[0], h1[1], h1[2], h1[3]}, o[d0], 0, 0, 0);   \
        o[d0] = __builtin_amdgcn_mfma_f32_32x32x16_bf16(pa2, (bf16x8){l2[0], l2[1], l2[2], l2[3], h2[0], h2[1], h2[2], h2[3]}, o[d0], 0, 0, 0);   \
        o[d0] = __builtin_amdgcn_mfma_f32_32x32x16_bf16(pa3, (bf16x8){l3[0], l3[1], l3[2], l3[3], h3[0], h3[1], h3[2], h3[3]}, o[d0], 0, 0, 0); } while (0)
    PV_D0(0); PV_D0(1); PV_D0(2); PV_D0(3);
#undef PV_D0
#undef TRRD
}

struct BlockRef { const bf16* Q; const bf16* K; const bf16* V; bf16* O; float* LSE; int P0; };
struct Seam { bf16x8 qr[8]; bf16x8 st_v0, st_v1, st_k0, st_k1; };
__device__ __forceinline__ int swa_jlo(int P0) { const int lowk = P0 - W + 1; return lowk > 0 ? lowk / KVBLK : 0; }
#define VMW() asm volatile("s_waitcnt vmcnt(0)" ::: "memory")
#define VMWN(n) asm volatile("s_waitcnt vmcnt(%0)" :: "i"(n) : "memory")
#define SLOAD_H(Kp, Vp, k0, pitch) do { const char* kb_ = (const char*)(Kp) + (size_t)(k0) * (size_t)((pitch) * 2); const char* vb_ = (const char*)(Vp) + (size_t)(k0) * (size_t)((pitch) * 2); \
        S.st_v0 = ld8g(vb_, rowoff); S.st_v1 = ld8g(vb_ + 32 * (pitch) * 2, rowoff); S.st_k0 = ld8g(kb_, rowoff); S.st_k1 = ld8g(kb_ + 32 * (pitch) * 2, rowoff); } while (0)
#define SWRITE_HK(bf) do { *(bf16x8*)(K_lds + (bf) * SHM_K + kws) = S.st_k0; *(bf16x8*)(K_lds + (bf) * SHM_K + kws + 32 * 256) = S.st_k1; } while (0)
#define SWRITE_HV(bf) do { *(bf16x8*)(V_lds + (bf) * SHM_V + vst0) = S.st_v0; *(bf16x8*)(V_lds + (bf) * SHM_V + vst1) = S.st_v1; } while (0)
#define SWRITE_H(bf) do { SWRITE_HV(bf); SWRITE_HK(bf); } while (0)
template <int DIL> __device__ __forceinline__ void swa_prime(const BlockRef& cur, char* lds, Seam& S) {
    constexpr int PITCH = 128;
    int tid_ = threadIdx.x; asm volatile("" : "+v"(tid_));
    const int tid = tid_, wid = __builtin_amdgcn_readfirstlane(tid >> 6), lane = tid & 63, r32 = lane & 31, hi = lane >> 5;
    const int sr = tid >> 4, sc = (tid & 15) * 8, kws = KSWZ(sr, sc * 2); char* K_lds = lds + 2 * SHM_V;
    const unsigned rowoff = (unsigned)(sr * PITCH + sc) * 2u, qoff = (unsigned)((wid * QBLK + r32) * PITCH + hi * 8) * 2u;
    const int kb0 = swa_jlo(cur.P0) * KVBLK;
#pragma unroll
    for (int d0 = 0; d0 < 8; ++d0) S.qr[d0] = ld8g((const char*)cur.Q + d0 * 32, qoff);
    SLOAD_H(cur.K, cur.V, kb0, PITCH); VMW(); SWRITE_HK(0);
    __syncthreads();
}
template <int DIL> __device__ __forceinline__ void swa_block(const BlockRef& cur, const BlockRef& nxt, char* lds, Seam& S) {
    constexpr int PITCH = 128, LPITCH = DIL * 48, SKV = 4096 / DIL;
    int tid_ = threadIdx.x; asm volatile("" : "+v"(tid_));
    const int tid = tid_, wid = __builtin_amdgcn_readfirstlane(tid >> 6), lane = tid & 63, r32 = lane & 31, hi = lane >> 5;
    const int j_lo = swa_jlo(cur.P0);
    int j_hi = (cur.P0 + QB - 1) / KVBLK + 1; if (j_hi > SKV / KVBLK) j_hi = SKV / KVBLK;
    const int NT = j_hi - j_lo;
    const int kbn = swa_jlo(nxt.P0) * KVBLK;
    const int qlo = cur.P0 + wid * QBLK, qm = qlo + r32 - 4 * hi;
    char* V_lds = lds; char* K_lds = lds + 2 * SHM_V;
    float* ws = (float*)(lds + 2 * SHM_V + 2 * SHM_K) + wid * 64; float* li_l = ws, * al_l = ws + 32;
    float m_reg = -1e30f, l_reg = 0; f32x16 o[4] = {};
    const int sr = tid >> 4, sc = (tid & 15) * 8, vst0 = v_st(sr, sc), vst1 = v_st(32 + sr, sc), kws = KSWZ(sr, sc * 2);
    const unsigned rowoff = (unsigned)(sr * PITCH + sc) * 2u, qoff = (unsigned)((wid * QBLK + r32) * PITCH + hi * 8) * 2u;
    const int vb0 = (int)(uintptr_t)V_lds + v_rd_base(lane);
    const bf16* Kh = cur.K; const bf16* Vh = cur.V; constexpr int pitch = PITCH;
#define RESC(a) do { if (__any((a) < 1.f)) { if (hi == 0) al_l[r32] = (a); asm volatile("s_waitcnt lgkmcnt(0)" ::: "memory");              \
                     for (int d_ = 0; d_ < 4; ++d_) for (int r = 0; r < 16; ++r) o[d_][r] *= al_l[crow(r, hi)]; } } while (0)
#define KBASE(t) ((j_lo + (t)) * KVBLK)
#define ACT(t) (KBASE(t) <= qlo + QBLK - 1 && KBASE(t) + KVBLK - 1 >= qlo - W + 1)
#define MASKT(P0_, P1_, t) do { const int kb_ = KBASE(t); if ((!SK || ACT(t)) && (kb_ + KVBLK - 1 > qlo || kb_ <= qlo + QBLK - 1 - W)) mask_tile(P0_, P1_, qm - kb_, (unsigned)W); } while (0)
#define SEAM_K0() do { VMWN(8); SWRITE_HK(0); SBAR(); } while (0)
    f32x16 pA0, pA1, pB0, pB1; float mnA, mnB, alA, alB; bf16x8 pa0, pa1, pa2, pa3;
    SWRITE_HV(0); SBAR();
    if (NT > 1) { SLOAD_H(Kh, Vh, KBASE(1), pitch); }
    SBAR(); qkt<0>(pA0, pA1, K_lds, r32, hi, S.qr, ACT(0));
    MASKT(pA0, pA1, 0); partialSM(pA0, pA1, m_reg, mnA, alA);
    if (NT > 1) { VMW(); SWRITE_H(1); }
    __syncthreads();
#define HALF_STEP(PX0, PX1, mnX, alX, PY0, PY1, alY, t, KB, VB, SB) do {                                                      \
        SBAR(); qkt<KB>(PX0, PX1, K_lds, r32, hi, S.qr, ACT(t));                                             \
        finishSM(PY0, PY1, alY, l_reg, pa0, pa1, pa2, pa3); SBAR();                                                           \
        if ((t) + 1 < NT) { SLOAD_H(Kh, Vh, KBASE((t) + 1), pitch); SBAR(); }                                               \
        pv_tile<VB>(o, vb0, pa0, pa1, pa2, pa3, ACT((t) - 1)); MASKT(PX0, PX1, (t)); partialSM(PX0, PX1, m_reg, mnX, alX);                                        \
        __syncthreads();                                                                                                      \
        if ((t) + 1 < NT) { VMW(); SWRITE_H(SB); }                                                                          \
        RESC(alX); __syncthreads(); } while (0)
    for (int t = 1; t + 1 < NT; t += 2) {
        HALF_STEP(pB0, pB1, mnB, alB, pA0, pA1, alA, t, 1, 0, 0);
        HALF_STEP(pA0, pA1, mnA, alA, pB0, pB1, alB, t + 1, 0, 1, 1);
    }
    const bool even = (NT & 1) == 0;
    if (even) { SBAR(); qkt<1>(pB0, pB1, K_lds, r32, hi, S.qr, ACT(NT - 1)); SBAR(); }
    SLOAD_H(nxt.K, nxt.V, kbn, PITCH); SBAR();
#pragma unroll
    for (int d0 = 0; d0 < 8; ++d0) S.qr[d0] = ld8g((const char*)nxt.Q + d0 * 32, qoff);
    SBAR();
    finishSM(pA0, pA1, alA, l_reg, pa0, pa1, pa2, pa3); SBAR();
    pv_tile<0>(o, vb0, pa0, pa1, pa2, pa3, ACT(even ? NT - 2 : NT - 1));
    if (even) { MASKT(pB0, pB1, NT - 1); partialSM(pB0, pB1, m_reg, mnB, alB); __syncthreads(); RESC(alB);
        finishSM(pB0, pB1, alB, l_reg, pa0, pa1, pa2, pa3); SBAR(); pv_tile<1>(o, vb0, pa0, pa1, pa2, pa3, ACT(NT - 1)); }
    SBAR(); SEAM_K0();
    if (hi == 0) li_l[r32] = l_reg; asm volatile("s_waitcnt lgkmcnt(0)" ::: "memory");
    float rli[16];
#pragma unroll
    for (int r = 0; r < 16; ++r) rli[r] = __builtin_amdgcn_rcpf(li_l[crow(r, hi)]);
    { char* Ob = (char*)cur.O + (size_t)(wid * QBLK) * (size_t)(PITCH * 2); const unsigned ooff = (unsigned)(4 * hi * PITCH + r32) * 2u;
#pragma unroll
      for (int r = 0; r < 16; ++r) { char* Or = Ob + (size_t)((r & 3) + 8 * (r >> 2)) * (size_t)(PITCH * 2);
#pragma unroll
        for (int d0 = 0; d0 < 4; ++d0) { const float v = o[d0][r] * rli[r];
            const float vn = __shfl_xor(v, 1);
            if ((r32 & 1) == 0) *(unsigned*)(Or + d0 * 64 + ooff) = cvtpk(v, vn); } } }
    if (hi == 0) cur.LSE[(size_t)(wid * QBLK + r32) * (size_t)LPITCH] = m_reg * SCALE + __builtin_amdgcn_logf(l_reg) * 0.6931471805599453f;
    __syncthreads();
#undef RESC
#undef KBASE
#undef ACT
#undef MASKT
#undef SEAM_K0
#undef HALF_STEP
}
#undef VMW
#undef VMWN
#undef SLOAD_H
#undef SWRITE_HK
#undef SWRITE_HV
#undef SWRITE_H
#undef KSWZ
#undef SBAR

template <int DIL> __device__ __forceinline__ BlockRef make_ref(int idx, const bf16* Q, const bf16* K, const bf16* V, bf16* O, float* LSE) {
    constexpr int GI = DIL == 1 ? 0 : (DIL == 4 ? 1 : 2), NQB = 16 / DIL, PITCH = 128;
    const int j = idx & 15, h = (idx >> 4) & 15, b = idx >> 8, r = j / NQB, qb = j - r * NQB;
    const size_t base = ((size_t)((b * 3 + GI) * 16 + h) * 4096 + (size_t)r * (4096 / DIL)) * 128;
    BlockRef R; R.P0 = qb * QB;
    R.K = K + base; R.V = V + base; R.Q = Q + base + (size_t)R.P0 * (size_t)PITCH; R.O = O + base + (size_t)R.P0 * (size_t)PITCH;
    R.LSE = LSE + (size_t)(b * 4096 + r + R.P0 * DIL) * 48 + GI * 16 + h;
    return R;
}
template <int DIL> __device__ __forceinline__ void attn_group(char* lds, const bf16* Q, const bf16* K, const bf16* V, bf16* O, float* LSE) {
    const int total = 1024, stride = gridDim.x; int L = blockIdx.x; if (L >= total) return;
    BlockRef cur = make_ref<DIL>(L, Q, K, V, O, LSE); Seam S;
    swa_prime<DIL>(cur, lds, S);
    for (;;) {
        const int Ln = L + stride; const bool last = Ln >= total;
        const BlockRef nxt = last ? cur : make_ref<DIL>(Ln, Q, K, V, O, LSE);
        swa_block<DIL>(cur, nxt, lds, S);
        if (last) break;
        cur = nxt; L = Ln;
    }
}
__device__ __forceinline__ void attn_phase(char* lds, const bf16* Q, const bf16* K, const bf16* V, bf16* O, float* LSE) {
#ifndef ATT_ONLY
    attn_group<1>(lds, Q, K, V, O, LSE);
    attn_group<4>(lds, Q, K, V, O, LSE);
    attn_group<16>(lds, Q, K, V, O, LSE);
#else
    attn_group<ATT_ONLY>(lds, Q, K, V, O, LSE);
#endif
}
}
namespace att2 {
typedef unsigned short bf16;
typedef short bf16x8 __attribute__((ext_vector_type(8)));
typedef short v4i16_t __attribute__((ext_vector_type(4)));
typedef float f32x4 __attribute__((ext_vector_type(4)));
typedef float f32x2 __attribute__((ext_vector_type(2)));
typedef unsigned u32x4 __attribute__((ext_vector_type(4)));
typedef unsigned u32x2 __attribute__((ext_vector_type(2)));
typedef __bf16 bf16x2_t __attribute__((ext_vector_type(2)));
#define ALAS __attribute__((address_space(3)))
constexpr int KST = 272, VST = 288, GRAN_K = 128 * KST, GRAN = GRAN_K + 128 * VST;
constexpr int LDS_NEED = 2 * GRAN;
constexpr float F8S = 16.0f;
constexpr float SCALE = 0.08838834764831845f / (F8S * F8S), C2 = 1.4426950408889634f * SCALE;
__device__ __forceinline__ u32x2 f8x4_to_bf16(unsigned w) { const f32x2 lo = __builtin_amdgcn_cvt_pk_f32_fp8((int)w, false), hi = __builtin_amdgcn_cvt_pk_f32_fp8((int)w, true);
    const bf16x2_t a = __builtin_convertvector(lo, bf16x2_t), b = __builtin_convertvector(hi, bf16x2_t); return (u32x2){__builtin_bit_cast(unsigned, a), __builtin_bit_cast(unsigned, b)}; }
__device__ __forceinline__ u32x4 f8x8_to_bf16(unsigned w0, unsigned w1) { const u32x2 a = f8x4_to_bf16(w0), b = f8x4_to_bf16(w1); return (u32x4){a.x, a.y, b.x, b.y}; }
__device__ __forceinline__ unsigned cvtpk(float lo, float hi) { const f32x2 v = {lo, hi}; const bf16x2_t b = __builtin_convertvector(v, bf16x2_t); return __builtin_bit_cast(unsigned, b); }
__device__ __forceinline__ v4i16_t vtr(const ALAS unsigned char* p) { return __builtin_amdgcn_ds_read_tr16_b64_v4i16((ALAS v4i16_t*)p); }

__device__ __forceinline__ void a2_compute(ALAS unsigned char* lds, int G, bool has_prev, int wid, int q16, int g4, const bf16x8 (&qf)[4], bf16* Oq, float* LSE, int b, int GI, int h, int DIL, int NBM, int NBS) {
        const ALAS unsigned char* slotP = lds + ((G - 1) & 1) * GRAN; const ALAS unsigned char* slotC = lds + (G & 1) * GRAN;
        f32x4 sc[9];
        const int nprev = 8 - wid;
#pragma unroll
        for (int kt = 0; kt < 9; ++kt) { sc[kt] = (f32x4){0.f, 0.f, 0.f, 0.f};
            const int kb = 16 * wid + 16 * kt; const bool inprev = kt < nprev;
            if (!inprev || has_prev) { const ALAS unsigned char* kp = (inprev ? slotP + kb * KST : slotC + (kb - 128) * KST) + q16 * KST + g4 * 16;
#pragma unroll
                for (int s = 0; s < 4; ++s) sc[kt] = __builtin_amdgcn_mfma_f32_16x16x32_bf16(*(const ALAS bf16x8*)(kp + s * 64), qf[s], sc[kt], 0, 0, 0); } }
        const float NEG = -__builtin_inff();
#pragma unroll
        for (int r = 0; r < 4; ++r) { if (4 * g4 + r < q16) sc[0][r] = NEG; if (4 * g4 + r > q16) sc[8][r] = NEG; }
        if (!has_prev) {
#pragma unroll
            for (int kt = 0; kt < 8; ++kt) if (kt < nprev) sc[kt] = (f32x4){NEG, NEG, NEG, NEG}; }
        float mx = NEG;
#pragma unroll
        for (int kt = 0; kt < 9; ++kt) mx = fmaxf(mx, fmaxf(fmaxf(sc[kt][0], sc[kt][1]), fmaxf(sc[kt][2], sc[kt][3])));
        mx = fmaxf(mx, __shfl_xor(mx, 16)); mx = fmaxf(mx, __shfl_xor(mx, 32));
        const float mL = -mx * C2; float ls = 0.f;
#pragma unroll
        for (int kt = 0; kt < 9; ++kt)
#pragma unroll
            for (int r = 0; r < 4; ++r) { const float p = __builtin_amdgcn_exp2f(fmaf(sc[kt][r], C2, mL)); sc[kt][r] = p; ls += p; }
        ls += __shfl_xor(ls, 16); ls += __shfl_xor(ls, 32);
        f32x4 o[8];
#pragma unroll
        for (int dt = 0; dt < 8; ++dt) o[dt] = (f32x4){0.f, 0.f, 0.f, 0.f};
#pragma unroll
        for (int p = 0; p < 5; ++p) { const int t0 = 2 * p, t1 = 2 * p + 1;
            const bool v0 = !(t0 < nprev) || has_prev, v1 = (t1 < 9) && (!(t1 < nprev) || has_prev);
            if (v0 || v1) {
                u32x4 pw; pw.x = cvtpk(sc[t0][0], sc[t0][1]); pw.y = cvtpk(sc[t0][2], sc[t0][3]);
                if (t1 < 9) { pw.z = cvtpk(sc[t1 < 9 ? t1 : 8][0], sc[t1 < 9 ? t1 : 8][1]); pw.w = cvtpk(sc[t1 < 9 ? t1 : 8][2], sc[t1 < 9 ? t1 : 8][3]); } else { pw.z = 0u; pw.w = 0u; }
                const bf16x8 pf = __builtin_bit_cast(bf16x8, pw);
                const int kb0 = 16 * wid + 16 * t0, kb1 = 16 * wid + 16 * t1;
                const ALAS unsigned char* vb0 = (t0 < nprev) ? slotP + GRAN_K + kb0 * VST : slotC + GRAN_K + (kb0 - 128) * VST;
                const ALAS unsigned char* vb1 = (t1 < 9) ? ((t1 < nprev) ? slotP + GRAN_K + kb1 * VST : slotC + GRAN_K + (kb1 - 128) * VST) : vb0;
                if (!v0) vb0 = vb1;
                if (!v1) vb1 = vb0;
                const ALAS unsigned char* a0 = vb0 + (4 * g4 + (q16 >> 2)) * VST + (q16 & 3) * 8; const ALAS unsigned char* a1 = vb1 + (4 * g4 + (q16 >> 2)) * VST + (q16 & 3) * 8;
#pragma unroll
                for (int dt = 0; dt < 8; ++dt) { const v4i16_t lo = vtr(a0 + dt * 32), hi = vtr(a1 + dt * 32);
                    o[dt] = __builtin_amdgcn_mfma_f32_16x16x32_bf16((bf16x8){lo[0], lo[1], lo[2], lo[3], hi[0], hi[1], hi[2], hi[3]}, pf, o[dt], 0, 0, 0); } } }
        { const float inv = __builtin_amdgcn_rcpf(ls); unsigned char* orow = (unsigned char*)Oq + 4 * g4;
#pragma unroll
          for (int dt = 0; dt < 8; ++dt) *(unsigned*)(orow + 16 * dt) = pg8::cvt4_fp8(o[dt][0] * inv, o[dt][1] * inv, o[dt][2] * inv, o[dt][3] * inv, 1.0f);
          if (g4 == 0) { const int blk = G & NBM, r = G >> NBS, t = (128 * blk + 16 * wid + q16) * DIL + r;
              LSE[((size_t)b * 4096 + t) * 48 + GI * 16 + h] = mx * SCALE + __builtin_amdgcn_logf(ls) * 0.6931471805599453f; } }
}

__device__ __forceinline__ void attn_item(ALAS unsigned char* lds, int b, int GI, int h, int G0, const bf16* Q, const bf16* K, const bf16* V, bf16* O, float* LSE) {
    const int DIL = 1 << (2 * GI), NBM = (32 >> (2 * GI)) - 1, NBS = 5 - 2 * GI;
    int tid_ = threadIdx.x; asm volatile("" : "+v"(tid_));
    const int tid = tid_, wid = __builtin_amdgcn_readfirstlane(tid >> 6), lane = tid & 63, q16 = lane & 15, g4 = lane >> 4;
    const size_t hb = (size_t)((b * 3 + GI) * 16 + h) * 4096;
    const char* Kh = (const char*)K + hb * 128; const char* Vh = (const char*)V + hb * 128;
    u32x4 skA[2], svA[2], skB[2], svB[2];
#define A2_GLOAD(G_, sk, sv) do { _Pragma("unroll") for (int i = 0; i < 2; ++i) { const unsigned o_ = (unsigned)((G_) * 128 * 128) + (unsigned)(tid + 512 * i) * 16u; \
        sk[i] = *(const u32x4*)(Kh + o_); sv[i] = *(const u32x4*)(Vh + o_); } } while (0)
#define A2_WIDEN(dstp_, src_) do { *(ALAS u32x4*)(dstp_) = f8x8_to_bf16(src_.x, src_.y); *(ALAS u32x4*)((dstp_) + 16) = f8x8_to_bf16(src_.z, src_.w); } while (0)
#define A2_GWRITE(G_, sk, sv) do { ALAS unsigned char* sl_ = lds + ((G_) & 1) * GRAN; _Pragma("unroll") for (int i = 0; i < 2; ++i) { const int id_ = tid + 512 * i, r_ = id_ >> 3, c_ = id_ & 7; \
        A2_WIDEN(sl_ + r_ * KST + c_ * 32, sk[i]); A2_WIDEN(sl_ + GRAN_K + r_ * VST + c_ * 32, sv[i]); } } while (0)
#define A2_QLOAD(G_, qf_) do { const size_t qr_ = hb + (size_t)(G_) * 128 + 16 * wid + q16; _Pragma("unroll") for (int s = 0; s < 4; ++s) { const u32x2 w_ = *(const u32x2*)((const unsigned char*)Q + qr_ * 128 + 32 * s + 8 * g4); \
        qf_[s] = __builtin_bit_cast(bf16x8, f8x8_to_bf16(w_.x, w_.y)); } } while (0)
    bf16x8 qfA[4], qfB[4];
    __syncthreads();
    if ((G0 & NBM) != 0) { A2_GLOAD(G0 - 1, skA, svA); A2_GWRITE(G0 - 1, skA, svA); }
    A2_GLOAD(G0, skB, svB); A2_QLOAD(G0, qfA); A2_GLOAD(G0 + 1, skA, svA); A2_GWRITE(G0, skB, svB);
    __syncthreads();
#define A2_BLOCK(n, skC, svC, skN, svN, qf, qn) do { \
        const int G = G0 + (n); const bool has_prev = (G & NBM) != 0; \
        if ((n) < 6) A2_GLOAD(G + 2, skN, svN); \
        if ((n) < 7) A2_QLOAD(G + 1, qn); \
        const size_t qrow = hb + (size_t)G * 128 + 16 * wid + q16; \
        a2_compute(lds, G, has_prev, wid, q16, g4, qf, O + qrow * 64, LSE, b, GI, h, DIL, NBM, NBS);   \
        __syncthreads(); \
        if ((n) < 7) A2_GWRITE(G + 1, skC, svC); \
        __syncthreads(); } while (0)
    A2_BLOCK(0, skA, svA, skB, svB, qfA, qfB); A2_BLOCK(1, skB, svB, skA, svA, qfB, qfA);
    A2_BLOCK(2, skA, svA, skB, svB, qfA, qfB); A2_BLOCK(3, skB, svB, skA, svA, qfB, qfA);
    A2_BLOCK(4, skA, svA, skB, svB, qfA, qfB); A2_BLOCK(5, skB, svB, skA, svA, qfB, qfA);
    A2_BLOCK(6, skA, svA, skB, svB, qfA, qfB); A2_BLOCK(7, skB, svB, skA, svA, qfB, qfA);
#undef A2_BLOCK
#undef A2_GLOAD
#undef A2_GWRITE
#undef A2_WIDEN
#undef A2_QLOAD
}

__device__ __forceinline__ void attn_phase(ALAS unsigned char* lds, const bf16* Q, const bf16* K, const bf16* V, bf16* O, float* LSE) {
    const int G_ = gridDim.x, vcu = (G_ % 8 == 0) ? ((int)blockIdx.x % 8) * (G_ / 8) + (int)blockIdx.x / 8 : (int)blockIdx.x;
    for (int it = vcu; it < 768; it += G_) { const int i4 = it & 3, h = (it >> 2) & 15, bg = it >> 6, b = bg / 3, g = bg - 3 * b;
        attn_item(lds, b, g, h, 8 * i4, Q, K, V, O, LSE); }
}
#undef ALAS
}
namespace hg {
typedef short bf16x8 __attribute__((ext_vector_type(8)));
typedef short s16x4 __attribute__((ext_vector_type(4)));
typedef float f32x16 __attribute__((ext_vector_type(16)));
typedef float f32x4 __attribute__((ext_vector_type(4)));
typedef float f32x2 __attribute__((ext_vector_type(2)));
typedef unsigned u32x4 __attribute__((ext_vector_type(4)));
typedef _Float16 f16x2_t __attribute__((ext_vector_type(2)));
#define HLAS __attribute__((address_space(3)))
constexpr int QT_OFF = 0, QT_ST = 264;
constexpr int QH_OFF = 16896, QH_ST = 272;
constexpr int KC_OFF = 34304, KC_ST = 272;
constexpr int KCT_OFF = 51712, KCT_ST = 144;
constexpr int VT_OFF = 70144, VT_ST = 144;
constexpr int GAM_OFF = 88576;
constexpr int TOT_OFF = 89088;
constexpr int OB_OFF = 93184, OB_ST = 132;
constexpr int LDS_END = OB_OFF + 64 * OB_ST * 4;
static_assert(LDS_END <= 131072, "hgrn LDS map");
typedef __bf16 bf16x2_t __attribute__((ext_vector_type(2)));
__device__ __forceinline__ unsigned cvtpk(float lo, float hi) { const f32x2 v = {lo, hi}; const bf16x2_t b = __builtin_convertvector(v, bf16x2_t); return __builtin_bit_cast(unsigned, b); }
__device__ __forceinline__ float ex(float x) { return __builtin_amdgcn_exp2f(x * 1.4426950408889634f); }
__device__ __forceinline__ float blo(unsigned w) { return __builtin_bit_cast(float, w << 16); }
__device__ __forceinline__ float bhi(unsigned w) { return __builtin_bit_cast(float, w & 0xffff0000u); }
__device__ __forceinline__ bf16x8 pack8(const f32x16& x, int o) {
    u32x4 w = {cvtpk(x[o + 0], x[o + 1]), cvtpk(x[o + 2], x[o + 3]), cvtpk(x[o + 4], x[o + 5]), cvtpk(x[o + 6], x[o + 7])}; return __builtin_bit_cast(bf16x8, w); }
__device__ __forceinline__ bf16x8 ld2x8(const HLAS unsigned char* p) {
    const s16x4 lo = *(const HLAS s16x4*)p, hi = *(const HLAS s16x4*)(p + 16); return (bf16x8){lo[0], lo[1], lo[2], lo[3], hi[0], hi[1], hi[2], hi[3]}; }

template <bool STATE_ONLY>
__device__ __forceinline__ void hgrn_chunked(HLAS unsigned char* lds, int bh, int seg_i, int ch0, int nch, const unsigned short* Qb, const unsigned short* Kb, const unsigned short* Vb, unsigned short* Ob,
                                             const float* LOGF, const unsigned short* SGb, const float* ogain, float* Sbase, float* Gbase) {
    constexpr int SEQ_ = 4096, DM_ = 2048, HD_ = 128;
    int tid_ = threadIdx.x; asm volatile("" : "+v"(tid_));
    const int tid = tid_, wid = __builtin_amdgcn_readfirstlane(tid >> 6), lane = tid & 63, wt = wid >> 2, wv = wid & 3, c = lane & 31, hi = lane >> 5;
    const int b = bh >> 4, h = bh & 15;
    const size_t goff0 = ((size_t)bh * SEQ_ + 8 * wid) * HD_ + 2 * lane;
    const int t4 = tid >> 3, seg = tid & 7;
    f32x4 gn[4];
    if constexpr (!STATE_ONLY) {
#pragma unroll
        for (int i = 0; i < 4; ++i) gn[i] = *(const f32x4*)(ogain + 16 * seg + 4 * i); }
    f32x16 S[4];
#pragma unroll
    for (int kt = 0; kt < 4; ++kt)
#pragma unroll
        for (int r = 0; r < 16; ++r) S[kt][r] = 0.f;
    if constexpr (!STATE_ONLY) {
        for (int j = 0; j < seg_i; ++j) { const float* Sj = Sbase + (size_t)j * HD_ * HD_ + 32 * wv + c; const float* Gj = Gbase + j * HD_;
#pragma unroll
            for (int kt = 0; kt < 4; ++kt)
#pragma unroll
                for (int r = 0; r < 16; ++r) { const int k = 32 * kt + (r & 3) + 8 * (r >> 2) + 4 * hi; S[kt][r] = ex(Gj[k]) * S[kt][r] + Sj[(size_t)k * HD_]; } } }
    float gs0 = 0.f, gs1 = 0.f;
#ifdef HG_STORE_K
    unsigned kv[8];
#endif
    f32x2 lfh[8]; unsigned qv[8], vv[8];
#ifdef HG_STORE_K
#define HG_KLOAD(i, o_) kv[i] = *(const unsigned*)(Kb + o_)
#define HG_K(i) const float k0 = blo(kv[i]), k1 = bhi(kv[i])
#else
#define HG_KLOAD(i, o_)
#define HG_K(i) const float k0 = 1.0f - ex(l0[i]), k1 = 1.0f - ex(l1[i])
#endif
#define HG_LOAD(t0_) do { _Pragma("unroll") for (int i = 0; i < 8; ++i) { const size_t o_ = goff0 + (size_t)((t0_) + i) * HD_; \
        lfh[i] = *(const f32x2*)(LOGF + o_); HG_KLOAD(i, o_); vv[i] = *(const unsigned*)(Vb + o_); if constexpr (!STATE_ONLY) qv[i] = *(const unsigned*)(Qb + o_); } } while (0)
    HG_LOAD(ch0 * 64);
    HLAS float* TOT = (HLAS float*)(lds + TOT_OFF); HLAS float* GAM = (HLAS float*)(lds + GAM_OFF); HLAS float* OB = (HLAS float*)(lds + OB_OFF);
    for (int ch = ch0; ch < ch0 + nch; ++ch) {
        const int t0 = ch * 64;
        float f0[8], f1[8], cs0 = 0.f, cs1 = 0.f;
#pragma unroll
        for (int i = 0; i < 8; ++i) { const float a0 = lfh[i][0], a1 = lfh[i][1]; cs0 += a0; cs1 += a1; f0[i] = ex(a0); f1[i] = ex(a1); }
        *(HLAS f32x2*)(TOT + wid * 128 + 2 * lane) = (f32x2){cs0, cs1};
        __syncthreads();
        {
            float pre0 = 0.f, pre1 = 0.f, tot0 = 0.f, tot1 = 0.f;
#pragma unroll
            for (int w = 0; w < 8; ++w) { const f32x2 tv = *(const HLAS f32x2*)(TOT + w * 128 + 2 * lane); tot0 += tv[0]; tot1 += tv[1]; if (w < wid) { pre0 += tv[0]; pre1 += tv[1]; } }
            gs0 += tot0; gs1 += tot1;
            const float rg0 = ex(fminf(-tot0, 80.f)), rg1 = ex(fminf(-tot1, 80.f));
            float kc0[8], kc1[8];
            { float r0 = ex(tot0 - pre0 - cs0), r1 = ex(tot1 - pre1 - cs1);
#pragma unroll
              for (int i = 7; i >= 0; --i) { kc0[i] = (1.0f - f0[i]) * r0; kc1[i] = (1.0f - f1[i]) * r1; r0 *= f0[i]; r1 *= f1[i]; } }
            if constexpr (!STATE_ONLY) { float e0 = ex(pre0), e1 = ex(pre1);
#pragma unroll
                for (int i = 0; i < 8; ++i) { const int t = 8 * wid + i; e0 *= f0[i]; e1 *= f1[i];
                    const float qt0 = blo(qv[i]) * e0, qt1 = bhi(qv[i]) * e1;
                    *(HLAS unsigned*)(lds + QT_OFF + t * QT_ST + lane * 4) = cvtpk(qt0, qt1);
                    *(HLAS unsigned*)(lds + QH_OFF + t * QH_ST + lane * 4) = cvtpk(qt0 * rg0, qt1 * rg1);
                    *(HLAS unsigned*)(lds + KC_OFF + t * KC_ST + lane * 4) = cvtpk(kc0[i], kc1[i]); } }
            *(HLAS u32x4*)(lds + KCT_OFF + (2 * lane) * KCT_ST + wid * 16) = (u32x4){cvtpk(kc0[0], kc0[1]), cvtpk(kc0[2], kc0[3]), cvtpk(kc0[4], kc0[5]), cvtpk(kc0[6], kc0[7])};
            *(HLAS u32x4*)(lds + KCT_OFF + (2 * lane + 1) * KCT_ST + wid * 16) = (u32x4){cvtpk(kc1[0], kc1[1]), cvtpk(kc1[2], kc1[3]), cvtpk(kc1[4], kc1[5]), cvtpk(kc1[6], kc1[7])};
            *(HLAS u32x4*)(lds + VT_OFF + (2 * lane) * VT_ST + wid * 16) = (u32x4){(vv[0] & 0xffffu) | (vv[1] << 16), (vv[2] & 0xffffu) | (vv[3] << 16), (vv[4] & 0xffffu) | (vv[5] << 16), (vv[6] & 0xffffu) | (vv[7] << 16)};
            *(HLAS u32x4*)(lds + VT_OFF + (2 * lane + 1) * VT_ST + wid * 16) = (u32x4){(vv[0] >> 16) | (vv[1] & 0xffff0000u), (vv[2] >> 16) | (vv[3] & 0xffff0000u), (vv[4] >> 16) | (vv[5] & 0xffff0000u), (vv[6] >> 16) | (vv[7] & 0xffff0000u)};
            if (wid == 0) *(HLAS f32x2*)(GAM + 2 * lane) = (f32x2){ex(tot0), ex(tot1)};
        }
        if (ch + 1 < ch0 + nch) HG_LOAD(t0 + 64);
        const size_t ooff = (size_t)(b * SEQ_ + t0 + t4) * DM_ + h * HD_ + 16 * seg;
        u32x4 sg0, sg1;
        if constexpr (!STATE_ONLY) { const size_t so_ = ((size_t)bh * SEQ_ + t0 + t4) * HD_ + 16 * seg; sg0 = *(const u32x4*)(SGb + so_); sg1 = *(const u32x4*)(SGb + so_ + 8); }
        __syncthreads();
        {
            const HLAS unsigned char* vrow = lds + VT_OFF + (32 * wv + c) * VT_ST;
            f32x16 O;
            if constexpr (!STATE_ONLY) {
            f32x16 X0, X1;
#pragma unroll
            for (int r = 0; r < 16; ++r) { O[r] = 0.f; X0[r] = 0.f; X1[r] = 0.f; }
            const HLAS unsigned char* qhp = lds + QH_OFF + (32 * wt + c) * QH_ST + hi * 16;
            { const HLAS unsigned char* kp = lds + KC_OFF + c * KC_ST + hi * 16;
#pragma unroll
              for (int ks = 0; ks < 8; ++ks) X0 = __builtin_amdgcn_mfma_f32_32x32x16_bf16(*(const HLAS bf16x8*)(kp + ks * 32), *(const HLAS bf16x8*)(qhp + ks * 32), X0, 0, 0, 0); }
            if (wt == 1) { const HLAS unsigned char* kp = lds + KC_OFF + (32 + c) * KC_ST + hi * 16;
#pragma unroll
              for (int ks = 0; ks < 8; ++ks) X1 = __builtin_amdgcn_mfma_f32_32x32x16_bf16(*(const HLAS bf16x8*)(kp + ks * 32), *(const HLAS bf16x8*)(qhp + ks * 32), X1, 0, 0, 0); }
#pragma unroll
            for (int r = 0; r < 16; ++r) { const bool drop = ((r & 3) + 8 * (r >> 2) + 4 * hi) > c; if (wt == 0) { if (drop) X0[r] = 0.f; } else { if (drop) X1[r] = 0.f; } }
#pragma unroll
            for (int st = 0; st < 2; ++st) O = __builtin_amdgcn_mfma_f32_32x32x16_bf16(pack8(X0, 8 * st), ld2x8(vrow + (16 * st + 4 * hi) * 2), O, 0, 0, 0);
            if (wt == 1) {
#pragma unroll
                for (int st = 0; st < 2; ++st) O = __builtin_amdgcn_mfma_f32_32x32x16_bf16(pack8(X1, 8 * st), ld2x8(vrow + (32 + 16 * st + 4 * hi) * 2), O, 0, 0, 0); }
            const HLAS unsigned char* qtp = lds + QT_OFF + (32 * wt + c) * QT_ST + 8 * hi;
#pragma unroll
            for (int kt = 0; kt < 4; ++kt)
#pragma unroll
                for (int st = 0; st < 2; ++st) O = __builtin_amdgcn_mfma_f32_32x32x16_bf16(ld2x8(qtp + (32 * kt + 16 * st) * 2), pack8(S[kt], 8 * st), O, 0, 0, 0);
            }
            bf16x8 vb[4];
#pragma unroll
            for (int st = 0; st < 4; ++st) vb[st] = *(const HLAS bf16x8*)(vrow + (16 * st + 8 * hi) * 2);
#pragma unroll
            for (int kt = 0; kt < 4; ++kt) {
#pragma unroll
                for (int g = 0; g < 4; ++g) { const f32x4 gm = *(const HLAS f32x4*)(GAM + 32 * kt + 8 * g + 4 * hi);
#pragma unroll
                    for (int j = 0; j < 4; ++j) S[kt][4 * g + j] *= gm[j]; }
                const HLAS unsigned char* kp = lds + KCT_OFF + (32 * kt + c) * KCT_ST + hi * 16;
#pragma unroll
                for (int st = 0; st < 4; ++st) S[kt] = __builtin_amdgcn_mfma_f32_32x32x16_bf16(*(const HLAS bf16x8*)(kp + st * 32), vb[st], S[kt], 0, 0, 0);
            }
            if constexpr (!STATE_ONLY) {
#pragma unroll
            for (int r = 0; r < 16; ++r) OB[(32 * wt + (r & 3) + 8 * (r >> 2) + 4 * hi) * OB_ST + 32 * wv + c] = O[r]; }
        }
        if constexpr (!STATE_ONLY) {
        __syncthreads();
        {
            f32x4 o[4]; float s = 0.f;
#pragma unroll
            for (int i = 0; i < 4; ++i) { o[i] = *(const HLAS f32x4*)(OB + t4 * OB_ST + 16 * seg + 4 * i); s += (o[i][0] * o[i][0] + o[i][1] * o[i][1]) + (o[i][2] * o[i][2] + o[i][3] * o[i][3]); }
            s += __shfl_xor(s, 1); s += __shfl_xor(s, 2); s += __shfl_xor(s, 4);
            const float sc = __builtin_amdgcn_rsqf(s * (1.0f / HD_) + 1e-6f);
            u32x4 w0, w1;
#pragma unroll
            for (int e = 0; e < 4; ++e) { const int i = e >> 1, j = (e & 1) * 2;
                w0[e] = cvtpk(o[i][j] * sc * gn[i][j] * blo(sg0[e]), o[i][j + 1] * sc * gn[i][j + 1] * bhi(sg0[e]));
                w1[e] = cvtpk(o[2 + i][j] * sc * gn[2 + i][j] * blo(sg1[e]), o[2 + i][j + 1] * sc * gn[2 + i][j + 1] * bhi(sg1[e])); }
            *(u32x4*)(Ob + ooff) = w0; *(u32x4*)(Ob + ooff + 8) = w1;
        }
        }
    }
    if constexpr (STATE_ONLY) {
        if (wt == 0) { float* Sj = Sbase + (size_t)seg_i * HD_ * HD_ + 32 * wv + c;
#pragma unroll
            for (int kt = 0; kt < 4; ++kt)
#pragma unroll
                for (int r = 0; r < 16; ++r) Sj[(size_t)(32 * kt + (r & 3) + 8 * (r >> 2) + 4 * hi) * HD_] = S[kt][r]; }
        if (wid == 0) *(f32x2*)(Gbase + seg_i * HD_ + 2 * lane) = (f32x2){gs0, gs1};
    }
#undef HG_LOAD
}
#undef HLAS
}
constexpr int BATCH = 4, SEQ = 4096, DM = 2048, MROWS = BATCH * SEQ, FFH = 5632, NHEAD = 16, HDIM = 128;
constexpr int NWAVES = 8;
constexpr int F8_FIRST_LAYER = 3, F8_FFN1_LAYER = 4;
constexpr size_t MiB = 1u << 20;
constexpr size_t WS_CTL = 0, WS_SS = 1 * MiB, CTL_ZERO_BYTES = 3 * MiB;
constexpr size_t WS_LBS = 3 * MiB, WS_JOBS = 3 * MiB + 32768, WS_ROPE = 3 * MiB + 65536;
constexpr size_t WS_WMAX = 2 * MiB;
constexpr size_t WS_ASC = 3 * MiB + 640 * 1024, WS_WSC = 3 * MiB + 704 * 1024;
constexpr size_t WS_WMAX2 = WS_WMAX + 256 * 1024, WS_ASC2 = 3 * MiB + 576 * 1024, WS_WSC2 = 3 * MiB + 896 * 1024;
#define I8_FFN2(L_) ((L_) == 2)
constexpr int I8_FFN1_LAYER = 0;
constexpr size_t WS_W = 4 * MiB;
constexpr size_t WS_WA_IN = WS_W, WS_WA_OUT = WS_W + 64 * MiB, WS_WF_IN = WS_W + 80 * MiB, WS_WF_OUT = WS_W + 256 * MiB,
                 WS_WQKV2 = WS_W + 344 * MiB, WS_WQ3 = WS_W + 416 * MiB, WS_WB_OUT = WS_W + 440 * MiB;
constexpr size_t WS_XB = 460 * MiB;
constexpr size_t WS_R1 = 524 * MiB;
constexpr size_t WS_R2 = 908 * MiB;
constexpr size_t WS_OG = 1168 * MiB;
constexpr size_t WS_X8 = 1360 * MiB;
constexpr size_t WS_END = 1392 * MiB;
constexpr int CW_BAR = 1024;
constexpr int RING_BYTES = 131072, SCR_OFF = 131072, LDS_BYTES = 163840, MISC_OFF = LDS_BYTES - 512;
static_assert(SCR_OFF == pg8::QKV_SCR_OFF && att2::LDS_NEED <= MISC_OFF && pg8::QKV_EPS_OFF + 1024 <= MISC_OFF, "LDS map");

#define GAS __attribute__((address_space(1)))
#define LAS __attribute__((address_space(3)))
typedef unsigned short bf16;
typedef unsigned v4u __attribute__((ext_vector_type(4)));
typedef unsigned v2u __attribute__((ext_vector_type(2)));
typedef float f32x4 __attribute__((ext_vector_type(4)));
#define LDS_WAIT() asm volatile("s_waitcnt lgkmcnt(0)" ::: "memory")
__device__ __forceinline__ unsigned f2bf(float f) { unsigned u = __builtin_bit_cast(unsigned, f); return (u + 0x7fffu + ((u >> 16) & 1u)) >> 16; }
__device__ __forceinline__ unsigned pk2(float lo, float hi) { return f2bf(lo) | (f2bf(hi) << 16); }
__device__ __forceinline__ float bflo(unsigned w) { return __builtin_bit_cast(float, w << 16); }
__device__ __forceinline__ float bfhi(unsigned w) { return __builtin_bit_cast(float, w & 0xffff0000u); }

#define XB_TMO      128
#define XB_XCNT(j)  (256  + 64 * (j))
#define XB_XSUB(j)  (1280 + 64 * (j))
#define XB_XGEN(j)  (2304 + 64 * (j))
#define XB_TOP      3328
#define XB_TOPGEN   3392
#define XCD_BAR_WORDS 3456
#define XB_SPIN_CAP (1u << 18)

__device__ __forceinline__ unsigned xb_ld(unsigned* p)              { return __hip_atomic_load(p, __ATOMIC_RELAXED, __HIP_MEMORY_SCOPE_AGENT); }
__device__ __forceinline__ unsigned xb_add(unsigned* p, unsigned v) { return __hip_atomic_fetch_add(p, v, __ATOMIC_RELAXED, __HIP_MEMORY_SCOPE_AGENT); }
__device__ __forceinline__ unsigned xb_xcc_id() { return (unsigned)__builtin_amdgcn_s_getreg((3 << 11) | 20) & 0xFu; }
#define XB_SPIN(cond, bar) do { unsigned _sp = 0; while (cond) { __builtin_amdgcn_s_sleep(1); \
    if ((++_sp & 255u) == 0u) { if (xb_ld(&(bar)[XB_TMO])) break; if (_sp > XB_SPIN_CAP) { atomicAdd(&(bar)[XB_TMO], 1u); break; } } } } while (0)

struct XcdBarrier {
    unsigned* bar; unsigned x;
    volatile LAS unsigned* st;
};

__device__ __forceinline__ XcdBarrier xcd_barrier_post(unsigned* bar, volatile LAS unsigned* st) {
    XcdBarrier b; b.bar = bar; b.x = xb_xcc_id(); b.st = st;
    if (threadIdx.x == 0) (void)xb_add(&bar[XB_XCNT(b.x)], 1u);
    return b;
}
__device__ __forceinline__ void xcd_barrier_complete(unsigned* bar, unsigned x, unsigned& nloc, unsigned& nx) {
    const unsigned G = gridDim.x * gridDim.y * gridDim.z;
    unsigned sum, cnt, mine, sp = 0u;
    for (;;) {
        sum = 0u; cnt = 0u; mine = 0u;
#pragma unroll
        for (unsigned j = 0; j < 16; ++j) { const unsigned c = xb_ld(&bar[XB_XCNT(j)]); sum += c; cnt += (c > 0u) ? 1u : 0u; mine = (j == x) ? c : mine; }
        if (sum == G) break;
        __builtin_amdgcn_s_sleep(1);
        if ((++sp & 255u) == 0u) { if (xb_ld(&bar[XB_TMO])) break; if (sp > XB_SPIN_CAP) { atomicAdd(&bar[XB_TMO], 1u); break; } }
    }
    nloc = mine > 0u ? mine : 1u; nx = cnt > 0u ? cnt : 1u;
}

__device__ __forceinline__ void xcd_barrier(const XcdBarrier& b) {
    asm volatile("s_waitcnt vmcnt(0)" ::: "memory");
    __syncthreads();
    if (threadIdx.x == 0) {
        unsigned* bar = b.bar;
        __builtin_amdgcn_s_waitcnt(0);
        unsigned nloc = b.st[0], nx = b.st[1];
        if (nloc == 0u) { xcd_barrier_complete(bar, b.x, nloc, nx); b.st[0] = nloc; b.st[1] = nx; }
        const unsigned old = xb_add(&bar[XB_XSUB(b.x)], 1u);
        const unsigned gen = old / nloc;
        if (old + 1u == (gen + 1u) * nloc) {
            __builtin_amdgcn_fence(__ATOMIC_RELEASE, "agent");
            asm volatile("s_waitcnt vmcnt(0)" ::: "memory");
            const unsigned og = xb_add(&bar[XB_TOP], 1u);
            const unsigned tg = og / nx;
            if (og + 1u == (tg + 1u) * nx) xb_add(&bar[XB_TOPGEN], 1u);
            else XB_SPIN(xb_ld(&bar[XB_TOPGEN]) == tg, bar);
            __builtin_amdgcn_fence(__ATOMIC_ACQUIRE, "agent");
            asm volatile("s_waitcnt vmcnt(0)" ::: "memory");
        } else {
            XB_SPIN(xb_ld(&bar[XB_TOPGEN]) == gen, bar);
            __builtin_amdgcn_fence(__ATOMIC_ACQUIRE, "agent");
            asm volatile("s_waitcnt vmcnt(0)" ::: "memory");
        }
    }
    __syncthreads();
}


__device__ __forceinline__ float wave_sum(float v) {
#pragma unroll
    for (int o = 1; o < 64; o <<= 1) v += __shfl_xor(v, o);
    return v;
}
__device__ __forceinline__ void conv_load64(float (&w)[64], const float* W, int ldw, int k0, int n0, int lane) {
    const float* src = W + (size_t)k0 * ldw + n0 + lane;
#pragma unroll
    for (int kk = 0; kk < 64; ++kk) w[kk] = __builtin_nontemporal_load(src + (size_t)kk * ldw);
}
__device__ __forceinline__ unsigned pack4_i8(float a, float b, float c, float d, float s) {
    const int q0 = (int)__builtin_rintf(__builtin_amdgcn_fmed3f(a * s, -127.f, 127.f)), q1 = (int)__builtin_rintf(__builtin_amdgcn_fmed3f(b * s, -127.f, 127.f)), q2 = (int)__builtin_rintf(__builtin_amdgcn_fmed3f(c * s, -127.f, 127.f)), q3 = (int)__builtin_rintf(__builtin_amdgcn_fmed3f(d * s, -127.f, 127.f));
    return (unsigned)(q0 & 255) | ((unsigned)(q1 & 255) << 8) | ((unsigned)(q2 & 255) << 16) | ((unsigned)(q3 & 255) << 24); }
__device__ __forceinline__ void conv_store64(const float (&w)[64], int K, const float* gain, bf16* WT, int k0, int nd0, LAS float* scr, int lane, bool f8 = false, const unsigned* wmax = nullptr, float* wsc = nullptr, int n0 = 0) {
    if (gain) {
#pragma unroll
        for (int kk = 0; kk < 64; ++kk) scr[kk * 65 + lane] = w[kk] * gain[k0 + kk]; }
    else {
#pragma unroll
        for (int kk = 0; kk < 64; ++kk) scr[kk * 65 + lane] = w[kk]; }
    LDS_WAIT(); asm volatile("" ::: "memory");
    const int c = lane & 7;
#pragma unroll
    for (int j = 0; j < 8; ++j) { const int n = (lane >> 3) + 8 * j; const LAS float* s = scr + (8 * c) * 65 + n;
        if (wmax) { const float am = fmaxf(__builtin_bit_cast(float, wmax[n0 + n]), 1e-30f), sc = 127.0f / am;
            v2u o; o.x = pack4_i8(s[0 * 65], s[1 * 65], s[2 * 65], s[3 * 65], sc); o.y = pack4_i8(s[4 * 65], s[5 * 65], s[6 * 65], s[7 * 65], sc);
            __builtin_nontemporal_store(o, (GAS v2u*)((unsigned char*)WT + (size_t)(nd0 + n) * K + k0 + 8 * c));
            if (k0 == 0 && c == 0) wsc[nd0 + n] = am * (1.0f / 127.0f); }
        else if (f8) { v2u o; o.x = pg8::cvt4_fp8(s[0 * 65], s[1 * 65], s[2 * 65], s[3 * 65], pg8::F8_WSCALE); o.y = pg8::cvt4_fp8(s[4 * 65], s[5 * 65], s[6 * 65], s[7 * 65], pg8::F8_WSCALE);
            __builtin_nontemporal_store(o, (GAS v2u*)((unsigned char*)WT + (size_t)(nd0 + n) * K + k0 + 8 * c)); }
        else { v4u o; o.x = pk2(s[0 * 65], s[1 * 65]); o.y = pk2(s[2 * 65], s[3 * 65]); o.z = pk2(s[4 * 65], s[5 * 65]); o.w = pk2(s[6 * 65], s[7 * 65]);
            __builtin_nontemporal_store(o, (GAS v4u*)(WT + (size_t)(nd0 + n) * K + k0 + 8 * c)); } }
    LDS_WAIT(); asm volatile("" ::: "memory");
}

struct Args { const float* in[16]; float* out; unsigned char* ws; };


__device__ __forceinline__ void wmax_tensor(const float* W, const float* gain, int K, int N, unsigned* wm, int gw, int NGW, int lane) {
    const int nblk = N / 64, nkb = K / 64, nitems = nkb * nblk;
    for (int it = gw; it < nitems; it += NGW) { const int k0 = 64 * (it % nkb), n0 = 64 * (it / nkb); const float* src = W + (size_t)k0 * N + n0 + lane; float m = 0.f;
#pragma unroll 16
        for (int kk = 0; kk < 64; ++kk) m = fmaxf(m, __builtin_fabsf(src[(size_t)kk * N] * (gain ? gain[k0 + kk] : 1.0f)));
        atomicMax(wm + n0 + lane, __builtin_bit_cast(unsigned, m)); }
}
__device__ __forceinline__ void wmax_pass(const Args& a, int gw, int NGW, int lane) {
    for (int l = I8_FFN1_LAYER; l < 4; ++l) wmax_tensor(a.in[14] + (size_t)l * DM * 2 * FFH, a.in[13] + l * DM, DM, 2 * FFH, (unsigned*)(a.ws + WS_WMAX) + l * 2 * FFH, gw, NGW, lane);
    for (int l = 0; l < 4; ++l) if (I8_FFN2(l)) wmax_tensor(a.in[15] + (size_t)l * FFH * DM, nullptr, FFH, DM, (unsigned*)(a.ws + WS_WMAX2) + l * DM, gw, NGW, lane);
}
template <int NP = 4>
__device__ __forceinline__ void quant_rows(const bf16* xb, const pg8::ssq_t* ss, unsigned char* xq, float* asc, int gw, int NGW, int lane) {
    constexpr int DM = NP * 512;
    for (int r = gw; r < MROWS; r += NGW) { const float rs = ss ? pg8::ss_to_rs(ss[r]) : 1.0f; const GAS v4u* src = (const GAS v4u*)(xb + (size_t)r * DM) + lane; v4u w[NP]; float m = 0.f;
#pragma unroll
        for (int j = 0; j < NP; ++j) { w[j] = src[64 * j];
#pragma unroll
            for (int q = 0; q < 4; ++q) m = fmaxf(m, fmaxf(__builtin_fabsf(bflo(w[j][q])), __builtin_fabsf(bfhi(w[j][q])))); }
#pragma unroll
        for (int o = 1; o < 64; o <<= 1) m = fmaxf(m, __shfl_xor(m, o));
        const float am = fmaxf(m * rs, 1e-30f), sc = rs * (127.0f / am);
#pragma unroll
        for (int j = 0; j < NP; ++j) { v2u o; o.x = pack4_i8(bflo(w[j][0]), bfhi(w[j][0]), bflo(w[j][1]), bfhi(w[j][1]), sc); o.y = pack4_i8(bflo(w[j][2]), bfhi(w[j][2]), bflo(w[j][3]), bfhi(w[j][3]), sc);
            *((GAS v2u*)(xq + (size_t)r * DM) + lane + 64 * j) = o; }
        if (lane == 0) asc[r] = am * (1.0f / 127.0f); }
}
__device__ __forceinline__ void prologue(const Args& a, LAS unsigned char* lds, int gw, int NGW, int lane, int wave) {
    unsigned char* ws = a.ws;
    { float* lbs = (float*)(ws + WS_LBS); const float* alb = a.in[5];
      for (int i = gw * 64 + lane; i < DM; i += NGW * 64) { const float a0 = alb[i], a1 = alb[DM + i]; float s1 = 1.0f / (1.0f + expf(a0 - a1)); s1 = fminf(fmaxf(s1, 0.0f), 1.0f - 1e-6f); lbs[i] = 0.0f; lbs[DM + i] = s1; } }
    { _Float16* rope = (_Float16*)(ws + WS_ROPE);
      for (int i = gw * 64 + lane; i < SEQ * 16; i += NGW * 64) { const int pos = i >> 4, j = i & 15; double inv = 1.0;
          for (int q = 0; q < j; ++q) inv *= 0.4403666026717805;
          const double ang = (double)pos * inv, nrev = __builtin_rint(ang * 0.15915494309189535);
          const double r = (ang - nrev * 6.283185307179586) - nrev * 2.4492935982947064e-16, r2 = r * r;
          double ts = r, sn = r, tc = 1.0, cs = 1.0;
          for (int q = 1; q <= 14; ++q) { tc *= -r2 / (double)((2 * q - 1) * (2 * q)); cs += tc; ts *= -r2 / (double)((2 * q) * (2 * q + 1)); sn += ts; }
          rope[pos * 32 + j] = (_Float16)(float)cs; rope[pos * 32 + 16 + j] = (_Float16)(float)sn; } }
    { const float* x = a.in[0]; bf16* xb = (bf16*)(ws + WS_XB); pg8::ssq_t* ss0 = (pg8::ssq_t*)(ws + WS_SS);
      for (int m = gw; m < MROWS; m += NGW) { const GAS f32x4* xr = (const GAS f32x4*)(x + (size_t)m * DM) + lane; GAS v2u* o8 = (GAS v2u*)(xb + (size_t)m * DM) + lane; float s = 0.f;
#pragma unroll
          for (int j = 0; j < 8; ++j) { const f32x4 v = xr[64 * j]; s += (v.x * v.x + v.y * v.y) + (v.z * v.z + v.w * v.w); v2u w; w.x = pk2(v.x, v.y); w.y = pk2(v.z, v.w); o8[64 * j] = w; }
          s = wave_sum(s); if (lane == 0) ss0[m] = (pg8::ssq_t)(s * pg8::SS_SCALE + 0.5f); } }
    pg8::ConvJob* jobs = (pg8::ConvJob*)(ws + WS_JOBS);
    LAS float* scr = (LAS float*)(lds + wave * 16640);
    for (int job = 0; job < 17; ++job) {
        const float* W; const float* gain = nullptr; bf16* dst; int K = DM, N, mode = 0, rowoff = 0;
        if (job < 2)       { W = a.in[2] + (size_t)job * DM * 8192; N = 8192; gain = a.in[1] + job * DM; dst = (bf16*)(ws + WS_WA_IN) + (size_t)job * 8192 * DM; }
        else if (job < 4)  { const int l = job - 2; W = a.in[4] + (size_t)l * DM * DM; N = DM; dst = (bf16*)(ws + WS_WA_OUT) + (size_t)l * DM * DM; }
        else if (job < 8)  { const int l = job - 4; W = a.in[14] + (size_t)l * DM * 2 * FFH; N = 2 * FFH; gain = a.in[13] + l * DM; dst = (bf16*)(ws + WS_WF_IN) + (size_t)l * 2 * FFH * DM; mode = 1; }
        else if (job < 12) { const int l = job - 8; W = a.in[15] + (size_t)l * FFH * DM; K = FFH; N = DM; dst = (bf16*)(ws + WS_WF_OUT) + (size_t)l * DM * FFH; }
        else if (job == 12) { W = a.in[10]; N = 6144; gain = a.in[9]; dst = (bf16*)(ws + WS_WQKV2); }
        else if (job == 13) { W = a.in[7]; N = 12288; gain = a.in[6]; dst = (bf16*)(ws + WS_WQKV2); rowoff = 6144; }
        else if (job == 14) { W = a.in[10] + (size_t)DM * 6144; N = 6144; gain = a.in[9] + DM; dst = (bf16*)(ws + WS_WQ3); }
        else { const int l = job - 15; W = a.in[12] + (size_t)l * DM * DM; N = DM; dst = (bf16*)(ws + WS_WB_OUT) + (size_t)l * DM * DM; }
        if (gw == 0 && lane == 0) { pg8::ConvJob J; J.W = W; J.gain = gain; J.dst = dst; J.K = K; J.N = N; J.mode = mode; J.rowoff = rowoff; jobs[job] = J; }
#ifndef CONV_ALL_IN_PROLOGUE
        if (!(job == 0 || job == 2 || job == 4 || job == 8)) continue;
#endif
        const bool i8job = job >= 4 + I8_FFN1_LAYER && job < 8;
        const bool i8ojob = job >= 8 && job < 12 && I8_FFN2(job - 8);
        const int nblk = N / 64, nkb = K / 64, nitems = nkb * nblk;
        float wa[64], wb[64];
#define CONV_KB 2
#define CONV_DEC(it_, k0_, n0_, nd0_) const int sg_##k0_ = (it_) >> 3, w_##k0_ = (it_) & 7, nkg_##k0_ = nkb / CONV_KB; \
        const int k0_ = 64 * (CONV_KB * (sg_##k0_ % nkg_##k0_) + (w_##k0_ % CONV_KB)), n0_ = 64 * ((8 / CONV_KB) * (sg_##k0_ / nkg_##k0_) + (w_##k0_ / CONV_KB)); int nd0_ = n0_ + rowoff; \
        if (mode == 1) { const int up_ = n0_ >= FFH, jn_ = up_ ? n0_ - FFH : n0_; nd0_ = 256 * (jn_ >> 7) + 128 * up_ + (jn_ & 127); }
        if (gw < nitems) { { CONV_DEC(gw, k0, n0, nd0); (void)nd0; conv_load64(wa, W, N, k0, n0, lane); }
            for (int it = gw; it < nitems; it += 2 * NGW) {
                const bool h1 = it + NGW < nitems, h2 = it + 2 * NGW < nitems;
                if (h1) { CONV_DEC(it + NGW, k0, n0, nd0); (void)nd0; conv_load64(wb, W, N, k0, n0, lane); }
                { CONV_DEC(it, k0, n0, nd0); conv_store64(wa, K, gain, dst, k0, nd0, scr, lane, (job >= 8 + F8_FIRST_LAYER && job < 12) || job >= 12 || (job >= 4 + F8_FFN1_LAYER && job < 8), i8job ? (const unsigned*)(ws + WS_WMAX) + (job - 4) * 2 * FFH : i8ojob ? (const unsigned*)(ws + WS_WMAX2) + (job - 8) * DM : nullptr, i8ojob ? (float*)(ws + WS_WSC2) + (job - 8) * DM : (float*)(ws + WS_WSC) + (job - 4) * 2 * FFH, n0); }
                if (h2) { CONV_DEC(it + 2 * NGW, k0, n0, nd0); (void)nd0; conv_load64(wa, W, N, k0, n0, lane); }
                if (h1) { CONV_DEC(it + NGW, k0, n0, nd0); conv_store64(wb, K, gain, dst, k0, nd0, scr, lane, (job >= 8 + F8_FIRST_LAYER && job < 12) || job >= 12 || (job >= 4 + F8_FFN1_LAYER && job < 8), i8job ? (const unsigned*)(ws + WS_WMAX) + (job - 4) * 2 * FFH : i8ojob ? (const unsigned*)(ws + WS_WMAX2) + (job - 8) * DM : nullptr, i8ojob ? (float*)(ws + WS_WSC2) + (job - 8) * DM : (float*)(ws + WS_WSC) + (job - 4) * 2 * FFH, n0); }
            } }
#undef CONV_DEC
    }
}

__device__ __forceinline__ void hgrn_naive(LAS unsigned char* lds, int bh, const bf16* Qb, const bf16* Kb, bf16* Vb, const float* LOGF, const bf16* SGb, const float* ogain) {
    int tid_ = threadIdx.x; asm volatile("" : "+v"(tid_));
    const int tid = tid_, b = bh >> 4, h = bh & 15, v = tid & 127, kg = tid >> 7;
    LAS float* Lf = (LAS float*)lds; LAS float* Lk = Lf + 2048; LAS float* Lq = Lk + 2048; LAS float* Lv = Lq + 2048; LAS float* Lp = Lv + 2048;
    float S[32];
#pragma unroll
    for (int j = 0; j < 32; ++j) S[j] = 0.f;
    const int stok = tid >> 5, sch = (tid & 31) * 4;
    for (int t0 = 0; t0 < SEQ; t0 += 16) {
        { const size_t off = (size_t)(b * SEQ + t0 + stok) * DM + h * HDIM + sch;
          const f32x4 lf = *(const f32x4*)(LOGF + off); const v2u kq = *(const v2u*)(Kb + off), qq = *(const v2u*)(Qb + off), vq = *(const v2u*)(Vb + off);
          *(LAS f32x4*)(Lf + stok * 128 + sch) = (f32x4){__expf(lf.x), __expf(lf.y), __expf(lf.z), __expf(lf.w)};
          *(LAS f32x4*)(Lk + stok * 128 + sch) = (f32x4){bflo(kq.x), bfhi(kq.x), bflo(kq.y), bfhi(kq.y)};
          *(LAS f32x4*)(Lq + stok * 128 + sch) = (f32x4){bflo(qq.x), bfhi(qq.x), bflo(qq.y), bfhi(qq.y)};
          *(LAS f32x4*)(Lv + stok * 128 + sch) = (f32x4){bflo(vq.x), bfhi(vq.x), bflo(vq.y), bfhi(vq.y)}; }
        __syncthreads();
        for (int tok = 0; tok < 16; ++tok) { const float vv = Lv[tok * 128 + v]; float acc = 0.f;
#pragma unroll
            for (int j4 = 0; j4 < 8; ++j4) { const f32x4 f = *(const LAS f32x4*)(Lf + tok * 128 + kg * 32 + 4 * j4), kk = *(const LAS f32x4*)(Lk + tok * 128 + kg * 32 + 4 * j4), qq = *(const LAS f32x4*)(Lq + tok * 128 + kg * 32 + 4 * j4);
#pragma unroll
                for (int e = 0; e < 4; ++e) { S[4 * j4 + e] = f[e] * S[4 * j4 + e] + kk[e] * vv; acc += qq[e] * S[4 * j4 + e]; } }
            Lp[(tok * 4 + kg) * 128 + v] = acc; }
        __syncthreads();
        { f32x4 o = *(const LAS f32x4*)(Lp + (stok * 4 + 0) * 128 + sch);
#pragma unroll
          for (int g = 1; g < 4; ++g) o += *(const LAS f32x4*)(Lp + (stok * 4 + g) * 128 + sch);
          float s = (o.x * o.x + o.y * o.y) + (o.z * o.z + o.w * o.w);
#pragma unroll
          for (int d = 1; d < 32; d <<= 1) s += __shfl_xor(s, d);
          const float sc = 1.0f / sqrtf(s * (1.0f / HDIM) + 1e-6f);
          const size_t off = (size_t)(b * SEQ + t0 + stok) * DM + h * HDIM + sch;
          const f32x4 gn = *(const f32x4*)(ogain + sch); const v2u sg = *(const v2u*)(SGb + off);
          v2u w; w.x = pk2(o.x * sc * gn.x * bflo(sg.x), o.y * sc * gn.y * bfhi(sg.x)); w.y = pk2(o.z * sc * gn.z * bflo(sg.y), o.w * sc * gn.w * bfhi(sg.y));
          *(v2u*)(Vb + off) = w; }
        __syncthreads();
    }
}

__device__ __forceinline__ void combine_phase(const bf16* OG, const float* LSE, bf16* OC) {
    typedef float f32x2c __attribute__((ext_vector_type(2)));
    const unsigned char* OG8 = (const unsigned char*)OG;
    const size_t nitem = (size_t)MROWS * (DM / 8), stride = (size_t)gridDim.x * blockDim.x;
    for (size_t i0 = (size_t)blockIdx.x * blockDim.x + threadIdx.x; i0 < nitem; i0 += 4 * stride) {
        v2u a[4], bb[4], cc[4]; float l0[4], l1[4], l2[4];
#pragma unroll
        for (int u = 0; u < 4; ++u) { const size_t i = i0 + u * stride; const size_t tok = i >> 8; const int c = (int)(i & 255) * 8, h = c >> 7, bb_ = (int)(tok >> 12), t_ = (int)(tok & 4095), d_ = c & 127;
            l0[u] = LSE[tok * 48 + h]; l1[u] = LSE[tok * 48 + 16 + h]; l2[u] = LSE[tok * 48 + 32 + h];
            a[u] = *(const v2u*)(OG8 + pg8::attn_row(bb_, 0, h, t_) * 128 + d_); bb[u] = *(const v2u*)(OG8 + pg8::attn_row(bb_, 1, h, t_) * 128 + d_); cc[u] = *(const v2u*)(OG8 + pg8::attn_row(bb_, 2, h, t_) * 128 + d_); }
#pragma unroll
        for (int u = 0; u < 4; ++u) { const size_t i = i0 + u * stride; const size_t tok = i >> 8; const int c = (int)(i & 255) * 8;
            const float mx = fmaxf(l0[u], fmaxf(l1[u], l2[u])); float w0 = __expf(l0[u] - mx), w1 = __expf(l1[u] - mx), w2 = __expf(l2[u] - mx); const float inv = 1.0f / (w0 + w1 + w2); w0 *= inv; w1 *= inv; w2 *= inv;
            float r[8];
#pragma unroll
            for (int e = 0; e < 2; ++e) {
                const f32x2c a0 = __builtin_amdgcn_cvt_pk_f32_fp8((int)a[u][e], false), a1 = __builtin_amdgcn_cvt_pk_f32_fp8((int)a[u][e], true);
                const f32x2c b0 = __builtin_amdgcn_cvt_pk_f32_fp8((int)bb[u][e], false), b1 = __builtin_amdgcn_cvt_pk_f32_fp8((int)bb[u][e], true);
                const f32x2c c0 = __builtin_amdgcn_cvt_pk_f32_fp8((int)cc[u][e], false), c1 = __builtin_amdgcn_cvt_pk_f32_fp8((int)cc[u][e], true);
                r[4 * e + 0] = w0 * a0[0] + w1 * b0[0] + w2 * c0[0]; r[4 * e + 1] = w0 * a0[1] + w1 * b0[1] + w2 * c0[1];
                r[4 * e + 2] = w0 * a1[0] + w1 * b1[0] + w2 * c1[0]; r[4 * e + 3] = w0 * a1[1] + w1 * b1[1] + w2 * c1[1]; }
            v2u o; o.x = pg8::cvt4_fp8(r[0], r[1], r[2], r[3], 1.0f); o.y = pg8::cvt4_fp8(r[4], r[5], r[6], r[7], 1.0f);
            *(v2u*)((unsigned char*)OC + tok * DM + c) = o; }
    }
}

#define GRID_BAR() xcd_barrier(bar)
template <int LAYER>
__device__ __forceinline__ void layer_phases(const Args& args, LAS unsigned char* lds, unsigned char* lds_raw, const XcdBarrier& bar) {
    unsigned char* ws = args.ws; const int G = gridDim.x;
    bf16* XB = (bf16*)(ws + WS_XB); pg8::ssq_t* SS = (pg8::ssq_t*)(ws + WS_SS); float* out = args.out;
    constexpr int ssi = 2 * LAYER;
    if constexpr (LAYER < 2) {
        bf16* HGO = (bf16*)(ws + WS_OG);
        bf16* Aq = (bf16*)(ws + WS_R1); bf16* Ak = Aq + (size_t)MROWS * DM; bf16* Av = Ak + (size_t)MROWS * DM; bf16* Asg = Av + (size_t)MROWS * DM; float* Alogf = (float*)(ws + WS_R1 + 256 * MiB);
#ifndef DIS_G1
        {
            pg8::Gemm g{XB, (const bf16*)(ws + WS_WA_IN) + (size_t)LAYER * 8192 * DM, MROWS, 8192, DM}; pg8::StaticOrder S; S.init(MROWS, 8192, G, (int)blockIdx.x);
            pg8::EpiHgrnIn E{Aq, Alogf, SS + (size_t)ssi * MROWS, (const float*)(ws + WS_LBS) + LAYER * DM};
            pg8::gemm_phase<pg8::EpiHgrnIn, pg8::StaticOrder, true, true>(lds, g, S, E);
#ifdef PROBE_REP_GEMM
            pg8::gemm_phase<pg8::EpiHgrnIn, pg8::StaticOrder, true, true>(lds, g, S, E);
#endif
        }
#endif
        GRID_BAR();
#ifndef DIS_HGRN
        {
            float* HS = (float*)(ws + WS_R2); float* HGm = (float*)(ws + WS_R2 + 16 * MiB);
            for (int u = blockIdx.x; u < BATCH * NHEAD * 3; u += G) { const int bh = u & 63, sg_ = u >> 6;
                hg::hgrn_chunked<true>(lds, bh, sg_, 16 * sg_, 16, Aq, Ak, Av, HGO, Alogf, Asg, args.in[3] + LAYER * HDIM, HS + (size_t)bh * 3 * HDIM * HDIM, HGm + bh * 3 * HDIM); }
#ifdef PROBE_REP_HG1
            __syncthreads();
            for (int u = blockIdx.x; u < BATCH * NHEAD * 3; u += G) { const int bh = u & 63, sg_ = u >> 6;
                hg::hgrn_chunked<true>(lds, bh, sg_, 16 * sg_, 16, Aq, Ak, Av, HGO, Alogf, Asg, args.in[3] + LAYER * HDIM, HS + (size_t)bh * 3 * HDIM * HDIM, HGm + bh * 3 * HDIM); }
#endif
            GRID_BAR();
            for (int u = blockIdx.x; u < BATCH * NHEAD * 4; u += G) { const int bh = u & 63, sg_ = u >> 6;
                hg::hgrn_chunked<false>(lds, bh, sg_, 16 * sg_, 16, Aq, Ak, Av, HGO, Alogf, Asg, args.in[3] + LAYER * HDIM, HS + (size_t)bh * 3 * HDIM * HDIM, HGm + bh * 3 * HDIM); }
#ifdef PROBE_REP_HG2
            __syncthreads();
            for (int u = blockIdx.x; u < BATCH * NHEAD * 4; u += G) { const int bh = u & 63, sg_ = u >> 6;
                hg::hgrn_chunked<false>(lds, bh, sg_, 16 * sg_, 16, Aq, Ak, Av, HGO, Alogf, Asg, args.in[3] + LAYER * HDIM, HS + (size_t)bh * 3 * HDIM * HDIM, HGm + bh * 3 * HDIM); }
#endif
        }
#endif
        GRID_BAR();
#ifndef DIS_G3
        {
            pg8::Gemm g{HGO, (const bf16*)(ws + WS_WA_OUT) + (size_t)LAYER * DM * DM, MROWS, DM, DM}; pg8::StaticOrder S; S.init(MROWS, DM, G, (int)blockIdx.x);
            pg8::EpiRes E{XB, nullptr, SS + (size_t)(ssi + 1) * MROWS, 1.0f, nullptr};
            pg8::gemm_phase<pg8::EpiRes, pg8::StaticOrder, true, true>(lds, g, S, E);
        }
#endif
    } else {
        bf16* KB = (bf16*)(ws + WS_R1); bf16* VB = (bf16*)(ws + WS_R1 + 192 * MiB);
        bf16* QO = (bf16*)(ws + WS_R2); bf16* OG = (bf16*)(ws + WS_OG); bf16* OC = (bf16*)(ws + WS_R2 + 192 * MiB); float* LSE = (float*)(ws + WS_R2 + 256 * MiB);
#ifndef DIS_G2
        {
            constexpr int N = LAYER == 2 ? 18432 : 6144;
            pg8::Gemm g{(const bf16*)(ws + WS_X8), LAYER == 2 ? (const bf16*)(ws + WS_WQKV2) : (const bf16*)(ws + WS_WQ3), MROWS, N, DM / 2}; pg8::StaticOrder S; S.init(MROWS, N, G, (int)blockIdx.x);
            pg8::EpiQkv E{QO, KB, VB, SS + (size_t)ssi * MROWS, args.in[11] + (LAYER - 2) * 3 * HDIM, args.in[8], (const _Float16*)(ws + WS_ROPE), 1.0f / (pg8::F8_XSCALE * pg8::F8_WSCALE)};
            pg8::gemm_phase<pg8::EpiQkv, pg8::StaticOrder, true, true, true>(lds, g, S, E);
#ifdef PROBE_REP_GEMM
            pg8::gemm_phase<pg8::EpiQkv, pg8::StaticOrder, true, true>(lds, g, S, E);
#endif
        }
#endif
        GRID_BAR();
#ifndef DIS_ATTN
#ifdef ATTN_OLD
        att::attn_phase((char*)lds_raw, QO, KB, VB, OG, LSE);
#else
        att2::attn_phase(lds, QO, KB, VB, OG, LSE);
#endif
#ifdef PROBE_REP_ATTN
        att2::attn_phase(lds, QO, KB, VB, OG, LSE);
#endif
#endif
        GRID_BAR();
#ifndef DIS_COMB
        combine_phase(OG, LSE, OC);
#endif
        GRID_BAR();
#ifndef DIS_G3
        {
            pg8::Gemm g{OC, (const bf16*)(ws + WS_WB_OUT) + (size_t)(LAYER - 2) * DM * DM, MROWS, DM, DM / 2}; pg8::StaticOrder S; S.init(MROWS, DM, G, (int)blockIdx.x);
            pg8::EpiRes E{XB, nullptr, SS + (size_t)(ssi + 1) * MROWS, 1.0f / (pg8::F8_XSCALE * pg8::F8_WSCALE), LAYER >= F8_FFN1_LAYER ? ws + WS_X8 : nullptr};
            pg8::gemm_phase<pg8::EpiRes, pg8::StaticOrder, true, true, true>(lds, g, S, E);
        }
#endif
    }
    GRID_BAR();
    bf16* HB = (bf16*)(ws + WS_R2);
#ifndef DIS_G4
    {
        constexpr bool I8I = LAYER >= I8_FFN1_LAYER;
        if constexpr (I8I) { int t_ = threadIdx.x; asm volatile("" : "+v"(t_)); quant_rows(XB, SS + (size_t)(ssi + 1) * MROWS, ws + WS_X8, (float*)(ws + WS_ASC), (int)blockIdx.x * NWAVES + (t_ >> 6), G * NWAVES, t_ & 63); GRID_BAR(); }
        constexpr bool F8I = !I8I && LAYER >= F8_FFN1_LAYER;
        pg8::Gemm g{(F8I || I8I) ? (const bf16*)(ws + WS_X8) : XB, (const bf16*)(ws + WS_WF_IN) + (size_t)LAYER * 2 * FFH * DM, MROWS, 2 * FFH, (F8I || I8I) ? DM / 2 : DM}; pg8::StaticOrder S; S.init(MROWS, 2 * FFH, G, (int)blockIdx.x);
#ifdef CONV_ALL_IN_PROLOGUE
        pg8::EpiFfn1 E{HB, FFH, SS + (size_t)(ssi + 1) * MROWS, (const pg8::ConvJob*)(ws + WS_JOBS), 3, LAYER >= F8_FIRST_LAYER && !I8_FFN2(LAYER), F8I ? 1.0f / (pg8::F8_XSCALE * pg8::F8_WSCALE) : 1.0f, I8I ? (const float*)(ws + WS_ASC) : nullptr, I8I ? (const float*)(ws + WS_WSC) + LAYER * 2 * FFH : nullptr};
#else
        pg8::EpiFfn1 E{HB, FFH, SS + (size_t)(ssi + 1) * MROWS, (const pg8::ConvJob*)(ws + WS_JOBS), LAYER, LAYER >= F8_FIRST_LAYER && !I8_FFN2(LAYER), F8I ? 1.0f / (pg8::F8_XSCALE * pg8::F8_WSCALE) : 1.0f, I8I ? (const float*)(ws + WS_ASC) : nullptr, I8I ? (const float*)(ws + WS_WSC) + LAYER * 2 * FFH : nullptr};
#endif
#ifdef PROBE_CLOCK
        const unsigned long long pc0 = clock64(), pw0 = wall_clock64();
#endif
        pg8::gemm_phase<pg8::EpiFfn1, pg8::StaticOrder, true, true, I8I ? 2 : (F8I ? 1 : 0)>(lds, g, S, E);
#ifdef PROBE_CLOCK
        if (LAYER == 0 && blockIdx.x == 0 && threadIdx.x == 0) { const unsigned long long dc = clock64() - pc0, dw = wall_clock64() - pw0;
            ((unsigned long long*)(ws + WS_CTL))[300] = dc; ((unsigned long long*)(ws + WS_CTL))[301] = dw; }
#endif
#ifdef PROBE_REP_GEMM
            pg8::gemm_phase<pg8::EpiFfn1, pg8::StaticOrder, true, true>(lds, g, S, E);
#endif
#ifdef PROBE_G4_L2RES
        { pg8::ProbeOrder00 S0; S0.init(MROWS, 2 * FFH, G, (int)blockIdx.x); pg8::Gemm gp{XB, g.Bt, MROWS, 2 * FFH, PROBE_G4_L2RES}; pg8::EpiFfn1 Ep{(bf16*)(ws + WS_OG), FFH, E.ss, E.jobs, 3, 0, 1.0f, nullptr, nullptr};
          pg8::gemm_phase<pg8::EpiFfn1, pg8::ProbeOrder00, true, true>(lds, gp, S0, Ep); }
#endif
    }
#endif
    GRID_BAR();
#ifndef DIS_G5
    {
        constexpr bool I8O = I8_FFN2(LAYER);
        if constexpr (I8O) { int t_ = threadIdx.x; asm volatile("" : "+v"(t_)); quant_rows<11>(HB, nullptr, ws + WS_OG, (float*)(ws + WS_ASC2), (int)blockIdx.x * NWAVES + (t_ >> 6), G * NWAVES, t_ & 63); GRID_BAR(); }
        constexpr bool F8L = !I8O && LAYER >= F8_FIRST_LAYER;
        pg8::Gemm g{I8O ? (const bf16*)(ws + WS_OG) : HB, (const bf16*)(ws + WS_WF_OUT) + (size_t)LAYER * DM * FFH, MROWS, DM, (F8L || I8O) ? FFH / 2 : FFH}; pg8::StaticOrder S; S.init(MROWS, DM, G, (int)blockIdx.x);
        if constexpr (I8O) {
            pg8::EpiResI8 E{XB, LAYER == 3 ? out : nullptr, SS + (size_t)(ssi + 2) * MROWS, 1.0f, (LAYER == 1 || LAYER == 2) ? ws + WS_X8 : nullptr, (const float*)(ws + WS_ASC2), (const float*)(ws + WS_WSC2) + LAYER * DM};
            pg8::gemm_phase<pg8::EpiResI8, pg8::StaticOrder, true, true, 2>(lds, g, S, E);
        } else {
            pg8::EpiRes E{XB, LAYER == 3 ? out : nullptr, SS + (size_t)(ssi + 2) * MROWS, F8L ? 1.0f / (pg8::F8_HSCALE * pg8::F8_WSCALE) : 1.0f, (LAYER == 1 || LAYER == 2) ? ws + WS_X8 : nullptr};
            pg8::gemm_phase<pg8::EpiRes, pg8::StaticOrder, true, true, F8L ? 1 : 0>(lds, g, S, E);
        }
    }
#endif
    if constexpr (LAYER < 3) GRID_BAR();
}

__global__ void __launch_bounds__(NWAVES * 64, 2) yoco_fwd(Args args) {
    extern __shared__ __attribute__((aligned(16))) unsigned char lds_raw[];
    LAS unsigned char* lds = (LAS unsigned char*)lds_raw;
    const int tid = threadIdx.x;
    volatile LAS unsigned* MISC = (volatile LAS unsigned*)(lds + MISC_OFF);
    if (tid < 64) MISC[tid] = 0u;
    __syncthreads();
    XcdBarrier bar = xcd_barrier_post((unsigned*)(args.ws + WS_CTL) + CW_BAR, MISC + 8);
    if constexpr (I8_FFN1_LAYER < 4) { wmax_pass(args, (int)blockIdx.x * NWAVES + (tid >> 6), (int)gridDim.x * NWAVES, tid & 63); GRID_BAR(); }
#ifndef DIS_PRO
    { const int lane = tid & 63, wave = __builtin_amdgcn_readfirstlane(tid >> 6), G = gridDim.x;
      const int vcu = (G % 8 == 0) ? ((int)blockIdx.x % 8) * (G / 8) + (int)blockIdx.x / 8 : (int)blockIdx.x;
      prologue(args, lds, vcu * NWAVES + wave, G * NWAVES, lane, wave);
#ifdef PROBE_REP_PRO
      prologue(args, lds, vcu * NWAVES + wave, G * NWAVES, lane, wave);
#endif
    }
#endif
    GRID_BAR();
#ifndef ONLY_LAYER
    layer_phases<0>(args, lds, lds_raw, bar);
    layer_phases<1>(args, lds, lds_raw, bar);
    layer_phases<2>(args, lds, lds_raw, bar);
    layer_phases<3>(args, lds, lds_raw, bar);
#else
    layer_phases<ONLY_LAYER>(args, lds, lds_raw, bar);
#endif
#ifdef PROBE_CLOCK
    if (blockIdx.x == 0 && threadIdx.x == 0) {
        const unsigned long long dc = ((volatile unsigned long long*)(args.ws + WS_CTL))[300], dw = ((volatile unsigned long long*)(args.ws + WS_CTL))[301];
        const unsigned long long ticks = dw ? (dc * 10000ull) / dw : 0ull, t0 = wall_clock64();
        while (wall_clock64() - t0 < ticks) __builtin_amdgcn_s_sleep(8);
    }
#endif
}

extern "C" void kernel_launch(void* const* d_in, const int* in_sizes, int n_in, void* d_out, int out_size, void* d_ws, size_t ws_size, hipStream_t stream) {
    static int grid = 0;
    if (grid == 0) {
        if (n_in != 16 || out_size != MROWS * DM || ws_size < WS_END) { fprintf(stderr, "kernel_launch: unexpected shapes (n_in %d out %d ws %zu)\n", n_in, out_size, ws_size); grid = -1; return; }
        int dev = 0, cus = 0, per_cu = 0;
        if (hipGetDevice(&dev) != hipSuccess || hipDeviceGetAttribute(&cus, hipDeviceAttributeMultiprocessorCount, dev) != hipSuccess) { grid = -1; return; }
        if (hipFuncSetAttribute((const void*)yoco_fwd, hipFuncAttributeMaxDynamicSharedMemorySize, LDS_BYTES) != hipSuccess) { fprintf(stderr, "kernel_launch: hipFuncSetAttribute failed\n"); grid = -1; return; }
        if (hipOccupancyMaxActiveBlocksPerMultiprocessor(&per_cu, (const void*)yoco_fwd, NWAVES * 64, LDS_BYTES) != hipSuccess || per_cu < 1) { fprintf(stderr, "kernel_launch: occupancy query says %d\n", per_cu); }
        (void)hipGetLastError();
        grid = cus;
    }
    if (grid < 0) return;
    (void)hipMemsetAsync((char*)d_ws + WS_CTL, 0, CTL_ZERO_BYTES, stream);
    Args a{};
    for (int i = 0; i < 16; ++i) a.in[i] = (const float*)d_in[i];
    a.out = (float*)d_out; a.ws = (unsigned char*)d_ws;
    hipLaunchKernelGGL(yoco_fwd, dim3(grid), dim3(NWAVES * 64), LDS_BYTES, stream, a);
}
```
